# Optimizing an MI355X kernel written in HIP

```python
import math
import jax, jax.numpy as jnp
from jax import lax
import numpy as np

D_MODEL = 1024
BATCH = 4
SEQ = 4096
DEPTH = 4

GRID_W = 64
CTX_LEN = 256
N_MIXERS = 4
Q_BLOCK = 128
NORM_EPS = 1e-6
NEG_INF = -1e30
ROPE_BASE = 10000.0
ROPE_DIM = 64

MLA_HEADS = 8
MLA_Q_RANK = 384
MLA_KV_RANK = 256
MLA_NOPE = 128
MLA_ROPE = ROPE_DIM
MLA_V = 128
MLA_WIDTH = MLA_HEADS * MLA_V

HY_WIDTH = D_MODEL
HY_ORDER = 2
HY_SHORT = 3
HY_EMB = 33
HY_BANDS = (HY_EMB - 1) // 2
HY_FILT_HIDDEN = 64
HY_DECAY_TARGET = 1e-2
HY_FAST_DECAY = 0.3
HY_SLOW_DECAY = 1.5

SWA_Q_HEADS = 16
SWA_KV_HEADS = 4
SWA_GROUP = SWA_Q_HEADS // SWA_KV_HEADS
SWA_HEAD_DIM = ROPE_DIM
SWA_WINDOW = 128
SWA_WIDTH = SWA_Q_HEADS * SWA_HEAD_DIM

CF_WIDTH = D_MODEL
CF_KERNEL = 31

kernel_name = "hybrid_mla_hyena_swa_conformer_flow_trunk"


def n_layers_of(m):
    return len(range(m, DEPTH, N_MIXERS))


def rmsnorm(x, g):
    xf = x.astype(jnp.float32)
    y = xf * lax.rsqrt(jnp.mean(xf * xf, axis=-1, keepdims=True) + NORM_EPS)
    return (y * g.astype(jnp.float32)).astype(x.dtype)


def layernorm(x, g, b):
    xf = x.astype(jnp.float32)
    mu = jnp.mean(xf, axis=-1, keepdims=True)
    xc = xf - mu
    var = jnp.mean(xc * xc, axis=-1, keepdims=True)
    return (xc * lax.rsqrt(var + NORM_EPS) * g.astype(jnp.float32) + b.astype(jnp.float32)).astype(x.dtype)


def modulate(h, shift, scale):
    return h * (1 + scale) + shift


def grid_rope(L, dim, dtype):
    rows = L // GRID_W
    row = jnp.repeat(jnp.arange(rows, dtype=jnp.float32), GRID_W)
    col = jnp.tile(jnp.arange(GRID_W, dtype=jnp.float32), rows)
    n_freq = dim // 4
    inv = ROPE_BASE ** (-jnp.arange(n_freq, dtype=jnp.float32) / n_freq)
    ang = jnp.concatenate([row[:, None] * inv, col[:, None] * inv], axis=-1)
    return jnp.cos(ang).astype(dtype), jnp.sin(ang).astype(dtype)


def apply_rope(x, cos, sin):
    half = x.shape[-1] // 2
    x1, x2 = x[..., :half], x[..., half:]
    return jnp.concatenate([x1 * cos - x2 * sin, x1 * sin + x2 * cos], axis=-1)


def depthwise_conv(u, w, b):
    K, C = w.shape
    pad = (K - 1) // 2
    y = lax.conv_general_dilated(u, w[:, None, :].astype(u.dtype), window_strides=(1,),
                                 padding=[(pad, pad)], dimension_numbers=('NWC', 'WIO', 'NWC'),
                                 feature_group_count=C)
    return y + b


def to_blocks(t):
    B, L = t.shape[:2]
    return jnp.moveaxis(t.reshape(B, L // Q_BLOCK, Q_BLOCK, *t.shape[2:]), 1, 0)


def from_blocks(o):
    nb, B, Q = o.shape[:3]
    return jnp.moveaxis(o, 0, 1).reshape(B, nb * Q, *o.shape[3:])


def mla_mixer(a, ac, cos, sin, w_in, q_norm_g, kv_norm_g, w_uq, w_ukv, w_out, ctx_out):
    B, L, _ = a.shape
    splits = [MLA_Q_RANK, MLA_Q_RANK + MLA_KV_RANK, MLA_Q_RANK + MLA_KV_RANK + MLA_ROPE]

    def project(t):
        n = t.shape[1]
        cq, ckv, k_rope, gate = jnp.split(t @ w_in, splits, axis=-1)
        q = (rmsnorm(cq, q_norm_g) @ w_uq).reshape(B, n, MLA_HEADS, MLA_NOPE + MLA_ROPE)
        kv = (rmsnorm(ckv, kv_norm_g) @ w_ukv).reshape(B, n, MLA_HEADS, MLA_NOPE + MLA_V)
        return q[..., :MLA_NOPE], q[..., MLA_NOPE:], kv[..., :MLA_NOPE], k_rope, kv[..., MLA_NOPE:], gate

    qn, qr, kn, kr, v, gate = project(a)
    qr = apply_rope(qr, cos[:, None, :], sin[:, None, :])
    kr = apply_rope(kr, cos, sin)
    qnc, qrc, knc, krc, vc, gatec = project(ac)
    scale = (MLA_NOPE + MLA_ROPE) ** -0.5

    def scores(qn_, qr_, kn_, kr_):
        s = jnp.einsum('bqhd,bkhd->bhqk', qn_, kn_) + jnp.einsum('bqhr,bkr->bhqk', qr_, kr_)
        return s.astype(jnp.float32) * scale

    def attend(blk):
        qn_b, qr_b = blk
        s = jnp.concatenate([scores(qn_b, qr_b, kn, kr), scores(qn_b, qr_b, knc, krc)], axis=-1)
        p = jax.nn.softmax(s, axis=-1).astype(v.dtype)
        return (jnp.einsum('bhqk,bkhd->bqhd', p[..., :L], v)
                + jnp.einsum('bhqk,bkhd->bqhd', p[..., L:], vc))

    o = from_blocks(lax.map(attend, (to_blocks(qn), to_blocks(qr)))).reshape(B, L, MLA_WIDTH)
    y = (o * jax.nn.silu(gate)) @ w_out
    yc = None
    if ctx_out:
        pc = jax.nn.softmax(scores(qnc, qrc, knc, krc), axis=-1).astype(vc.dtype)
        oc = jnp.einsum('bhqk,bkhd->bqhd', pc, vc).reshape(B, -1, MLA_WIDTH)
        yc = (oc * jax.nn.silu(gatec)) @ w_out
    return y, yc


def hyena_filter_spectra(L, w_in, w_hid, b, freq, w_out):
    f32 = jnp.float32
    t = jnp.linspace(0.0, 1.0, L, dtype=f32)[:, None]
    wpos = (2.0 * math.pi / L) * jnp.arange(L, dtype=f32)[:, None]
    bands = jnp.linspace(1e-4, HY_BANDS - 1, HY_BANDS, dtype=f32)[None, :]
    hdn = jnp.concatenate([t, jnp.cos(bands * wpos), -jnp.sin(bands * wpos)], axis=-1)
    b, freq = b.astype(f32), freq.astype(f32)
    for k, w in enumerate((w_in, w_hid[0], w_hid[1])):
        hdn = jnp.sin(freq[k] * (hdn @ w.astype(f32) + b[k]))
    h = (hdn @ w_out.astype(f32)).reshape(L, HY_ORDER, 2, HY_WIDTH)
    deltas = jnp.abs(jnp.linspace(math.log(HY_DECAY_TARGET) / HY_FAST_DECAY,
                                  math.log(HY_DECAY_TARGET) / HY_SLOW_DECAY, HY_WIDTH, dtype=f32))
    h = h * jnp.exp(-t * deltas)[:, None, None, :]
    hf, hb = h[:, :, 0], h[:, :, 1]
    k_circ = jnp.concatenate([hf[:1] + hb[:1], hf[1:], jnp.zeros_like(hf[:1]), hb[:0:-1]], axis=0)
    return jnp.fft.rfft(k_circ, axis=0)


def fft_long_conv(u, spec):
    L = u.shape[1]
    U = jnp.fft.rfft(u.astype(jnp.float32), n=2 * L, axis=1)
    return jnp.fft.irfft(U * spec, n=2 * L, axis=1)[:, :L].astype(u.dtype)


def hyena_seq(t, w_in, conv_w, conv_b, spec, bias, w_out):
    u, gate = jnp.split(t @ w_in, [(HY_ORDER + 1) * HY_WIDTH], axis=-1)
    u = depthwise_conv(u, conv_w, conv_b)
    v, *gates = jnp.split(u, HY_ORDER + 1, axis=-1)
    z = v
    for o in range(HY_ORDER):
        z = gates[o] * (fft_long_conv(z, spec[:, o]) + z * bias[o])
    return (z * jax.nn.silu(gate)) @ w_out


def swa_mixer(a, ac, cos, sin, w_in, sink, w_out, ctx_out):
    B, L, _ = a.shape
    nq = SWA_Q_HEADS * SWA_HEAD_DIM
    nkv = SWA_KV_HEADS * SWA_HEAD_DIM

    def project(t):
        n = t.shape[1]
        q, k, v, gate = jnp.split(t @ w_in, [nq, nq + nkv, nq + 2 * nkv], axis=-1)
        return (q.reshape(B, n, SWA_KV_HEADS, SWA_GROUP, SWA_HEAD_DIM),
                k.reshape(B, n, SWA_KV_HEADS, SWA_HEAD_DIM),
                v.reshape(B, n, SWA_KV_HEADS, SWA_HEAD_DIM), gate)

    q, k, v, gate = project(a)
    q = apply_rope(q, cos[:, None, None, :], sin[:, None, None, :])
    k = apply_rope(k, cos[:, None, :], sin[:, None, :])
    qc, kc, vc, gatec = project(ac)
    scale = SWA_HEAD_DIM ** -0.5
    sink_logit = sink.astype(jnp.float32).reshape(SWA_KV_HEADS, SWA_GROUP, 1, 1)

    def softmax_with_sink(parts, n_q):
        s_sink = jnp.broadcast_to(sink_logit, (B, SWA_KV_HEADS, SWA_GROUP, n_q, 1))
        p = jax.nn.softmax(jnp.concatenate([*parts, s_sink], axis=-1), axis=-1)
        return p[..., :-1].astype(v.dtype)

    span = Q_BLOCK + 2 * SWA_WINDOW
    pad = ((0, 0), (SWA_WINDOW, SWA_WINDOW), (0, 0), (0, 0))
    kp, vp = jnp.pad(k, pad), jnp.pad(v, pad)
    rel = jnp.arange(span)[None, :] - jnp.arange(Q_BLOCK)[:, None]
    band = (rel >= 0) & (rel <= 2 * SWA_WINDOW)

    def attend(args):
        j, q_b = args
        start = j * Q_BLOCK
        k_b = lax.dynamic_slice_in_dim(kp, start, span, axis=1)
        v_b = lax.dynamic_slice_in_dim(vp, start, span, axis=1)
        kpos = start - SWA_WINDOW + jnp.arange(span)
        valid = band & ((kpos >= 0) & (kpos < L))[None, :]
        s_win = jnp.einsum('bqhgd,bkhd->bhgqk', q_b, k_b).astype(jnp.float32) * scale
        s_win = jnp.where(valid, s_win, NEG_INF)
        s_ctx = jnp.einsum('bqhgd,bkhd->bhgqk', q_b, kc).astype(jnp.float32) * scale
        p = softmax_with_sink([s_win, s_ctx], Q_BLOCK)
        return (jnp.einsum('bhgqk,bkhd->bqhgd', p[..., :span], v_b)
                + jnp.einsum('bhgqk,bkhd->bqhgd', p[..., span:], vc))

    o = from_blocks(lax.map(attend, (jnp.arange(L // Q_BLOCK), to_blocks(q)))).reshape(B, L, SWA_WIDTH)
    y = (o * jax.nn.silu(gate)) @ w_out
    yc = None
    if ctx_out:
        s = jnp.einsum('bqhgd,bkhd->bhgqk', qc, kc).astype(jnp.float32) * scale
        pc = softmax_with_sink([s], qc.shape[1])
        oc = jnp.einsum('bhgqk,bkhd->bqhgd', pc, vc).reshape(B, -1, SWA_WIDTH)
        yc = (oc * jax.nn.silu(gatec)) @ w_out
    return y, yc


def conformer_seq(t, w_in, dw_w, dw_b, ln_g, ln_b, w_out):
    a, b, gate = jnp.split(t @ w_in, 3, axis=-1)
    u = a * jax.nn.sigmoid(b)
    u = depthwise_conv(u, dw_w, dw_b)
    u = jax.nn.silu(layernorm(u, ln_g, ln_b))
    return (u * jax.nn.silu(gate)) @ w_out


def setup_inputs(seed: int = 0) -> dict:
    key = jax.random.key(seed)
    ks = iter(jax.random.split(key, 40))
    D = D_MODEL
    f32 = jnp.float32

    def nrm(shape, std):
        return jax.random.normal(next(ks), shape, f32) * std

    def gain(shape):
        return 1.0 + nrm(shape, 0.02)

    nA, nB, nC, nD = (n_layers_of(m) for m in range(N_MIXERS))
    mla_in = MLA_Q_RANK + MLA_KV_RANK + MLA_ROPE + MLA_WIDTH
    swa_in = SWA_Q_HEADS * SWA_HEAD_DIM + 2 * SWA_KV_HEADS * SWA_HEAD_DIM + SWA_WIDTH
    return {
        "x": nrm((BATCH, SEQ, D), 1.0),
        "c": nrm((BATCH, D), 1.0),
        "ctx": nrm((BATCH, CTX_LEN, D), 1.0),
        "c_ctx": nrm((D,), 1.0),
        "norm_g": gain((DEPTH, D)),
        "ada_w": nrm((DEPTH, D, 3 * D), 0.5 * D ** -0.5),
        "ada_b": nrm((DEPTH, 3 * D), 0.02),
        "final_g": gain((D,)),
        "mla_w_in": nrm((nA, D, mla_in), D ** -0.5),
        "mla_q_norm_g": gain((nA, MLA_Q_RANK)),
        "mla_kv_norm_g": gain((nA, MLA_KV_RANK)),
        "mla_w_uq": nrm((nA, MLA_Q_RANK, MLA_HEADS * (MLA_NOPE + MLA_ROPE)), MLA_Q_RANK ** -0.5),
        "mla_w_ukv": nrm((nA, MLA_KV_RANK, MLA_HEADS * (MLA_NOPE + MLA_V)), MLA_KV_RANK ** -0.5),
        "mla_w_out": nrm((nA, MLA_WIDTH, D), MLA_WIDTH ** -0.5),
        "hy_w_in": nrm((nB, D, (HY_ORDER + 2) * HY_WIDTH), D ** -0.5),
        "hy_conv_w": nrm((nB, HY_SHORT, (HY_ORDER + 1) * HY_WIDTH), HY_SHORT ** -0.5),
        "hy_conv_b": nrm((nB, (HY_ORDER + 1) * HY_WIDTH), 0.02),
        "hy_filt_w_in": nrm((nB, HY_EMB, HY_FILT_HIDDEN), HY_EMB ** -0.5),
        "hy_filt_w_hid": nrm((nB, 2, HY_FILT_HIDDEN, HY_FILT_HIDDEN), HY_FILT_HIDDEN ** -0.5),
        "hy_filt_b": nrm((nB, 3, HY_FILT_HIDDEN), 0.2),
        "hy_filt_freq": gain((nB, 3, HY_FILT_HIDDEN)),
        "hy_filt_w_out": nrm((nB, HY_FILT_HIDDEN, HY_ORDER * 2 * HY_WIDTH), 0.005),
        "hy_bias": nrm((nB, HY_ORDER, HY_WIDTH), 0.5),
        "hy_w_out": nrm((nB, HY_WIDTH, D), HY_WIDTH ** -0.5),
        "swa_w_in": nrm((nC, D, swa_in), D ** -0.5),
        "swa_sink": nrm((nC, SWA_Q_HEADS), 0.5),
        "swa_w_out": nrm((nC, SWA_WIDTH, D), SWA_WIDTH ** -0.5),
        "cf_w_in": nrm((nD, D, 3 * CF_WIDTH), D ** -0.5),
        "cf_dw_w": nrm((nD, CF_KERNEL, CF_WIDTH), CF_KERNEL ** -0.5),
        "cf_dw_b": nrm((nD, CF_WIDTH), 0.02),
        "cf_ln_g": gain((nD, CF_WIDTH)),
        "cf_ln_b": nrm((nD, CF_WIDTH), 0.02),
        "cf_w_out": nrm((nD, CF_WIDTH, D), CF_WIDTH ** -0.5),
    }


def reference(x, c, ctx, c_ctx, norm_g, ada_w, ada_b, final_g,
              mla_w_in, mla_q_norm_g, mla_kv_norm_g, mla_w_uq, mla_w_ukv, mla_w_out,
              hy_w_in, hy_conv_w, hy_conv_b, hy_filt_w_in, hy_filt_w_hid, hy_filt_b, hy_filt_freq,
              hy_filt_w_out, hy_bias, hy_w_out,
              swa_w_in, swa_sink, swa_w_out,
              cf_w_in, cf_dw_w, cf_dw_b, cf_ln_g, cf_ln_b, cf_w_out):
    B, L, _ = x.shape
    Lc = ctx.shape[1]
    cos, sin = grid_rope(L, ROPE_DIM, x.dtype)
    silu_c = jax.nn.silu(c)
    silu_cc = jax.nn.silu(c_ctx)
    xc = ctx
    for i in range(DEPTH):
        m, j = i % N_MIXERS, i // N_MIXERS
        ctx_out = i < DEPTH - 1
        shift, scale, gate = jnp.split((silu_c @ ada_w[i] + ada_b[i])[:, None, :], 3, axis=-1)
        a = modulate(rmsnorm(x, norm_g[i]), shift, scale)
        if ctx_out or m in (0, 2):
            shift_c, scale_c, gate_c = jnp.split(silu_cc @ ada_w[i] + ada_b[i], 3, axis=-1)
            ac = modulate(rmsnorm(xc, norm_g[i]), shift_c, scale_c)
        yc = None
        if m == 0:
            y, yc = mla_mixer(a, ac, cos, sin, mla_w_in[j], mla_q_norm_g[j], mla_kv_norm_g[j],
                              mla_w_uq[j], mla_w_ukv[j], mla_w_out[j], ctx_out)
        elif m == 1:
            filt = (hy_filt_w_in[j], hy_filt_w_hid[j], hy_filt_b[j], hy_filt_freq[j], hy_filt_w_out[j])
            y = hyena_seq(a, hy_w_in[j], hy_conv_w[j], hy_conv_b[j],
                          hyena_filter_spectra(L, *filt), hy_bias[j], hy_w_out[j])
            if ctx_out:
                yc = hyena_seq(ac, hy_w_in[j], hy_conv_w[j], hy_conv_b[j],
                               hyena_filter_spectra(Lc, *filt), hy_bias[j], hy_w_out[j])
        elif m == 2:
            y, yc = swa_mixer(a, ac, cos, sin, swa_w_in[j], swa_sink[j], swa_w_out[j], ctx_out)
        else:
            y = conformer_seq(a, cf_w_in[j], cf_dw_w[j], cf_dw_b[j], cf_ln_g[j], cf_ln_b[j], cf_w_out[j])
            if ctx_out:
                yc = conformer_seq(ac, cf_w_in[j], cf_dw_w[j], cf_dw_b[j], cf_ln_g[j], cf_ln_b[j], cf_w_out[j])
        x = x + gate * y
        if ctx_out:
            xc = xc + gate_c * yc
    return rmsnorm(x, final_g)
```

```cpp
#include <hip/hip_runtime.h>
#include <hip/hip_cooperative_groups.h>
#include <cstdio>
#include <cstdint>
namespace cg = cooperative_groups;

typedef unsigned short bf16_t;
typedef __attribute__((ext_vector_type(8))) short bf16x8;
typedef __attribute__((ext_vector_type(4))) float f32x4;
typedef __attribute__((ext_vector_type(2))) float f32x2;
typedef __attribute__((ext_vector_type(4))) unsigned u32x4;
typedef __attribute__((ext_vector_type(2))) unsigned u32x2;

#define NT 512
#define DYN_LDS 139264
#ifndef PROBE_REPS
#define PROBE_REPS 1, 1, 1, 1, 1, 1, 1, 1
#endif
#define DI __device__ __forceinline__

constexpr int NLAT = 16384, NCTX = 1024, NTOK = 17408, SEQ = 4096, LCTX = 256, KEYS = 4352;
constexpr float LOG2E = 1.4426950408889634f;
constexpr size_t XCD_BAR_BYTES = 3456 * 4;

constexpr size_t al(size_t x) { return (x + 255) & ~(size_t)255; }
constexpr size_t O_W_MLA_IN = 0;
constexpr size_t O_W_UQ = O_W_MLA_IN + al((size_t)1792 * 1024 * 2);
constexpr size_t O_W_UKV = O_W_UQ + al((size_t)1536 * 384 * 2);
constexpr size_t O_W_MLA_OUT = O_W_UKV + al((size_t)2048 * 256 * 2);
constexpr size_t O_W_HY_IN = O_W_MLA_OUT + al((size_t)1024 * 1024 * 2);
constexpr size_t O_W_HY_OUT = O_W_HY_IN + al((size_t)4096 * 1024 * 2);
constexpr size_t O_W_SWA_IN = O_W_HY_OUT + al((size_t)1024 * 1024 * 2);
constexpr size_t O_W_SWA_OUT = O_W_SWA_IN + al((size_t)2560 * 1024 * 2);
constexpr size_t O_W_CF_IN = O_W_SWA_OUT + al((size_t)1024 * 1024 * 2);
constexpr size_t O_W_CF_OUT = O_W_CF_IN + al((size_t)3072 * 1024 * 2);
constexpr size_t O_MOD = O_W_CF_OUT + al((size_t)1024 * 1024 * 2);
constexpr size_t O_HDN = O_MOD + al((size_t)4 * 5 * 3072 * 4);
constexpr size_t O_HDNC = O_HDN + al((size_t)64 * 4096 * 4);
constexpr size_t O_HDNB = O_HDNC + al((size_t)64 * 256 * 4);
constexpr size_t O_ROPE = O_HDNB + al((size_t)4096 * 64 * 2);
constexpr size_t O_RSS = O_ROPE + al((size_t)4096 * 32 * 8);
constexpr size_t O_XC = O_RSS + al((size_t)2 * NTOK * 4);
constexpr size_t O_ACT = O_XC + al((size_t)NCTX * 1024 * 4);
constexpr size_t O_T = O_ACT + al((size_t)NTOK * 1024 * 2);
constexpr size_t O_CQ = O_T;
constexpr size_t O_CKV = O_CQ + al((size_t)NTOK * 384 * 2);
constexpr size_t O_SG0 = O_CKV + al((size_t)NTOK * 256 * 2);
constexpr size_t O_Q = O_SG0 + al((size_t)NTOK * 1024 * 2);
constexpr size_t O_KP = O_Q + al((size_t)NTOK * 1536 * 2);
constexpr size_t O_END0 = O_KP + al((size_t)NTOK * 1536 * 2);
constexpr size_t O_UT = O_T;
constexpr size_t O_FFT = O_UT + al((size_t)4096 * NTOK * 2);
constexpr size_t O_END1 = O_FFT + (size_t)256 * 131072;
constexpr size_t O_QS = O_T;
constexpr size_t O_KS = O_QS + al((size_t)NTOK * 1024 * 2);
constexpr size_t O_VT2 = O_KS + al((size_t)NTOK * 256 * 2);
constexpr size_t O_SG2 = O_VT2 + al((size_t)16 * 64 * KEYS * 2);
constexpr size_t O_U3 = O_T;
constexpr size_t O_SG3 = O_U3 + al((size_t)NLAT * 1024 * 2);
constexpr size_t O_BAR = (O_END0 > O_END1 ? O_END0 : O_END1);
constexpr size_t WS_NEED = O_BAR + XCD_BAR_BYTES;

struct P {
  const float* in[33];
  float* out;
  unsigned char* ws;
  int reps[8];
};

DI int otid() { int t = threadIdx.x; asm volatile("" : "+v"(t)); return t; }
template <class T> DI T* opq(T* p) { asm volatile("" : "+s"(p)); return p; }
DI bf16_t f2bf(float x) { unsigned r; asm("v_cvt_pk_bf16_f32 %0, %1, %1" : "=v"(r) : "v"(x)); return (bf16_t)r; }
DI float bf2f(bf16_t v) { return __uint_as_float(((unsigned)v) << 16); }
DI unsigned pack2(float a, float b) { unsigned r; asm("v_cvt_pk_bf16_f32 %0, %1, %2" : "=v"(r) : "v"(a), "v"(b)); return r; }
DI float siluf(float x) { return x * __builtin_amdgcn_rcpf(1.f + __expf(-x)); }
DI float sigmf(float x) { return __builtin_amdgcn_rcpf(1.f + __expf(-x)); }
DI float wave_sum(float v) {
#pragma unroll
  for (int o = 32; o >= 1; o >>= 1) v += __shfl_xor(v, o, 64);
  return v;
}
DI void store4bf(bf16_t* p, float a, float b, float c, float d) {
  uint2 v; v.x = pack2(a, b); v.y = pack2(c, d);
  *(uint2*)p = v;
}
DI f32x4 mfma16(bf16x8 a, bf16x8 b, f32x4 c) { return __builtin_amdgcn_mfma_f32_16x16x32_bf16(a, b, c, 0, 0, 0); }

DI int tok_modrow(int tok) { return tok < NLAT ? (tok >> 12) : 4; }
DI int tok_batch(int tok) { return tok < NLAT ? (tok >> 12) : ((tok - NLAT) >> 8); }
DI int tok_key(int tok) { return tok < NLAT ? (tok & 4095) : (SEQ + ((tok - NLAT) & 255)); }
DI int key_perm(int key) { const int x = key & 31; return (key & ~31) | (((x >> 2) & 3) * 8 + (x >> 4) * 4 + (x & 3)); }

constexpr int GLD = 72;
template <class Epi>
DI void gemm_tile(const bf16_t* __restrict__ W, const bf16_t* __restrict__ X, int K, int f0, int t0, char* smem, const Epi& epi) {
  bf16_t* sW = (bf16_t*)smem;
  bf16_t* sX = sW + 128 * GLD;
  const int tid = otid(), lane = tid & 63, wave = tid >> 6;
  const int wf = wave >> 2, wt = wave & 3;
  const int lr = lane & 15, lq = lane >> 4;
  f32x4 acc[4][4];
#pragma unroll
  for (int i = 0; i < 4; ++i)
#pragma unroll
    for (int j = 0; j < 4; ++j) acc[i][j] = (f32x4){0.f, 0.f, 0.f, 0.f};
  u32x4 rwA[2], rxA[4], rwB[2], rxB[4];
  const int crow = tid >> 3, ccol = (tid & 7) * 8;
  const bf16_t* Wp = W + (size_t)(f0 + crow) * K + ccol;
  const bf16_t* Xp = X + (size_t)(t0 + crow) * K + ccol;
#define G_LOAD(RW, RX, KOFF)                                                            \
  {                                                                                     \
    _Pragma("unroll") for (int i = 0; i < 2; ++i) RW[i] = *(const u32x4*)(Wp + (size_t)(64 * i) * K + (KOFF)); \
    _Pragma("unroll") for (int i = 0; i < 4; ++i) RX[i] = *(const u32x4*)(Xp + (size_t)(64 * i) * K + (KOFF)); \
  }
#define G_STORE(RW, RX)                                                                 \
  {                                                                                     \
    _Pragma("unroll") for (int i = 0; i < 2; ++i) *(u32x4*)(sW + (crow + 64 * i) * GLD + ccol) = RW[i]; \
    _Pragma("unroll") for (int i = 0; i < 4; ++i) *(u32x4*)(sX + (crow + 64 * i) * GLD + ccol) = RX[i]; \
  }
#define G_COMPUTE()                                                                     \
  {                                                                                     \
    _Pragma("unroll") for (int ks = 0; ks < 2; ++ks) {                                  \
      bf16x8 a[4], b[4];                                                                \
      _Pragma("unroll") for (int i = 0; i < 4; ++i) a[i] = *(const bf16x8*)(sW + (wf * 64 + i * 16 + lr) * GLD + ks * 32 + lq * 8); \
      _Pragma("unroll") for (int i = 0; i < 4; ++i) b[i] = *(const bf16x8*)(sX + (wt * 64 + i * 16 + lr) * GLD + ks * 32 + lq * 8); \
      _Pragma("unroll") for (int i = 0; i < 4; ++i)                                     \
        _Pragma("unroll") for (int j = 0; j < 4; ++j) acc[i][j] = mfma16(a[i], b[j], acc[i][j]); \
    }                                                                                   \
  }
  G_LOAD(rwA, rxA, 0);
  G_LOAD(rwB, rxB, 64);
  for (int k0 = 0; k0 < K; k0 += 128) {
    __syncthreads();
    G_STORE(rwA, rxA);
    __syncthreads();
    { const int kn = k0 + 128 < K ? k0 + 128 : K - 128; G_LOAD(rwA, rxA, kn); }
    G_COMPUTE();
    __syncthreads();
    G_STORE(rwB, rxB);
    __syncthreads();
    { const int kn = k0 + 192 < K ? k0 + 192 : K - 64; G_LOAD(rwB, rxB, kn); }
    G_COMPUTE();
  }
#undef G_LOAD
#undef G_STORE
#undef G_COMPUTE
  epi(f0 + wf * 64, t0 + wt * 64, acc);
}

struct TileWalk {
  int nft, start, ntl, u, nlb;
  DI TileWalk(int nft_, int ntt) {
    const int x = blockIdx.x & 7;
    nft = nft_;
    start = (x * ntt) >> 3;
    ntl = (((x + 1) * ntt) >> 3) - start;
    u = blockIdx.x >> 3;
    nlb = (gridDim.x - x + 7) >> 3;
  }
  DI bool next(int& ft, int& tt) {
    if (u >= ntl * nft) return false;
    const int grp = u / (4 * nft), rem = u - grp * 4 * nft;
    const int left = ntl - grp * 4, gsz = left < 4 ? left : 4;
    ft = rem / gsz;
    tt = start + grp * 4 + rem % gsz;
    u += nlb;
    return true;
  }
};

template <class Epi>
DI void gemm_phase(const bf16_t* W, const bf16_t* X, int K, int NF, int NTK, char* smem, const Epi& epi) {
  TileWalk tw(NF / 128, NTK / 256);
  int ft, tt;
  while (tw.next(ft, tt)) gemm_tile(W, X, K, ft * 128, tt * 256, smem, epi);
}


constexpr int G_BK = 64, G_HALF = 128, G_HT = G_HALF * G_BK;
DI int g_lds_byte(int r, int c) {
  int st = (r >> 4) * 2 + (c >> 5), rr = r & 15, cc = c & 31, ob = rr * 64 + cc * 2;
  return st * 1024 + (ob ^ (((ob >> 9) & 1) << 5));
}
DI void g_stage_rc(int b, int& R, int& C) {
  int st = b / 1024, sb = b % 1024, swz = sb ^ (((sb >> 9) & 1) << 5);
  R = (st >> 1) * 16 + swz / 64; C = (st & 1) * 32 + (swz % 64) / 2;
}
template <class Epi>
DI void gemm_tile256(const bf16_t* __restrict__ W, const bf16_t* __restrict__ X, int K, int f0, int t0, char* smem, const Epi& epi, bool dry = false) {
  const int tidx = otid();
  const int wid = tidx >> 6, lane = tidx & 63, wr = wid >> 2, wc = wid & 3, fr = lane & 15, fq = lane >> 4;
  f32x4 acc[8][4];
#pragma unroll
  for (int i = 0; i < 8; ++i)
#pragma unroll
    for (int j = 0; j < 4; ++j) acc[i][j] = (f32x4){0.f, 0.f, 0.f, 0.f};
  int r0, c0, r1, c1;
  g_stage_rc(tidx * 16, r0, c0);
  g_stage_rc(tidx * 16 + 8192, r1, c1);
  const bf16_t* Wg0 = W + (size_t)(f0 + r0) * K + c0;
  const bf16_t* Wg1 = W + (size_t)(f0 + r1) * K + c1;
  const bf16_t* Xg0 = X + (size_t)(t0 + r0) * K + c0;
  const bf16_t* Xg1 = X + (size_t)(t0 + r1) * K + c1;
  const size_t hk = (size_t)128 * K;
#define GLL(src, dst) __builtin_amdgcn_global_load_lds((const unsigned*)(src), (__attribute__((address_space(3))) unsigned*)(dst), 16, 0, 0)
#define STAGE_ALL(buf, kt)                                                     \
  {                                                                            \
    char* sb_ = smem + (buf) * 65536 + tidx * 16;                              \
    const size_t ko_ = (size_t)(kt) * 64;                                      \
    GLL(Wg0 + ko_, sb_);               GLL(Wg1 + ko_, sb_ + 8192);             \
    GLL(Wg0 + hk + ko_, sb_ + 16384);  GLL(Wg1 + hk + ko_, sb_ + 24576);       \
    GLL(Xg0 + ko_, sb_ + 32768);       GLL(Xg1 + ko_, sb_ + 40960);            \
    GLL(Xg0 + hk + ko_, sb_ + 49152);  GLL(Xg1 + hk + ko_, sb_ + 57344);       \
  }
  const int ob = fr * 64 + fq * 16;
  const int lane_off = ob ^ (((ob >> 9) & 1) << 5);
  const char* aBase = smem + wr * 16384 + lane_off;
  const char* bBase = smem + 32768 + (wc >> 1) * 16384 + (wc & 1) * 8192 + lane_off;
  const int nt = K / 64;
  STAGE_ALL(0, 0);
  for (int kt = 0; kt < nt; ++kt) {
    asm volatile("s_waitcnt vmcnt(0)" ::: "memory");
    __builtin_amdgcn_s_barrier();
    if (kt + 1 < nt) STAGE_ALL((kt + 1) & 1, kt + 1);
    const char* ab = aBase + (kt & 1) * 65536;
    const char* bb = bBase + (kt & 1) * 65536;
#pragma unroll
    for (int ks = 0; ks < 2; ++ks) {
      bf16x8 a[8], b[4];
#pragma unroll
      for (int m = 0; m < 8; ++m) a[m] = *(const bf16x8*)(ab + (m * 2 + ks) * 1024);
#pragma unroll
      for (int n = 0; n < 4; ++n) b[n] = *(const bf16x8*)(bb + (n * 2 + ks) * 1024);
#pragma unroll
      for (int m = 0; m < 8; ++m)
#pragma unroll
        for (int n = 0; n < 4; ++n) acc[m][n] = mfma16(a[m], b[n], acc[m][n]);
    }
  }
#undef GLL
#undef STAGE_ALL
  if (!dry) {
    f32x4 (&lo)[4][4] = *reinterpret_cast<f32x4 (*)[4][4]>(&acc[0]);
    f32x4 (&hi)[4][4] = *reinterpret_cast<f32x4 (*)[4][4]>(&acc[4]);
    epi(f0 + wr * 128, t0 + wc * 64, lo);
    epi(f0 + wr * 128 + 64, t0 + wc * 64, hi);
  }
}


template <class Epi>
DI void gemm_tile8p(const bf16_t* __restrict__ A, const bf16_t* __restrict__ Bt, int K, int brow, int bcol, char* smem, const Epi& epi, bool dry = false) {
  bf16_t* shm = (bf16_t*)smem;
  #define SA(b,h) (shm+((b)*2+(h))*G_HT)
  #define SB(b,h) (shm+(4+(b)*2+(h))*G_HT)
  #define STAGE(P,BASE,br,kt) do{long _g=(long)(br)*K+(long)(kt)*G_BK; \
    for(int _i=0;_i<2;++_i){int _b=tidx*16+_i*8192;int _r,_c;g_stage_rc(_b,_r,_c); \
      __builtin_amdgcn_global_load_lds((const unsigned*)(BASE+_g+(long)_r*K+_c), \
        (__attribute__((address_space(3))) unsigned*)((char*)(P)+_b),16,0,0);}}while(0)
  #define LDA(dst,b,h) for(int m=0;m<4;++m)for(int k=0;k<2;++k) \
    dst[m][k]=*reinterpret_cast<const bf16x8*>((char*)SA(b,h)+g_lds_byte(wr*64+m*16+fr,k*32+fq*8))
  #define LDB(dst,b,h) for(int n=0;n<2;++n)for(int k=0;k<2;++k) \
    dst[n][k]=*reinterpret_cast<const bf16x8*>((char*)SB(b,h)+g_lds_byte(wc*32+n*16+fr,k*32+fq*8))
  #define MMA(ai,bj,At,Bt_) do{__builtin_amdgcn_s_setprio(1); \
    for(int m=0;m<4;++m)for(int n=0;n<2;++n)for(int k=0;k<2;++k) \
      acc[ai][bj][m][n]=__builtin_amdgcn_mfma_f32_16x16x32_bf16(At[m][k],Bt_[n][k],acc[ai][bj][m][n],0,0,0); \
    __builtin_amdgcn_s_setprio(0);}while(0)
  #define WAIT_V(n) asm volatile("s_waitcnt vmcnt(" #n ")":::"memory")
  #define WAIT_L(n) asm volatile("s_waitcnt lgkmcnt(" #n ")":::"memory")
  #define BAR __builtin_amdgcn_s_barrier()
  #define SCHED __builtin_amdgcn_sched_barrier(0)
  const int tidx = otid();
  const int wid=tidx>>6,lane=tidx&63,wr=wid>>2,wc=wid&3,fr=lane&15,fq=lane>>4;
  f32x4 acc[2][2][4][2]={};
  bf16x8 At[4][2],B0[2][2],B1[2][2];
  const int nt=K/G_BK;
  asm volatile("s_waitcnt vmcnt(0) lgkmcnt(0)" ::: "memory");
  __syncthreads();
  STAGE(SB(0,0),Bt,bcol,0); STAGE(SA(0,0),A,brow,0);
  STAGE(SB(0,1),Bt,bcol+G_HALF,0); STAGE(SA(0,1),A,brow+G_HALF,0);
  if(wr==1)BAR;
  WAIT_V(4); BAR;
  STAGE(SB(1,0),Bt,bcol,1); STAGE(SA(1,0),A,brow,1); STAGE(SB(1,1),Bt,bcol+G_HALF,1);
  WAIT_V(6); BAR;
  for(int t=0;t<nt-2;t+=2){
    LDB(B0,0,0); SCHED; LDA(At,0,0); STAGE(SA(1,1),A,brow+G_HALF,t+1);
    WAIT_L(8); BAR; WAIT_L(0); MMA(0,0,At,B0); BAR; SCHED;
    LDB(B1,0,1); STAGE(SB(0,0),Bt,bcol,t+2);
    BAR; WAIT_L(0); MMA(0,1,At,B1); BAR;
    LDA(At,0,1); STAGE(SA(0,0),A,brow,t+2);
    BAR; WAIT_L(0); MMA(1,0,At,B0); BAR; SCHED;
    STAGE(SB(0,1),Bt,bcol+G_HALF,t+2);
    WAIT_V(6); BAR; MMA(1,1,At,B1); BAR;
    LDB(B0,1,0); SCHED; LDA(At,1,0); STAGE(SA(0,1),A,brow+G_HALF,t+2);
    WAIT_L(8); BAR; WAIT_L(0); MMA(0,0,At,B0); BAR; SCHED;
    LDB(B1,1,1); STAGE(SB(1,0),Bt,bcol,t+3);
    BAR; WAIT_L(0); MMA(0,1,At,B1); BAR;
    LDA(At,1,1); STAGE(SA(1,0),A,brow,t+3);
    BAR; WAIT_L(0); MMA(1,0,At,B0); BAR; SCHED;
    STAGE(SB(1,1),Bt,bcol+G_HALF,t+3);
    WAIT_V(6); BAR; MMA(1,1,At,B1); BAR;
  }
  { LDB(B0,0,0); LDA(At,0,0); STAGE(SA(1,1),A,brow+G_HALF,nt-1);
    BAR; WAIT_L(0); MMA(0,0,At,B0); BAR;
    LDB(B1,0,1); BAR; WAIT_L(0); MMA(0,1,At,B1); BAR;
    LDA(At,0,1); WAIT_V(4); BAR; WAIT_L(0); MMA(1,0,At,B0); MMA(1,1,At,B1); BAR; }
  { LDB(B0,1,0); LDA(At,1,0); WAIT_V(2); BAR; WAIT_L(0); MMA(0,0,At,B0); BAR;
    LDB(B1,1,1); WAIT_V(0); BAR; WAIT_L(0); MMA(0,1,At,B1); BAR;
    LDA(At,1,1); BAR; WAIT_L(0); MMA(1,0,At,B0); MMA(1,1,At,B1); BAR; }
  if(wr==0)BAR;
  if (!dry) {
#pragma unroll
    for(int ai=0;ai<2;++ai)
#pragma unroll
      for(int bj=0;bj<2;++bj) epi(brow+ai*G_HALF+wr*64, bcol+bj*G_HALF+wc*32, acc[ai][bj]);
  }
  #undef SA
  #undef SB
  #undef STAGE
  #undef LDA
  #undef LDB
  #undef MMA
  #undef WAIT_V
  #undef WAIT_L
  #undef BAR
  #undef SCHED
}

template <class Epi>
DI void gemm_phase256(const bf16_t* W, const bf16_t* X, int K, int NF, int NTK, char* smem, const Epi& epi, bool dry = false) {
  TileWalk tw(NF / 256, NTK / 256);
  int ft, tt;
  while (tw.next(ft, tt)) gemm_tile8p(W, X, K, ft * 256, tt * 256, smem, epi, dry);
}

struct EpiMlaIn {
  bf16_t *cq, *ckv, *kp, *sg; const float2* rope; float* rss;
  template <int NTI> DI void operator()(int f0, int t0, f32x4 (&acc)[4][NTI]) const {
    const int lane = otid() & 63, lr = lane & 15, lq = lane >> 4;
    if (f0 >= 1728) return;
    if (f0 == 640) {
#pragma unroll
      for (int ti = 0; ti < NTI; ++ti) {
        const int tok = t0 + ti * 16 + lr;
        const bool lat = tok < NLAT;
        const int pos = tok & 4095;
#pragma unroll
        for (int fi = 0; fi < 2; ++fi) {
          float o1[4], o2[4];
#pragma unroll
          for (int j = 0; j < 4; ++j) {
            const int d = fi * 16 + 4 * lq + j;
            float x1 = acc[fi][ti][j], x2 = acc[fi + 2][ti][j];
            if (lat) { float2 cs = rope[pos * 32 + d]; o1[j] = x1 * cs.x - x2 * cs.y; o2[j] = x1 * cs.y + x2 * cs.x; }
            else { o1[j] = x1; o2[j] = x2; }
          }
          const int d0 = fi * 16 + 4 * lq;
#pragma unroll
          for (int h = 0; h < 8; ++h) {
            bf16_t* base = kp + ((size_t)tok * 8 + h) * 192 + 128;
            store4bf(base + d0, o1[0], o1[1], o1[2], o1[3]);
            store4bf(base + 32 + d0, o2[0], o2[1], o2[2], o2[3]);
          }
        }
      }
      return;
    }
    if (f0 < 640) {
#pragma unroll
      for (int ti = 0; ti < NTI; ++ti) {
        const int tok = t0 + ti * 16 + lr;
        float ss = 0.f;
#pragma unroll
        for (int fi = 0; fi < 4; ++fi) {
          const int f = f0 + fi * 16 + 4 * lq;
          f32x4 v = acc[fi][ti];
          ss += v[0] * v[0] + v[1] * v[1] + v[2] * v[2] + v[3] * v[3];
          if (f0 < 384) store4bf(cq + (size_t)tok * 384 + f, v[0], v[1], v[2], v[3]);
          else store4bf(ckv + (size_t)tok * 256 + (f - 384), v[0], v[1], v[2], v[3]);
        }
        ss += __shfl_xor(ss, 16, 64);
        ss += __shfl_xor(ss, 32, 64);
        if (lq == 0) atomicAdd(rss + (f0 < 384 ? 0 : NTOK) + tok, ss);
      }
      return;
    }
#pragma unroll
    for (int fi = 0; fi < 4; ++fi)
#pragma unroll
      for (int ti = 0; ti < NTI; ++ti) {
        const int tok = t0 + ti * 16 + lr;
        const int f = f0 + fi * 16 + 4 * lq;
        f32x4 v = acc[fi][ti];
        store4bf(sg + (size_t)tok * 1024 + (f - 704), siluf(v[0]), siluf(v[1]), siluf(v[2]), siluf(v[3]));
      }
  }
};

struct EpiUq {
  bf16_t* q; const float2* rope; const float* rss;
  template <int NTI> DI void operator()(int f0, int t0, f32x4 (&acc)[4][NTI]) const {
    const int lane = otid() & 63, lr = lane & 15, lq = lane >> 4;
    const bool isrope = (f0 % 192) == 128;
#pragma unroll
    for (int ti = 0; ti < NTI; ++ti) {
      const int tok = t0 + ti * 16 + lr;
      const int pos = tok & 4095;
      const float sc = 0.07216878364870322f * LOG2E * rsqrtf(rss[tok] * (1.f / 384.f) + 1e-6f);
      if (isrope && tok < NLAT) {
#pragma unroll
        for (int fi = 0; fi < 2; ++fi) {
          float o1[4], o2[4];
#pragma unroll
          for (int j = 0; j < 4; ++j) {
            const int d = fi * 16 + 4 * lq + j;
            float2 cs = rope[pos * 32 + d];
            float x1 = acc[fi][ti][j], x2 = acc[fi + 2][ti][j];
            o1[j] = (x1 * cs.x - x2 * cs.y) * sc; o2[j] = (x1 * cs.y + x2 * cs.x) * sc;
          }
          bf16_t* base = q + (size_t)tok * 1536 + f0 + fi * 16 + 4 * lq;
          store4bf(base, o1[0], o1[1], o1[2], o1[3]);
          store4bf(base + 32, o2[0], o2[1], o2[2], o2[3]);
        }
      } else {
#pragma unroll
        for (int fi = 0; fi < 4; ++fi) {
          f32x4 v = acc[fi][ti];
          store4bf(q + (size_t)tok * 1536 + f0 + fi * 16 + 4 * lq, v[0] * sc, v[1] * sc, v[2] * sc, v[3] * sc);
        }
      }
    }
  }
};

struct EpiUkv {
  bf16_t *kp, *vt; const float* rss;
  template <int NTI> DI void operator()(int f0, int t0, f32x4 (&acc)[4][NTI]) const {
    const int lane = otid() & 63, lr = lane & 15, lq = lane >> 4;
    const int h = f0 >> 8, r = f0 & 255;
#pragma unroll
    for (int ti = 0; ti < NTI; ++ti) {
      const int tok = t0 + ti * 16 + lr;
      const float rs = rsqrtf(rss[NTOK + tok] * (1.f / 256.f) + 1e-6f);
      if (r < 128) {
#pragma unroll
        for (int fi = 0; fi < 4; ++fi) {
          f32x4 v = acc[fi][ti] * rs;
          store4bf(kp + ((size_t)tok * 8 + h) * 192 + r + fi * 16 + 4 * lq, v[0], v[1], v[2], v[3]);
        }
      } else {
        const int b = tok_batch(tok), key = key_perm(tok_key(tok));
#pragma unroll
        for (int fi = 0; fi < 4; ++fi)
#pragma unroll
          for (int j = 0; j < 4; ++j) {
            const int dv = r - 128 + fi * 16 + 4 * lq + j;
            vt[((size_t)(b * 8 + h) * 128 + dv) * KEYS + key] = f2bf(acc[fi][ti][j] * rs);
          }
      }
    }
  }
};

struct EpiRes {
  const float *sl, *sc; float *xl, *xc; const float* mod; bool dry;
  template <int NTI> DI void operator()(int f0, int t0, f32x4 (&acc)[4][NTI]) const {
    if (dry) return;
    const int lane = otid() & 63, lr = lane & 15, lq = lane >> 4;
#pragma unroll
    for (int ti = 0; ti < NTI; ++ti) {
      const int tok = t0 + ti * 16 + lr;
      const size_t ro = tok < NLAT ? (size_t)tok * 1024 : (size_t)(tok - NLAT) * 1024;
      const float* xs = (tok < NLAT ? sl : sc) + ro;
      float* xr = (tok < NLAT ? xl : xc) + ro;
      const float* g = mod + tok_modrow(tok) * 3072 + 2048;
#pragma unroll
      for (int fi = 0; fi < 4; ++fi) {
        const int f = f0 + fi * 16 + 4 * lq;
        float4 xv = *(const float4*)(xs + f);
        float4 gv = *(const float4*)(g + f);
        f32x4 v = acc[fi][ti];
        xv.x += gv.x * v[0]; xv.y += gv.y * v[1]; xv.z += gv.z * v[2]; xv.w += gv.w * v[3];
        *(float4*)(xr + f) = xv;
      }
    }
  }
};

struct EpiHyIn {
  bf16_t* ut;
  template <int NTI> DI void operator()(int f0, int t0, f32x4 (&acc)[4][NTI]) const {
    const int lane = otid() & 63, lr = lane & 15, lq = lane >> 4;
    const bool gate = f0 >= 3072;
#pragma unroll
    for (int fi = 0; fi < 4; ++fi)
#pragma unroll
      for (int ti = 0; ti < NTI; ++ti) {
        const int tok = t0 + ti * 16 + lr;
#pragma unroll
        for (int j = 0; j < 4; ++j) {
          const int f = f0 + fi * 16 + 4 * lq + j;
          float v = acc[fi][ti][j];
          if (gate) v = siluf(v);
          ut[(size_t)f * NTOK + tok] = f2bf(v);
        }
      }
  }
};

struct EpiSwaIn {
  bf16_t *qs, *ks, *vt, *sg; const float2* rope;
  template <int NTI> DI void operator()(int f0, int t0, f32x4 (&acc)[4][NTI]) const {
    const int lane = otid() & 63, lr = lane & 15, lq = lane >> 4;
    const float sc = 0.125f * LOG2E;
#pragma unroll
    for (int ti = 0; ti < NTI; ++ti) {
      const int tok = t0 + ti * 16 + lr;
      const int pos = tok & 4095;
      if (f0 < 1280) {
        const bool isq = f0 < 1024;
        const float s = isq ? sc : 1.f;
        bf16_t* dst = isq ? qs + (size_t)tok * 1024 + f0 : ks + (size_t)tok * 256 + (f0 - 1024);
#pragma unroll
        for (int fi = 0; fi < 2; ++fi) {
          float o1[4], o2[4];
#pragma unroll
          for (int j = 0; j < 4; ++j) {
            const int d = fi * 16 + 4 * lq + j;
            float x1 = acc[fi][ti][j], x2 = acc[fi + 2][ti][j];
            if (tok < NLAT) { float2 cs = rope[pos * 32 + d]; o1[j] = (x1 * cs.x - x2 * cs.y) * s; o2[j] = (x1 * cs.y + x2 * cs.x) * s; }
            else { o1[j] = x1 * s; o2[j] = x2 * s; }
          }
          store4bf(dst + fi * 16 + 4 * lq, o1[0], o1[1], o1[2], o1[3]);
          store4bf(dst + 32 + fi * 16 + 4 * lq, o2[0], o2[1], o2[2], o2[3]);
        }
      } else if (f0 < 1536) {
        const int g = (f0 - 1280) >> 6;
        const int b = tok_batch(tok), key = key_perm(tok_key(tok));
#pragma unroll
        for (int fi = 0; fi < 4; ++fi)
#pragma unroll
          for (int j = 0; j < 4; ++j) {
            const int dv = fi * 16 + 4 * lq + j;
            vt[((size_t)(b * 4 + g) * 64 + dv) * KEYS + key] = f2bf(acc[fi][ti][j]);
          }
      } else {
#pragma unroll
        for (int fi = 0; fi < 4; ++fi) {
          f32x4 v = acc[fi][ti];
          store4bf(sg + (size_t)tok * 1024 + (f0 - 1536) + fi * 16 + 4 * lq, siluf(v[0]), siluf(v[1]), siluf(v[2]), siluf(v[3]));
        }
      }
    }
  }
};

struct EpiCfIn {
  bf16_t *u3, *sg;
  template <int NTI> DI void operator()(int f0, int t0, f32x4 (&acc)[4][NTI]) const {
    const int lane = otid() & 63, lr = lane & 15, lq = lane >> 4;
#pragma unroll
    for (int ti = 0; ti < NTI; ++ti) {
      const int tok = t0 + ti * 16 + lr;
      if (f0 < 2048) {
        const int c0 = (f0 >> 6) * 32;
#pragma unroll
        for (int fi = 0; fi < 2; ++fi) {
          f32x4 a = acc[fi][ti], b = acc[fi + 2][ti];
          store4bf(u3 + (size_t)tok * 1024 + c0 + fi * 16 + 4 * lq, a[0] * sigmf(b[0]), a[1] * sigmf(b[1]), a[2] * sigmf(b[2]), a[3] * sigmf(b[3]));
        }
      } else {
#pragma unroll
        for (int fi = 0; fi < 4; ++fi) {
          f32x4 v = acc[fi][ti];
          store4bf(sg + (size_t)tok * 1024 + (f0 - 2048) + fi * 16 + 4 * lq, siluf(v[0]), siluf(v[1]), siluf(v[2]), siluf(v[3]));
        }
      }
    }
  }
};

template <int MODE>
DI void transpose_w(const float* __restrict__ src, int K, int N, bf16_t* __restrict__ dst, char* smem, const float* __restrict__ kscale = nullptr) {
  float* tile = (float*)smem;
  const int tid = otid();
  const int nkt = K / 64, nnt = N / 64;
  for (int t = blockIdx.x; t < nkt * nnt; t += gridDim.x) {
    const int k0 = (t % nkt) * 64, n0 = (t / nkt) * 64;
    __syncthreads();
#pragma unroll
    for (int i = 0; i < 8; ++i) {
      const int e = tid + NT * i, kk = e >> 6, nn = e & 63;
      tile[kk * 65 + nn] = src[(size_t)(k0 + kk) * N + n0 + nn] * (kscale ? kscale[k0 + kk] : 1.f);
    }
    __syncthreads();
    const int nn = tid >> 3, kc = tid & 7;
    int n = n0 + nn;
    if (MODE == 1) {
      if (n < 1024) n = (n >> 5) * 64 + (n & 31);
      else if (n < 2048) { const int c = n - 1024; n = (c >> 5) * 64 + 32 + (c & 31); }
    }
    uint4 v;
    v.x = pack2(tile[(kc * 8 + 0) * 65 + nn], tile[(kc * 8 + 1) * 65 + nn]);
    v.y = pack2(tile[(kc * 8 + 2) * 65 + nn], tile[(kc * 8 + 3) * 65 + nn]);
    v.z = pack2(tile[(kc * 8 + 4) * 65 + nn], tile[(kc * 8 + 5) * 65 + nn]);
    v.w = pack2(tile[(kc * 8 + 6) * 65 + nn], tile[(kc * 8 + 7) * 65 + nn]);
    *(uint4*)(dst + (size_t)n * K + k0 + kc * 8) = v;
  }
  __syncthreads();
}

DI void phase0(const P& p, char* smem) {
  const int tid = otid(), lane = tid & 63, wave = tid >> 6;
  unsigned char* ws = p.ws;
  transpose_w<0>(p.in[8], 1024, 1728, (bf16_t*)(ws + O_W_MLA_IN), smem);
  for (size_t i = (size_t)blockIdx.x * NT + tid; i < (size_t)64 * 1024 / 2; i += (size_t)gridDim.x * NT)
    ((unsigned*)(ws + O_W_MLA_IN + (size_t)1728 * 1024 * 2))[i] = 0u;
  transpose_w<0>(p.in[11], 384, 1536, (bf16_t*)(ws + O_W_UQ), smem, p.in[9]);
  transpose_w<0>(p.in[12], 256, 2048, (bf16_t*)(ws + O_W_UKV), smem, p.in[10]);
  for (int i = blockIdx.x * NT + tid; i < 2 * NTOK; i += gridDim.x * NT) ((float*)(ws + O_RSS))[i] = 0.f;
  transpose_w<0>(p.in[13], 1024, 1024, (bf16_t*)(ws + O_W_MLA_OUT), smem);
  transpose_w<0>(p.in[14], 1024, 4096, (bf16_t*)(ws + O_W_HY_IN), smem);
  transpose_w<0>(p.in[23], 1024, 1024, (bf16_t*)(ws + O_W_HY_OUT), smem);
  transpose_w<0>(p.in[24], 1024, 2560, (bf16_t*)(ws + O_W_SWA_IN), smem);
  transpose_w<0>(p.in[26], 1024, 1024, (bf16_t*)(ws + O_W_SWA_OUT), smem);
  transpose_w<1>(p.in[27], 1024, 3072, (bf16_t*)(ws + O_W_CF_IN), smem);
  transpose_w<0>(p.in[32], 1024, 1024, (bf16_t*)(ws + O_W_CF_OUT), smem);
  {
    float* sS = (float*)smem;
    float* red = sS + 5 * 1024;
    __syncthreads();
    for (int i = tid; i < 5 * 1024; i += NT) {
      const int r = i >> 10, k = i & 1023;
      const float v = r < 4 ? p.in[1][r * 1024 + k] : p.in[3][k];
      sS[i] = siluf(v);
    }
    __syncthreads();
    float* mod = (float*)(ws + O_MOD);
    for (int it = blockIdx.x; it < 4 * 48; it += gridDim.x) {
      const int layer = it / 48, col = (it % 48) * 64 + lane;
      const float* w = p.in[5] + ((size_t)layer * 1024 + wave * 128) * 3072 + col;
      float a0 = 0, a1 = 0, a2 = 0, a3 = 0, a4 = 0;
#pragma unroll 8
      for (int k = 0; k < 128; ++k) {
        const float wv = w[(size_t)k * 3072];
        const int kk = wave * 128 + k;
        a0 += sS[kk] * wv; a1 += sS[1024 + kk] * wv; a2 += sS[2048 + kk] * wv; a3 += sS[3072 + kk] * wv; a4 += sS[4096 + kk] * wv;
      }
      red[(wave * 5 + 0) * 64 + lane] = a0; red[(wave * 5 + 1) * 64 + lane] = a1; red[(wave * 5 + 2) * 64 + lane] = a2;
      red[(wave * 5 + 3) * 64 + lane] = a3; red[(wave * 5 + 4) * 64 + lane] = a4;
      __syncthreads();
      if (tid < 320) {
        const int r = tid >> 6, c = tid & 63;
        float s = 0;
#pragma unroll
        for (int w8 = 0; w8 < 8; ++w8) s += red[(w8 * 5 + r) * 64 + c];
        const int cc = (it % 48) * 64 + c;
        mod[(layer * 5 + r) * 3072 + cc] = s + p.in[6][layer * 3072 + cc];
      }
      __syncthreads();
    }
  }
  {
    float2* rope = (float2*)(ws + O_ROPE);
    for (int i = blockIdx.x * NT + tid; i < 4096 * 32; i += gridDim.x * NT) {
      const int pos = i >> 5, d = i & 31;
      const float inv = exp2f(-(float)(d & 15) * (13.287712379549449f / 16.f));
      const float ang = (float)(d < 16 ? (pos >> 6) : (pos & 63)) * inv;
      float s, c; sincosf(ang, &s, &c);
      rope[i] = make_float2(c, s);
    }
  }
  {
    float* swin = (float*)smem;
    float* swh = swin + 33 * 64;
    float* shall = swh + 2 * 64 * 64;
    float* sh = shall + wave * 64;
    const float* fb = p.in[19];
    const float* ff = p.in[20];
    __syncthreads();
    for (int i = tid; i < 33 * 64; i += NT) swin[i] = p.in[17][i];
    for (int i = tid; i < 2 * 64 * 64; i += NT) swh[i] = p.in[18][i];
    __syncthreads();
    const float f0 = ff[lane], f1 = ff[64 + lane], f2 = ff[128 + lane], b0 = fb[lane], b1 = fb[64 + lane], b2 = fb[128 + lane];
    for (int item = blockIdx.x * 8 + wave; item < SEQ + LCTX; item += gridDim.x * 8) {
      const bool isc = item >= SEQ;
      const int t = isc ? item - SEQ : item;
      const int Lf = isc ? LCTX : SEQ;
      const float tl = (float)t / (float)(Lf - 1);
      const float wpos = (6.283185307179586f / (float)Lf) * (float)t;
      float e = 0.f;
      if (lane == 0) e = tl;
      else if (lane < 33) {
        const int kb = (lane - 1) & 15;
        const float band = 1e-4f + (float)kb * ((15.f - 1e-4f) / 15.f);
        const float a = band * wpos;
        e = lane < 17 ? cosf(a) : -sinf(a);
      }
      sh[lane] = e;
      __builtin_amdgcn_wave_barrier();
      float acc = 0.f;
#pragma unroll 11
      for (int i = 0; i < 33; ++i) acc += sh[i] * swin[i * 64 + lane];
      float hv = sinf(f0 * (acc + b0));
      __builtin_amdgcn_wave_barrier();
      sh[lane] = hv;
      __builtin_amdgcn_wave_barrier();
      acc = 0.f;
#pragma unroll 16
      for (int i = 0; i < 64; ++i) acc += sh[i] * swh[i * 64 + lane];
      hv = sinf(f1 * (acc + b1));
      __builtin_amdgcn_wave_barrier();
      sh[lane] = hv;
      __builtin_amdgcn_wave_barrier();
      acc = 0.f;
#pragma unroll 16
      for (int i = 0; i < 64; ++i) acc += sh[i] * swh[4096 + i * 64 + lane];
      hv = sinf(f2 * (acc + b2));
      __builtin_amdgcn_wave_barrier();
      if (isc) ((float*)(ws + O_HDNC))[lane * LCTX + t] = hv;
      else { ((float*)(ws + O_HDN))[lane * SEQ + t] = hv; ((bf16_t*)(ws + O_HDNB))[t * 64 + lane] = f2bf(hv); }
    }
    __syncthreads();
  }
}

DI void phase_norm(const P& p, int layer, int ntok) {
  const int lane = otid() & 63, wave = otid() >> 6;
  const float* xc = layer == 0 ? p.in[2] : (const float*)(p.ws + O_XC);
  const float* xlat = layer == 0 ? p.in[0] : p.out;
  const float* mod = (const float*)(p.ws + O_MOD) + layer * 5 * 3072;
  const float* g = p.in[4] + layer * 1024;
  bf16_t* act = (bf16_t*)(p.ws + O_ACT);
  for (int row0 = (blockIdx.x * 8 + wave) * 4; row0 < ntok; row0 += gridDim.x * 32) {
    f32x4 v[4][4];
#pragma unroll
    for (int r = 0; r < 4; ++r) {
      const int row = row0 + r;
      const float* x = row < NLAT ? xlat + (size_t)row * 1024 : xc + (size_t)(row - NLAT) * 1024;
#pragma unroll
      for (int i = 0; i < 4; ++i) v[r][i] = ((const f32x4*)x)[lane + 64 * i];
    }
    const float* m = mod + tok_modrow(row0) * 3072;
#pragma unroll
    for (int r = 0; r < 4; ++r) {
      float ss = 0.f;
#pragma unroll
      for (int i = 0; i < 4; ++i) ss += v[r][i].x * v[r][i].x + v[r][i].y * v[r][i].y + v[r][i].z * v[r][i].z + v[r][i].w * v[r][i].w;
      ss = wave_sum(ss);
      const float rstd = rsqrtf(ss * (1.f / 1024.f) + 1e-6f);
#pragma unroll
      for (int i = 0; i < 4; ++i) {
        const int c = (lane + 64 * i) * 4;
        const f32x4 gv = *(const f32x4*)(g + c), sh = *(const f32x4*)(m + c), sc = *(const f32x4*)(m + 1024 + c);
        store4bf(act + (size_t)(row0 + r) * 1024 + c, v[r][i].x * rstd * gv.x * (1.f + sc.x) + sh.x, v[r][i].y * rstd * gv.y * (1.f + sc.y) + sh.y,
                 v[r][i].z * rstd * gv.z * (1.f + sc.z) + sh.z, v[r][i].w * rstd * gv.w * (1.f + sc.w) + sh.w);
      }
    }
  }
}

template <int PER>
DI void small_norm(bf16_t* buf, const float* g) {
  const int lane = otid() & 63, wave = otid() >> 6;
  for (int row = blockIdx.x * 8 + wave; row < NTOK; row += gridDim.x * 8) {
    bf16_t* r = buf + (size_t)row * (64 * PER);
    float v[PER]; float ss = 0.f;
#pragma unroll
    for (int i = 0; i < PER; ++i) { v[i] = bf2f(r[lane + 64 * i]); ss += v[i] * v[i]; }
    ss = wave_sum(ss);
    const float rstd = rsqrtf(ss / (float)(64 * PER) + 1e-6f);
#pragma unroll
    for (int i = 0; i < PER; ++i) r[lane + 64 * i] = f2bf(v[i] * rstd * g[lane + 64 * i]);
  }
}

DI void phase_final(const P& p) {
  const int lane = otid() & 63, wave = otid() >> 6;
  const float* g = p.in[7];
  for (int row = blockIdx.x * 8 + wave; row < NLAT; row += gridDim.x * 8) {
    float* x = p.out + (size_t)row * 1024;
    f32x4 v[4]; float ss = 0.f;
#pragma unroll
    for (int i = 0; i < 4; ++i) { v[i] = ((const f32x4*)x)[lane + 64 * i]; ss += v[i].x * v[i].x + v[i].y * v[i].y + v[i].z * v[i].z + v[i].w * v[i].w; }
    ss = wave_sum(ss);
    const float rstd = rsqrtf(ss * (1.f / 1024.f) + 1e-6f);
#pragma unroll
    for (int i = 0; i < 4; ++i) {
      const int c = (lane + 64 * i) * 4;
      const float4 gv = *(const float4*)(g + c);
      float4 o; o.x = v[i].x * rstd * gv.x; o.y = v[i].y * rstd * gv.y; o.z = v[i].z * rstd * gv.z; o.w = v[i].w * rstd * gv.w;
      ((float4*)x)[lane + 64 * i] = o;
    }
  }
}

struct AttnItem {
  const bf16_t* Kbase; int kld;
  const bf16_t* Vt;
  int b; int a0, n1, n2;
  const bf16_t* Q; int qld;
  int qtok0; int qpos0;
  float minit, linit;
  bf16_t* og; int ocol;
  bool dry;
};

template <int DQK, int DV, bool MASK>
DI void attn_item(const AttnItem& a, char* smem) {
  constexpr int NKS = DQK / 32, NDB = DV / 16;
  constexpr int KBYTES = 64 * DQK * 2, VBYTES = DV * 64 * 2, STG = KBYTES + VBYTES;
  constexpr int KCH = KBYTES / 8192, VCH = VBYTES / 8192;
  const int tid = otid(), lane = tid & 63, lr = lane & 15, lq = lane >> 4;
  bf16x8 qf[2][NKS];
#pragma unroll
  for (int nb = 0; nb < 2; ++nb)
#pragma unroll
    for (int ks = 0; ks < NKS; ++ks) qf[nb][ks] = *(const bf16x8*)(a.Q + (size_t)(nb * 16 + lr) * a.qld + ks * 32 + lq * 8);
  f32x4 o[NDB][2];
#pragma unroll
  for (int i = 0; i < NDB; ++i) { o[i][0] = (f32x4){0.f, 0.f, 0.f, 0.f}; o[i][1] = (f32x4){0.f, 0.f, 0.f, 0.f}; }
  float m[2] = {a.minit, a.minit};
  float l[2] = {lq == 0 ? a.linit : 0.f, lq == 0 ? a.linit : 0.f};
  int kR[KCH], kC[KCH], vOff[VCH];
#pragma unroll
  for (int c = 0; c < KCH; ++c) {
    const int bb = tid * 16 + c * 8192, st = bb >> 10, sb = bb & 1023, swz = sb ^ (((sb >> 9) & 1) << 5);
    kR[c] = (st / NKS) * 16 + (swz >> 6); kC[c] = (st % NKS) * 32 + ((swz & 63) >> 1);
  }
#pragma unroll
  for (int c = 0; c < VCH; ++c) {
    const int bb = tid * 16 + c * 8192, st = bb >> 10, sb = bb & 1023, swz = sb ^ (((sb >> 9) & 1) << 5);
    vOff[c] = ((st >> 1) * 16 + (swz >> 6)) * KEYS + (st & 1) * 32 + ((swz & 63) >> 1);
  }
  const int ntile = a.n1 + a.n2;
#define ATT_STAGE(buf, i)                                                                                     \
  {                                                                                                           \
    const int kt_ = (i) < a.n1 ? a.a0 + (i) : 64 + ((i) - a.n1);                                              \
    const int key0_ = kt_ * 64;                                                                               \
    const int tokb_ = key0_ < SEQ ? a.b * SEQ + key0_ : NLAT + a.b * LCTX + (key0_ - SEQ);                    \
    char* sb_ = smem + (buf) * STG + tid * 16;                                                                \
    _Pragma("unroll") for (int c = 0; c < KCH; ++c)                                                           \
      __builtin_amdgcn_global_load_lds((const unsigned*)(a.Kbase + (size_t)(tokb_ + kR[c]) * a.kld + kC[c]),  \
                                       (__attribute__((address_space(3))) unsigned*)(sb_ + c * 8192), 16, 0, 0); \
    _Pragma("unroll") for (int c = 0; c < VCH; ++c)                                                           \
      __builtin_amdgcn_global_load_lds((const unsigned*)(a.Vt + vOff[c] + key0_),                             \
                                       (__attribute__((address_space(3))) unsigned*)(sb_ + KBYTES + c * 8192), 16, 0, 0); \
  }
  const int ob = lr * 64 + lq * 16;
  const int lane_off = ob ^ (((ob >> 9) & 1) << 5);
  __syncthreads();
  ATT_STAGE(0, 0);
  for (int it = 0; it < ntile; ++it) {
    asm volatile("s_waitcnt vmcnt(0)" ::: "memory");
    __builtin_amdgcn_s_barrier();
    if (it + 1 < ntile) ATT_STAGE((it + 1) & 1, it + 1);
    const char* sK = smem + (it & 1) * STG + lane_off;
    const char* sV = sK + KBYTES;
    f32x4 s[4][2];
#pragma unroll
    for (int kb = 0; kb < 4; ++kb) { s[kb][0] = (f32x4){0.f, 0.f, 0.f, 0.f}; s[kb][1] = (f32x4){0.f, 0.f, 0.f, 0.f}; }
#pragma unroll
    for (int ks = 0; ks < NKS; ++ks)
#pragma unroll
      for (int kb = 0; kb < 4; ++kb) {
        const bf16x8 kf = *(const bf16x8*)(sK + (kb * NKS + ks) * 1024);
        s[kb][0] = mfma16(kf, qf[0][ks], s[kb][0]);
        s[kb][1] = mfma16(kf, qf[1][ks], s[kb][1]);
      }
    if (MASK) {
      const int kt = it < a.n1 ? a.a0 + it : 64;
      const int dq = kt - (a.qpos0 >> 6);
      if (kt < 64 && (dq <= -2 || dq >= 2)) {
#pragma unroll
        for (int nb = 0; nb < 2; ++nb) {
          const int qp = a.qpos0 + nb * 16 + lr;
#pragma unroll
          for (int kb = 0; kb < 4; ++kb)
#pragma unroll
            for (int j = 0; j < 4; ++j) {
              const int kp = kt * 64 + kb * 16 + 4 * lq + j;
              const int dlt = kp - qp;
              if (dlt > 128 || dlt < -128) s[kb][nb][j] = -INFINITY;
            }
        }
      }
    }
    bf16x8 pf[2][2];
#pragma unroll
    for (int nb = 0; nb < 2; ++nb) {
      float mx = -INFINITY;
#pragma unroll
      for (int kb = 0; kb < 4; ++kb)
#pragma unroll
        for (int j = 0; j < 4; ++j) mx = fmaxf(mx, s[kb][nb][j]);
      mx = fmaxf(mx, __shfl_xor(mx, 16, 64));
      mx = fmaxf(mx, __shfl_xor(mx, 32, 64));
      const float mn = fmaxf(m[nb], mx);
      const float alpha = __builtin_amdgcn_exp2f(m[nb] - mn);
      m[nb] = mn;
      float rs = 0.f;
      float pv[4][4];
#pragma unroll
      for (int kb = 0; kb < 4; ++kb)
#pragma unroll
        for (int j = 0; j < 4; ++j) { pv[kb][j] = __builtin_amdgcn_exp2f(s[kb][nb][j] - mn); rs += pv[kb][j]; }
      l[nb] = l[nb] * alpha + rs;
#pragma unroll
      for (int st = 0; st < 2; ++st) {
        u32x4 u;
        u.x = pack2(pv[2 * st][0], pv[2 * st][1]); u.y = pack2(pv[2 * st][2], pv[2 * st][3]);
        u.z = pack2(pv[2 * st + 1][0], pv[2 * st + 1][1]); u.w = pack2(pv[2 * st + 1][2], pv[2 * st + 1][3]);
        pf[nb][st] = __builtin_bit_cast(bf16x8, u);
      }
      if (__builtin_amdgcn_ballot_w64(alpha != 1.f) != 0ull) {
#pragma unroll
        for (int db = 0; db < NDB; ++db) { o[db][nb][0] *= alpha; o[db][nb][1] *= alpha; o[db][nb][2] *= alpha; o[db][nb][3] *= alpha; }
      }
    }
#pragma unroll
    for (int st = 0; st < 2; ++st)
#pragma unroll
      for (int db = 0; db < NDB; ++db) {
        const bf16x8 vf = *(const bf16x8*)(sV + (db * 2 + st) * 1024);
        o[db][0] = mfma16(vf, pf[0][st], o[db][0]);
        o[db][1] = mfma16(vf, pf[1][st], o[db][1]);
      }
  }
#undef ATT_STAGE
  if (a.dry) return;
#pragma unroll
  for (int nb = 0; nb < 2; ++nb) {
    float lt = l[nb];
    lt += __shfl_xor(lt, 16, 64);
    lt += __shfl_xor(lt, 32, 64);
    const float inv = 1.f / lt;
    const int tok = a.qtok0 + nb * 16 + lr;
#pragma unroll
    for (int db = 0; db < NDB; ++db) {
      bf16_t* dst = a.og + (size_t)tok * 1024 + a.ocol + db * 16 + 4 * lq;
      const uint2 g = *(const uint2*)dst;
      const float g0 = __uint_as_float(g.x << 16), g1 = __uint_as_float(g.x & 0xffff0000u);
      const float g2 = __uint_as_float(g.y << 16), g3 = __uint_as_float(g.y & 0xffff0000u);
      store4bf(dst, o[db][nb][0] * inv * g0, o[db][nb][1] * inv * g1, o[db][nb][2] * inv * g2, o[db][nb][3] * inv * g3);
    }
  }
}

DI void phase_mla_attn(const P& p, char* smem, bool dry) {
  const int wave = otid() >> 6;
  const bf16_t* q = (const bf16_t*)(p.ws + O_Q);
  const bf16_t* kp = (const bf16_t*)(p.ws + O_KP);
  const bf16_t* vt = (const bf16_t*)(p.ws + O_ACT);
  bf16_t* og = (bf16_t*)(p.ws + O_SG0);
  const int xcd = blockIdx.x & 7, lb = blockIdx.x >> 3, nlb = (gridDim.x - xcd + 7) >> 3;
  for (int li = lb; li < 68; li += nlb) {
    AttnItem a;
    int b, h, qtok;
    if (li < 64) { const int pair = (li >> 4) * 8 + xcd; b = pair >> 3; h = pair & 7; qtok = b * SEQ + (li & 15) * 256; a.a0 = 0; a.n1 = 64; }
    else { const int pair = (li - 64) * 8 + xcd; b = pair >> 3; h = pair & 7; qtok = NLAT + b * LCTX; a.a0 = 0; a.n1 = 0; }
    a.n2 = 4; a.b = b;
    a.Kbase = kp + h * 192; a.kld = 1536;
    a.Vt = vt + (size_t)(b * 8 + h) * 128 * KEYS;
    a.qtok0 = qtok + wave * 32; a.qpos0 = 0;
    a.Q = q + (size_t)a.qtok0 * 1536 + h * 192; a.qld = 1536;
    a.minit = -INFINITY; a.linit = 0.f;
    a.og = og; a.ocol = h * 128; a.dry = dry;
    attn_item<192, 128, false>(a, smem);
  }
}

DI void phase_swa_attn(const P& p, char* smem, bool dry) {
  const int wave = otid() >> 6;
  const bf16_t* qs = (const bf16_t*)(p.ws + O_QS);
  const bf16_t* ks = (const bf16_t*)(p.ws + O_KS);
  const bf16_t* vt = (const bf16_t*)(p.ws + O_VT2);
  bf16_t* og = (bf16_t*)(p.ws + O_SG2);
  const float* sink = p.in[25];
  for (int it = blockIdx.x; it < 1024; it += gridDim.x) {
    AttnItem a;
    int b, g, qtok, pos0;
    if (it < 1024) {
      b = it >> 8; g = (it >> 6) & 3; const int qb = it & 63;
      pos0 = qb * 64; qtok = b * SEQ + pos0;
      a.a0 = qb - 2 < 0 ? 0 : qb - 2; const int a1 = qb + 3 > 64 ? 64 : qb + 3; a.n1 = a1 - a.a0;
    } else {
      const int j = it - 1024; b = j >> 4; g = (j >> 2) & 3; pos0 = (j & 3) * 64; qtok = NLAT + b * LCTX + pos0;
      a.a0 = 0; a.n1 = 0;
    }
    const int head = g * 4 + (wave >> 1);
    a.n2 = 4; a.b = b;
    a.Kbase = ks + g * 64; a.kld = 256;
    a.Vt = vt + (size_t)(b * 4 + g) * 64 * KEYS;
    a.qtok0 = qtok + (wave & 1) * 32; a.qpos0 = pos0 + (wave & 1) * 32;
    a.Q = qs + (size_t)a.qtok0 * 1024 + head * 64; a.qld = 1024;
    a.minit = sink[head] * LOG2E; a.linit = 1.f;
    a.og = og; a.ocol = head * 64; a.dry = dry;
    attn_item<64, 64, true>(a, smem);
  }
}

typedef f32x2 c32;
DI c32 cmul(c32 a, c32 b) { return (c32){a.x * b.x - a.y * b.y, a.x * b.y + a.y * b.x}; }
DI c32 cmulc(c32 a, c32 b) { return (c32){a.x * b.x + a.y * b.y, a.y * b.x - a.x * b.y}; }
DI int phys(int i) { return i + (i >> 5); }
DI c32 w16(int k) {
  const float c1 = 0.9238795325112867f, s1 = 0.3826834323650898f, r = 0.7071067811865476f;
  switch (k & 7) {
    case 0: return (c32){1.f, 0.f};
    case 1: return (c32){c1, -s1};
    case 2: return (c32){r, -r};
    case 3: return (c32){s1, -c1};
    case 4: return (c32){0.f, -1.f};
    case 5: return (c32){-s1, -c1};
    case 6: return (c32){-r, -r};
    default: return (c32){-c1, -s1};
  }
}
DI c32 w16g(int m) {
  const c32 w = w16(m & 7);
  return (m & 8) ? (c32){-w.x, -w.y} : w;
}
template <bool ZHI>
DI void r4_fwd(c32& x0, c32& x1, c32& x2, c32& x3, c32 t1, c32 t2, c32 t3) {
  const c32 s02 = ZHI ? x0 : x0 + x2, s13 = ZHI ? x1 : x1 + x3, d02 = ZHI ? x0 : x0 - x2, d13 = ZHI ? x1 : x1 - x3;
  const c32 e = (c32){d13.y, -d13.x};
  x0 = s02 + s13; x1 = cmul(s02 - s13, t1); x2 = cmul(d02 + e, t2); x3 = cmul(d02 - e, t3);
}
template <bool LOONLY>
DI void r4_inv(c32& x0, c32& x1, c32& x2, c32& x3, c32 t1, c32 t2, c32 t3) {
  const c32 p1 = cmulc(x1, t1), p2 = cmulc(x2, t2), p3 = cmulc(x3, t3);
  const c32 a = x0 + p1, b = x0 - p1, c = p2 + p3, dd = p2 - p3;
  const c32 d = (c32){-dd.y, dd.x};
  x0 = a + c; x1 = b + d;
  if (!LOONLY) { x2 = a - c; x3 = b - d; }
}
template <bool ZHI>
DI void fft16_fwd2(c32 (&v0)[16], c32 (&v1)[16], c32 w1) {
  const c32 w2 = cmul(w1, w1), w3 = cmul(w1, w2), w4 = cmul(w2, w2), w8 = cmul(w4, w4), w48 = cmul(w4, w8);
#pragma unroll
  for (int k = 0; k < 4; ++k) {
    const c32 tB = k ? cmul(w2, w16g(2 * k)) : w2, tA = k ? cmul(w1, w16g(k)) : w1, tAB = k ? cmul(w3, w16g(3 * k)) : w3;
    r4_fwd<ZHI>(v0[k], v0[k + 4], v0[k + 8], v0[k + 12], tB, tA, tAB);
    r4_fwd<ZHI>(v1[k], v1[k + 4], v1[k + 8], v1[k + 12], tB, tA, tAB);
  }
#pragma unroll
  for (int q = 0; q < 16; q += 4) {
    r4_fwd<false>(v0[q], v0[q + 1], v0[q + 2], v0[q + 3], w8, w4, w48);
    r4_fwd<false>(v1[q], v1[q + 1], v1[q + 2], v1[q + 3], w8, w4, w48);
  }
}
template <bool LOONLY>
DI void fft16_inv2(c32 (&v0)[16], c32 (&v1)[16], c32 w1) {
  const c32 w2 = cmul(w1, w1), w3 = cmul(w1, w2), w4 = cmul(w2, w2), w8 = cmul(w4, w4), w48 = cmul(w4, w8);
#pragma unroll
  for (int q = 0; q < 16; q += 4) {
    r4_inv<false>(v0[q], v0[q + 1], v0[q + 2], v0[q + 3], w8, w4, w48);
    r4_inv<false>(v1[q], v1[q + 1], v1[q + 2], v1[q + 3], w8, w4, w48);
  }
#pragma unroll
  for (int k = 0; k < 4; ++k) {
    const c32 tB = k ? cmul(w2, w16g(2 * k)) : w2, tA = k ? cmul(w1, w16g(k)) : w1, tAB = k ? cmul(w3, w16g(3 * k)) : w3;
    r4_inv<LOONLY>(v0[k], v0[k + 4], v0[k + 8], v0[k + 12], tB, tA, tAB);
    r4_inv<LOONLY>(v1[k], v1[k + 4], v1[k + 8], v1[k + 12], tB, tA, tAB);
  }
}
template <int H, bool INV, bool PRUNE>
DI void fft_pass16(c32* X0, c32* X1) {
  constexpr int ST = H / 16;
  const int tid = otid();
  const int jb = tid & (ST - 1), base = (tid / ST) * H + jb;
  c32 v0[16], v1[16];
  constexpr int NLD = (PRUNE && !INV) ? 8 : 16, NSTR = (PRUNE && INV) ? 8 : 16;
#pragma unroll
  for (int k = 0; k < NLD; ++k) { v0[k] = X0[phys(base + k * ST)]; v1[k] = X1[phys(base + k * ST)]; }
#pragma unroll
  for (int k = NLD; k < 16; ++k) { v0[k] = (c32){0.f, 0.f}; v1[k] = (c32){0.f, 0.f}; }
  const float fr = (float)jb * (1.f / (float)H);
  const c32 w1 = (c32){__builtin_amdgcn_cosf(fr), -__builtin_amdgcn_sinf(fr)};
  if (INV) fft16_inv2<PRUNE>(v0, v1, w1); else fft16_fwd2<PRUNE>(v0, v1, w1);
#pragma unroll
  for (int k = 0; k < NSTR; ++k) { X0[phys(base + k * ST)] = v0[k]; X1[phys(base + k * ST)] = v1[k]; }
  __syncthreads();
}
DI void fft_pass2(c32* X0, c32* X1) {
  const int tid = otid();
#pragma unroll
  for (int i = 0; i < 8; ++i) {
    const int i0 = phys(2 * (tid + NT * i));
    const c32 a = X0[i0], b = X0[i0 + 1], c = X1[i0], d = X1[i0 + 1];
    X0[i0] = a + b; X0[i0 + 1] = a - b; X1[i0] = c + d; X1[i0 + 1] = c - d;
  }
  __syncthreads();
}
template <bool PRUNE>
DI void fft_fwd(c32* X0, c32* X1) { fft_pass16<8192, false, PRUNE>(X0, X1); fft_pass16<512, false, false>(X0, X1); fft_pass16<32, false, false>(X0, X1); fft_pass2(X0, X1); }
DI void fft_conv(c32* X0, c32* X1, const c32* __restrict__ Ks) {
  fft_pass16<8192, false, true>(X0, X1); fft_pass16<512, false, false>(X0, X1); fft_pass16<32, false, false>(X0, X1);
  {
    const int tid = otid();
#pragma unroll
    for (int i = 0; i < 8; ++i) {
      const int mm = tid + NT * i, i0 = phys(2 * mm);
      const f32x4 kk = *(const f32x4*)(Ks + 2 * mm);
      const c32 k0 = (c32){kk.x, kk.y}, k1 = (c32){kk.z, kk.w};
      const c32 a = X0[i0], b = X0[i0 + 1], c = X1[i0], d = X1[i0 + 1];
      const c32 pa = cmul(a + b, k0), pb = cmul(a - b, k1), pc = cmul(c + d, k0), pd = cmul(c - d, k1);
      X0[i0] = pa + pb; X0[i0 + 1] = pa - pb; X1[i0] = pc + pd; X1[i0 + 1] = pc - pd;
    }
    __syncthreads();
  }
  fft_pass16<32, true, false>(X0, X1); fft_pass16<512, true, false>(X0, X1); fft_pass16<8192, true, true>(X0, X1);
}
DI void spec_mul(c32* X0, c32* X1, const c32* __restrict__ Ks) {
  const int tid = otid();
#pragma unroll 8
  for (int i = 0; i < 16; ++i) {
    const c32 k = Ks[tid + NT * i];
    const int n = phys(tid + NT * i);
    X0[n] = cmul(X0[n], k); X1[n] = cmul(X1[n], k);
  }
  __syncthreads();
}
DI float sconv(const bf16_t* u, int t, int len, float w0, float w1, float w2, float cb) {
  float r = cb + w1 * bf2f(u[t]);
  if (t > 0) r += w0 * bf2f(u[t - 1]);
  if (t + 1 < len) r += w2 * bf2f(u[t + 1]);
  return r;
}

DI void sconv8(const bf16_t* u, int t0, int len, float w0, float w1, float w2, float cb, float (&out)[8]) {
  const u32x4 raw = *(const u32x4*)(u + t0);
  float x[10];
  x[0] = t0 > 0 ? bf2f(u[t0 - 1]) : 0.f;
  x[9] = t0 + 8 < len ? bf2f(u[t0 + 8]) : 0.f;
#pragma unroll
  for (int i = 0; i < 4; ++i) { x[1 + 2 * i] = __uint_as_float(raw[i] << 16); x[2 + 2 * i] = __uint_as_float(raw[i] & 0xffff0000u); }
#pragma unroll
  for (int i = 0; i < 8; ++i) out[i] = cb + w0 * x[i] + w1 * x[i + 1] + w2 * x[i + 2];
}

DI void phase_hyena(const P& p, char* smem, float* aux, bool dry) {
  const int tid = otid();
  c32* X0 = (c32*)smem; c32* X1 = (c32*)(smem + 67584);
  bf16_t* ut = (bf16_t*)(p.ws + O_UT);
  const float* hdn = (const float*)(p.ws + O_HDN);
  const float* hdnc = (const float*)(p.ws + O_HDNC);
  c32* Ksp = (c32*)(p.ws + O_FFT + (size_t)blockIdx.x * 131072);
  const float* cw = p.in[15];
  const float* cbv = p.in[16];
  const float* fwo = p.in[21];
  const float* hb = p.in[22];
  for (int c = blockIdx.x; c < 1024; c += gridDim.x) {
    __syncthreads();
    { const int ta = otid(); if (ta < 256) aux[ta] = fwo[(size_t)(ta >> 2) * 4096 + (ta & 3) * 1024 + c]; }
    __syncthreads();
    const float la0 = -15.350567286626973f, la1 = -3.0701134573253945f;
    const float delta = fabsf(la0 + (la1 - la0) * ((float)c / 1023.f));
    const float bias0 = hb[c], bias1 = hb[1024 + c];
    float w0[3], w1[3], w2[3], cb[3];
#pragma unroll
    for (int r = 0; r < 3; ++r) { const int f = r * 1024 + c; w0[r] = cw[f]; w1[r] = cw[3072 + f]; w2[r] = cw[6144 + f]; cb[r] = cbv[f]; }
    const int t0 = tid * 8;
    {
      const int lane = tid & 63, wv = tid >> 6, lr = lane & 15, lq = lane >> 4;
      const bf16_t* hdnb = (const bf16_t*)(p.ws + O_HDNB);
      bf16x8 bfr[2];
#pragma unroll
      for (int ks = 0; ks < 2; ++ks) {
        u32x4 u;
#pragma unroll
        for (int e = 0; e < 4; ++e) {
          const int j0 = ks * 32 + lq * 8 + 2 * e;
          const float wa = lr < 4 ? aux[j0 * 4 + lr] : 0.f, wb = lr < 4 ? aux[(j0 + 1) * 4 + lr] : 0.f;
          u[e] = pack2(wa, wb);
        }
        bfr[ks] = __builtin_bit_cast(bf16x8, u);
      }
      const int o = (lr >> 1) & 1, dir = lr & 1;
      c32* Xo = o ? X1 : X0;
#pragma unroll 1
      for (int mb0 = 0; mb0 < 32; mb0 += 8) {
        bf16x8 a0[8], a1[8];
#pragma unroll
        for (int i = 0; i < 8; ++i) {
          const bf16_t* src = hdnb + (size_t)((wv * 32 + mb0 + i) * 16 + lr) * 64 + lq * 8;
          a0[i] = *(const bf16x8*)src; a1[i] = *(const bf16x8*)(src + 32);
        }
#pragma unroll
        for (int i = 0; i < 8; ++i) {
          f32x4 cc = (f32x4){0.f, 0.f, 0.f, 0.f};
          cc = mfma16(a0[i], bfr[0], cc);
          cc = mfma16(a1[i], bfr[1], cc);
#pragma unroll
          for (int j = 0; j < 4; ++j) {
            const int t = (wv * 32 + mb0 + i) * 16 + 4 * lq + j;
            const float val = cc[j] * __expf(-((float)t / 4095.f) * delta);
            const float partner = __shfl_xor(val, 1, 64);
            if (lr < 4) {
              if (t == 0) { if (dir == 0) Xo[0] = (c32){val + partner, 0.f}; else Xo[phys(4096)] = (c32){0.f, 0.f}; }
              else Xo[phys(dir ? 8192 - t : t)] = (c32){val, 0.f};
            }
          }
        }
      }
      __syncthreads();
      fft_fwd<false>(X0, X1);
#pragma unroll 4
      for (int i = 0; i < 16; ++i) { Ksp[tid + NT * i] = X0[phys(tid + NT * i)]; Ksp[8192 + tid + NT * i] = X1[phys(tid + NT * i)]; }
      __syncthreads();
    }
    const bf16_t* uv = ut + (size_t)c * NTOK;
    const bf16_t* ug0 = ut + (size_t)(1024 + c) * NTOK;
    const bf16_t* ug1 = ut + (size_t)(2048 + c) * NTOK;
    bf16_t* usg = ut + (size_t)(3072 + c) * NTOK;
    {
      float z[4][8], g[4][8];
#pragma unroll
      for (int bb = 0; bb < 4; ++bb) sconv8(uv + bb * SEQ, t0, SEQ, w0[0], w1[0], w2[0], cb[0], z[bb]);
#pragma unroll
      for (int i = 0; i < 8; ++i) {
        X0[phys(t0 + i)] = (c32){z[0][i], z[1][i]};
        X1[phys(t0 + i)] = (c32){z[2][i], z[3][i]};
      }
      __syncthreads();
      fft_conv(X0, X1, Ksp);
      const int t0b = otid() * 8;
#pragma unroll
      for (int bb = 0; bb < 4; ++bb) sconv8(ug0 + bb * SEQ, t0b, SEQ, w0[1], w1[1], w2[1], cb[1], g[bb]);
#pragma unroll
      for (int i = 0; i < 8; ++i) {
        const c32 y0 = X0[phys(t0b + i)], y1 = X1[phys(t0b + i)];
        z[0][i] = g[0][i] * (y0.x * (1.f / 8192.f) + z[0][i] * bias0);
        z[1][i] = g[1][i] * (y0.y * (1.f / 8192.f) + z[1][i] * bias0);
        z[2][i] = g[2][i] * (y1.x * (1.f / 8192.f) + z[2][i] * bias0);
        z[3][i] = g[3][i] * (y1.y * (1.f / 8192.f) + z[3][i] * bias0);
      }
      __syncthreads();
#pragma unroll
      for (int i = 0; i < 8; ++i) {
        X0[phys(t0b + i)] = (c32){z[0][i], z[1][i]};
        X1[phys(t0b + i)] = (c32){z[2][i], z[3][i]};
      }
      __syncthreads();
      fft_conv(X0, X1, Ksp + 8192);
      const int t0c = otid() * 8;
#pragma unroll
      for (int bb = 0; bb < 4; ++bb) sconv8(ug1 + bb * SEQ, t0c, SEQ, w0[2], w1[2], w2[2], cb[2], g[bb]);
#pragma unroll
      for (int bb = 0; bb < 4; ++bb) {
        const u32x4 sgv = *(const u32x4*)(usg + bb * SEQ + t0c);
        float oo[8];
#pragma unroll
        for (int i = 0; i < 8; ++i) {
          const c32 y = (bb < 2) ? X0[phys(t0c + i)] : X1[phys(t0c + i)];
          const float yy = (bb & 1) ? y.y : y.x;
          const float zz = g[bb][i] * (yy * (1.f / 8192.f) + z[bb][i] * bias1);
          const unsigned ra = sgv[i >> 1];
          const float fa = (i & 1) ? __uint_as_float(ra & 0xffff0000u) : __uint_as_float(ra << 16);
          oo[i] = zz * fa;
        }
        u32x4 wv;
        wv.x = pack2(oo[0], oo[1]); wv.y = pack2(oo[2], oo[3]); wv.z = pack2(oo[4], oo[5]); wv.w = pack2(oo[6], oo[7]);
        if (!dry) *(u32x4*)(usg + bb * SEQ + t0c) = wv;
      }
      __syncthreads();
    }
  }
  for (int cb0 = blockIdx.x; cb0 < 1024; cb0 += 4 * gridDim.x) {
    float* aux4 = (float*)smem;
    float* klag = aux4 + 1024;
    f32x4* su = (f32x4*)(klag + 4096);
    f32x4* sz4 = su + 1024;
    f32x4* part = sz4 + 1024;
    int cch[4];
#pragma unroll
    for (int ch = 0; ch < 4; ++ch) { const int cc = cb0 + ch * gridDim.x; cch[ch] = cc < 1024 ? cc : cb0; }
    __syncthreads();
    {
      const int ta = otid();
      if (ta < 256) {
#pragma unroll
        for (int ch = 0; ch < 4; ++ch) aux4[ch * 256 + ta] = fwo[(size_t)(ta >> 2) * 4096 + (ta & 3) * 1024 + cch[ch]];
      }
    }
    __syncthreads();
    {
      const int tf = otid();
      const int t = tf & 255, o = tf >> 8;
      float a0[4] = {0.f, 0.f, 0.f, 0.f}, a1[4] = {0.f, 0.f, 0.f, 0.f};
#pragma unroll 16
      for (int j = 0; j < 64; ++j) {
        const float hv = hdnc[j * LCTX + t];
#pragma unroll
        for (int ch = 0; ch < 4; ++ch) { a0[ch] += hv * aux4[ch * 256 + j * 4 + 2 * o]; a1[ch] += hv * aux4[ch * 256 + j * 4 + 2 * o + 1]; }
      }
#pragma unroll
      for (int ch = 0; ch < 4; ++ch) {
        const float la0 = -15.350567286626973f, la1 = -3.0701134573253945f;
        const float delta = fabsf(la0 + (la1 - la0) * ((float)cch[ch] / 1023.f));
        const float dec = __expf(-((float)t / 255.f) * delta);
        float* kl = klag + ch * 1024 + o * 512;
        if (t == 0) kl[255] = (a0[ch] + a1[ch]) * dec;
        else { kl[255 + t] = a0[ch] * dec; kl[255 - t] = a1[ch] * dec; }
      }
    }
    const int tc = otid();
    const int t = tc & 255, half = tc >> 8;
    float vreg[4][2], g0r[4][2], g1r[4][2], z1[4][2];
#pragma unroll
    for (int ch = 0; ch < 4; ++ch) {
      const int c = cch[ch];
      const bf16_t* uv = ut + (size_t)c * NTOK;
      const bf16_t* ug0 = ut + (size_t)(1024 + c) * NTOK;
      const bf16_t* ug1 = ut + (size_t)(2048 + c) * NTOK;
#pragma unroll
      for (int i = 0; i < 2; ++i) {
        const int base = NLAT + (2 * half + i) * LCTX;
        vreg[ch][i] = sconv(uv + base, t, LCTX, cw[c], cw[3072 + c], cw[6144 + c], cbv[c]);
        g0r[ch][i] = sconv(ug0 + base, t, LCTX, cw[1024 + c], cw[3072 + 1024 + c], cw[6144 + 1024 + c], cbv[1024 + c]);
        g1r[ch][i] = sconv(ug1 + base, t, LCTX, cw[2048 + c], cw[3072 + 2048 + c], cw[6144 + 2048 + c], cbv[2048 + c]);
        ((float*)(su + ch * 256))[t * 4 + 2 * half + i] = vreg[ch][i];
      }
    }
    __syncthreads();
#pragma unroll
    for (int o = 0; o < 2; ++o) {
#pragma unroll
      for (int ch = 0; ch < 4; ++ch) {
        const f32x4* src = (o == 0 ? su : sz4) + ch * 256;
        const float* kl = klag + ch * 1024 + o * 512 + t + 255 - half * 128;
        f32x4 acc = (f32x4){0.f, 0.f, 0.f, 0.f};
#pragma unroll 8
        for (int s2 = 0; s2 < 128; ++s2) acc += kl[-s2] * src[half * 128 + s2];
        part[ch * 512 + half * 256 + t] = acc;
      }
      __syncthreads();
#pragma unroll
      for (int ch = 0; ch < 4; ++ch) {
        const int c = cch[ch];
        const f32x4 p0 = part[ch * 512 + t], p1 = part[ch * 512 + 256 + t];
        const float bias0 = hb[c], bias1 = hb[1024 + c];
        bf16_t* usg = ut + (size_t)(3072 + c) * NTOK;
#pragma unroll
        for (int i = 0; i < 2; ++i) {
          const int bsel = 2 * half + i;
          const float y = (bsel == 0 ? p0.x + p1.x : bsel == 1 ? p0.y + p1.y : bsel == 2 ? p0.z + p1.z : p0.w + p1.w);
          if (o == 0) {
            z1[ch][i] = g0r[ch][i] * (y + vreg[ch][i] * bias0);
            ((float*)(sz4 + ch * 256))[t * 4 + bsel] = z1[ch][i];
          } else {
            const float z2 = g1r[ch][i] * (y + z1[ch][i] * bias1);
            const int tok = NLAT + bsel * LCTX + t;
            if (!dry && (ch == 0 || cb0 + ch * (int)gridDim.x < 1024)) usg[tok] = f2bf(z2 * bf2f(usg[tok]));
          }
        }
      }
      __syncthreads();
    }
  }
}

DI void phase_hy_transpose(const P& p, char* smem) {
  const int tid = otid();
  const bf16_t* z = (const bf16_t*)(p.ws + O_UT) + (size_t)3072 * NTOK;
  bf16_t* og = (bf16_t*)(p.ws + O_ACT);
  bf16_t* tile = (bf16_t*)smem;
  for (int t = blockIdx.x; t < 272 * 16; t += gridDim.x) {
    const int tk0 = (t >> 4) * 64, c0 = (t & 15) * 64;
    __syncthreads();
    { const int ch = tid >> 3, kc = tid & 7;
      *(u32x4*)(tile + ch * 72 + kc * 8) = *(const u32x4*)(z + (size_t)(c0 + ch) * NTOK + tk0 + kc * 8); }
    __syncthreads();
    { const int tk = tid >> 3, cc = tid & 7;
      u32x4 v;
      v.x = (unsigned)tile[(cc * 8 + 0) * 72 + tk] | ((unsigned)tile[(cc * 8 + 1) * 72 + tk] << 16);
      v.y = (unsigned)tile[(cc * 8 + 2) * 72 + tk] | ((unsigned)tile[(cc * 8 + 3) * 72 + tk] << 16);
      v.z = (unsigned)tile[(cc * 8 + 4) * 72 + tk] | ((unsigned)tile[(cc * 8 + 5) * 72 + tk] << 16);
      v.w = (unsigned)tile[(cc * 8 + 6) * 72 + tk] | ((unsigned)tile[(cc * 8 + 7) * 72 + tk] << 16);
      *(u32x4*)(og + (size_t)(tk0 + tk) * 1024 + c0 + cc * 8) = v; }
  }
}

DI void phase_cfconv(const P& p, char* smem) {
  const int tid = otid(), lane = tid & 63, wave = tid >> 6;
  const bf16_t* u3 = (const bf16_t*)(p.ws + O_U3);
  const bf16_t* sg = (const bf16_t*)(p.ws + O_SG3);
  bf16_t* og = (bf16_t*)(p.ws + O_ACT);
  float* red = (float*)smem;
  float* red2 = red + 256;
  const int c0 = tid * 2;
  float w[31][2];
#pragma unroll
  for (int k = 0; k < 31; ++k) { const float2 t = *(const float2*)(p.in[28] + k * 1024 + c0); w[k][0] = t.x; w[k][1] = t.y; }
  const float2 bb = *(const float2*)(p.in[29] + c0), lg = *(const float2*)(p.in[30] + c0), lb = *(const float2*)(p.in[31] + c0);
  for (int tile = blockIdx.x; tile < 1024; tile += gridDim.x) {
    const int tok0 = tile * 16, b = tok0 >> 12, pos0 = tok0 & 4095;
    float acc[16][2];
#pragma unroll
    for (int o = 0; o < 16; ++o) { acc[o][0] = bb.x; acc[o][1] = bb.y; }
#pragma unroll
    for (int r = 0; r < 46; ++r) {
      const int pos = pos0 - 15 + r;
      const int pc = pos < 0 ? 0 : (pos > 4095 ? 4095 : pos);
      unsigned raw = *(const unsigned*)(u3 + (size_t)(b * SEQ + pc) * 1024 + c0);
      if (pos != pc) raw = 0u;
      const float x0 = __uint_as_float(raw << 16), x1 = __uint_as_float(raw & 0xffff0000u);
#pragma unroll
      for (int o = 0; o < 16; ++o) {
        const int j = r - o;
        if (j >= 0 && j <= 30) { acc[o][0] += w[j][0] * x0; acc[o][1] += w[j][1] * x1; }
      }
    }
    __syncthreads();
#pragma unroll
    for (int o = 0; o < 16; ++o) {
      float s1 = acc[o][0] + acc[o][1];
      float s2 = acc[o][0] * acc[o][0] + acc[o][1] * acc[o][1];
      s1 = wave_sum(s1); s2 = wave_sum(s2);
      if (lane == 0) { red[wave * 32 + o] = s1; red[wave * 32 + 16 + o] = s2; }
    }
    __syncthreads();
    if (tid < 32) {
      float s = 0.f;
#pragma unroll
      for (int w8 = 0; w8 < 8; ++w8) s += red[w8 * 32 + tid];
      red2[tid] = s;
    }
    __syncthreads();
#pragma unroll
    for (int o = 0; o < 16; ++o) {
      const float mean = red2[o] * (1.f / 1024.f);
      const float var = red2[16 + o] * (1.f / 1024.f) - mean * mean;
      const float rstd = rsqrtf(fmaxf(var, 0.f) + 1e-6f);
      const int tok = tok0 + o;
      const unsigned graw = *(const unsigned*)(sg + (size_t)tok * 1024 + c0);
      const float y0 = siluf((acc[o][0] - mean) * rstd * lg.x + lb.x) * __uint_as_float(graw << 16);
      const float y1 = siluf((acc[o][1] - mean) * rstd * lg.y + lb.y) * __uint_as_float(graw & 0xffff0000u);
      *(unsigned*)(og + (size_t)tok * 1024 + c0) = pack2(y0, y1);
    }
  }
}


#define XB_TMO      128
#define XB_XCNT(j)  (256  + 64 * (j))
#define XB_XSUB(j)  (1280 + 64 * (j))
#define XB_XGEN(j)  (2304 + 64 * (j))
#define XB_TOP      3328
#define XB_TOPGEN   3392
#define XCD_BAR_WORDS 3456
#define XB_SPIN_CAP (1u << 22)
#define LAS __attribute__((address_space(3)))
DI unsigned xb_ld(unsigned* p) { return __hip_atomic_load(p, __ATOMIC_RELAXED, __HIP_MEMORY_SCOPE_AGENT); }
DI unsigned xb_add(unsigned* p, unsigned v) { return __hip_atomic_fetch_add(p, v, __ATOMIC_RELAXED, __HIP_MEMORY_SCOPE_AGENT); }
DI unsigned xb_xcc_id() { return (unsigned)__builtin_amdgcn_s_getreg((3 << 11) | 20) & 0xFu; }
#define XB_SPIN(cond, bar) do { unsigned _sp = 0; while (cond) { __builtin_amdgcn_s_sleep(1); \
    if ((++_sp & 255u) == 0u) { if (xb_ld(&(bar)[XB_TMO])) break; if (_sp > XB_SPIN_CAP) { atomicAdd(&(bar)[XB_TMO], 1u); break; } } } } while (0)
struct XcdBarrier { unsigned* bar; unsigned x; volatile LAS unsigned* st; };
DI XcdBarrier xcd_barrier_post(unsigned* bar, volatile LAS unsigned* st) {
  XcdBarrier b; b.bar = bar; b.x = xb_xcc_id(); b.st = st;
  if (threadIdx.x == 0) (void)xb_add(&bar[XB_XCNT(b.x)], 1u);
  return b;
}
DI void xcd_barrier_complete(unsigned* bar, unsigned x, unsigned& nloc, unsigned& nx) {
  const unsigned G = gridDim.x * gridDim.y * gridDim.z;
  unsigned sum, cnt, mine, sp = 0u;
  for (;;) {
    sum = 0u; cnt = 0u; mine = 0u;
#pragma unroll
    for (unsigned j = 0; j < 16; ++j) { const unsigned c = xb_ld(&bar[XB_XCNT(j)]); sum += c; cnt += (c > 0u) ? 1u : 0u; mine = (j == x) ? c : mine; }
    if (sum == G) break;
    __builtin_amdgcn_s_sleep(1);
    if ((++sp & 255u) == 0u) { if (xb_ld(&bar[XB_TMO])) break; if (sp > XB_SPIN_CAP) { atomicAdd(&bar[XB_TMO], 1u); break; } }
  }
  nloc = mine > 0u ? mine : 1u; nx = cnt > 0u ? cnt : 1u;
}
__device__ __attribute__((noinline)) void xcd_barrier(unsigned* bbar, unsigned bx, volatile LAS unsigned* bst, bool leader) {
  XcdBarrier b; b.bar = bbar; b.x = bx; b.st = bst;
  asm volatile("s_waitcnt vmcnt(0)" ::: "memory");
  __syncthreads();
  if (leader) {
    unsigned* bar = b.bar;
    __builtin_amdgcn_s_waitcnt(0);
    unsigned nloc = b.st[0], nx = b.st[1];
    if (nloc == 0u) { xcd_barrier_complete(bar, b.x, nloc, nx); b.st[0] = nloc; b.st[1] = nx; }
    const unsigned old = xb_add(&bar[XB_XSUB(b.x)], 1u);
    const unsigned gen = old / nloc;
    if (old + 1u == (gen + 1u) * nloc) {
      __builtin_amdgcn_fence(__ATOMIC_RELEASE, "agent");
      asm volatile("s_waitcnt vmcnt(0)" ::: "memory");
      const unsigned og = xb_add(&bar[XB_TOP], 1u);
      const unsigned tg = og / nx;
      if (og + 1u == (tg + 1u) * nx) xb_add(&bar[XB_TOPGEN], 1u);
      else XB_SPIN(xb_ld(&bar[XB_TOPGEN]) == tg, bar);
      __builtin_amdgcn_fence(__ATOMIC_ACQUIRE, "agent");
      xb_add(&bar[XB_XGEN(b.x)], 1u);
      asm volatile("s_waitcnt vmcnt(0)" ::: "memory");
    } else {
      XB_SPIN(xb_ld(&bar[XB_XGEN(b.x)]) == gen, bar);
      __builtin_amdgcn_fence(__ATOMIC_ACQUIRE, "agent");
      asm volatile("s_waitcnt vmcnt(0)" ::: "memory");
    }
  }
  __syncthreads();
}

__global__ void __launch_bounds__(NT) mega(P p) {
  cg::grid_group grid = cg::this_grid();
  extern __shared__ __attribute__((aligned(16))) char smem[];
  __shared__ float aux[256];
  __shared__ uint4 xb_words;
  if (threadIdx.x == 0) xb_words = make_uint4(0u, 0u, 0u, 0u);
  __syncthreads();
  const XcdBarrier xb = xcd_barrier_post((unsigned*)(p.ws + O_BAR), (volatile LAS unsigned*)&xb_words);
  if (p.reps[7] == 0x7fffffff) grid.sync();

#define REP(g) for (int rep_ = 0; rep_ < p.reps[g]; ++rep_)
  REP(0) { phase0(p, smem); xcd_barrier(xb.bar, xb.x, xb.st, otid() == 0); }
  REP(1) { phase_norm(p, 0, NTOK); xcd_barrier(xb.bar, xb.x, xb.st, otid() == 0); }
  REP(2) {
    unsigned char* ws = opq(p.ws); const bf16_t* act = (const bf16_t*)(ws + O_ACT); const float2* rope = (const float2*)(ws + O_ROPE); (void)act; (void)rope;
    EpiMlaIn e{(bf16_t*)(ws + O_CQ), (bf16_t*)(ws + O_CKV), (bf16_t*)(ws + O_KP), (bf16_t*)(ws + O_SG0), rope, (float*)(ws + O_RSS)};
    gemm_phase256((const bf16_t*)(ws + O_W_MLA_IN), act, 1024, 1792, NTOK, smem, e, rep_ + 1 < p.reps[2]);
    xcd_barrier(xb.bar, xb.x, xb.st, otid() == 0);
  }
  REP(2) {
    unsigned char* ws = opq(p.ws); const bf16_t* act = (const bf16_t*)(ws + O_ACT); const float2* rope = (const float2*)(ws + O_ROPE); (void)act; (void)rope;
    EpiUq e1{(bf16_t*)(ws + O_Q), rope, (const float*)(ws + O_RSS)};
    EpiUkv e2{(bf16_t*)(ws + O_KP), (bf16_t*)(ws + O_ACT), (const float*)(ws + O_RSS)};
    TileWalk tw(14, 68);
    int ft, tt;
    while (tw.next(ft, tt)) {
      if (ft < 6) gemm_tile8p((const bf16_t*)(ws + O_W_UQ), (const bf16_t*)(ws + O_CQ), 384, ft * 256, tt * 256, smem, e1, rep_ + 1 < p.reps[2]);
      else gemm_tile8p((const bf16_t*)(ws + O_W_UKV), (const bf16_t*)(ws + O_CKV), 256, (ft - 6) * 256, tt * 256, smem, e2, rep_ + 1 < p.reps[2]);
    }
    xcd_barrier(xb.bar, xb.x, xb.st, otid() == 0);
  }
  REP(4) { phase_mla_attn(p, smem, rep_ + 1 < p.reps[4]); xcd_barrier(xb.bar, xb.x, xb.st, otid() == 0); }
  REP(3) {
    unsigned char* ws = opq(p.ws); const bf16_t* act = (const bf16_t*)(ws + O_ACT); float* xc = (float*)(ws + O_XC); float* mod = (float*)(ws + O_MOD); (void)act;
    EpiRes e{p.in[0], p.in[2], p.out, xc, mod + 0 * 5 * 3072, rep_ + 1 < p.reps[3]};
    gemm_phase256((const bf16_t*)(ws + O_W_MLA_OUT), (const bf16_t*)(ws + O_SG0), 1024, 1024, NTOK, smem, e);
    xcd_barrier(xb.bar, xb.x, xb.st, otid() == 0);
  }
  REP(1) { phase_norm(p, 1, NTOK); xcd_barrier(xb.bar, xb.x, xb.st, otid() == 0); }
  REP(2) {
    unsigned char* ws = opq(p.ws); const bf16_t* act = (const bf16_t*)(ws + O_ACT); const float2* rope = (const float2*)(ws + O_ROPE); (void)act; (void)rope;
    EpiHyIn e{(bf16_t*)(ws + O_UT)};
    gemm_phase256((const bf16_t*)(ws + O_W_HY_IN), act, 1024, 4096, NTOK, smem, e, rep_ + 1 < p.reps[2]);
    xcd_barrier(xb.bar, xb.x, xb.st, otid() == 0);
  }
  REP(5) { phase_hyena(p, smem, aux, rep_ + 1 < p.reps[5]); xcd_barrier(xb.bar, xb.x, xb.st, otid() == 0); }
  phase_hy_transpose(p, smem);
  xcd_barrier(xb.bar, xb.x, xb.st, otid() == 0);
  REP(3) {
    unsigned char* ws = opq(p.ws); const bf16_t* act = (const bf16_t*)(ws + O_ACT); float* xc = (float*)(ws + O_XC); float* mod = (float*)(ws + O_MOD); (void)act;
    EpiRes e{p.out, xc, p.out, xc, mod + 1 * 5 * 3072, rep_ + 1 < p.reps[3]};
    gemm_phase256((const bf16_t*)(ws + O_W_HY_OUT), act, 1024, 1024, NTOK, smem, e);
    xcd_barrier(xb.bar, xb.x, xb.st, otid() == 0);
  }
  REP(1) { phase_norm(p, 2, NTOK); xcd_barrier(xb.bar, xb.x, xb.st, otid() == 0); }
  REP(2) {
    unsigned char* ws = opq(p.ws); const bf16_t* act = (const bf16_t*)(ws + O_ACT); const float2* rope = (const float2*)(ws + O_ROPE); (void)act; (void)rope;
    EpiSwaIn e{(bf16_t*)(ws + O_QS), (bf16_t*)(ws + O_KS), (bf16_t*)(ws + O_VT2), (bf16_t*)(ws + O_SG2), rope};
    gemm_phase256((const bf16_t*)(ws + O_W_SWA_IN), act, 1024, 2560, NTOK, smem, e, rep_ + 1 < p.reps[2]);
    xcd_barrier(xb.bar, xb.x, xb.st, otid() == 0);
  }
  REP(6) { phase_swa_attn(p, smem, rep_ + 1 < p.reps[6]); xcd_barrier(xb.bar, xb.x, xb.st, otid() == 0); }
  REP(3) {
    unsigned char* ws = opq(p.ws); const bf16_t* act = (const bf16_t*)(ws + O_ACT); float* xc = (float*)(ws + O_XC); float* mod = (float*)(ws + O_MOD); (void)act;
    EpiRes e{p.out, xc, p.out, xc, mod + 2 * 5 * 3072, rep_ + 1 < p.reps[3]};
    gemm_phase256((const bf16_t*)(ws + O_W_SWA_OUT), (const bf16_t*)(ws + O_SG2), 1024, 1024, NLAT, smem, e);
    xcd_barrier(xb.bar, xb.x, xb.st, otid() == 0);
  }
  REP(1) { phase_norm(p, 3, NLAT); xcd_barrier(xb.bar, xb.x, xb.st, otid() == 0); }
  REP(2) {
    unsigned char* ws = opq(p.ws); const bf16_t* act = (const bf16_t*)(ws + O_ACT); const float2* rope = (const float2*)(ws + O_ROPE); (void)act; (void)rope;
    EpiCfIn e{(bf16_t*)(ws + O_U3), (bf16_t*)(ws + O_SG3)};
    gemm_phase256((const bf16_t*)(ws + O_W_CF_IN), act, 1024, 3072, NLAT, smem, e, rep_ + 1 < p.reps[2]);
    xcd_barrier(xb.bar, xb.x, xb.st, otid() == 0);
  }
  REP(7) { phase_cfconv(p, smem); xcd_barrier(xb.bar, xb.x, xb.st, otid() == 0); }
  REP(3) {
    unsigned char* ws = opq(p.ws); const bf16_t* act = (const bf16_t*)(ws + O_ACT); float* xc = (float*)(ws + O_XC); float* mod = (float*)(ws + O_MOD); (void)act;
    EpiRes e{p.out, xc, p.out, xc, mod + 3 * 5 * 3072, rep_ + 1 < p.reps[3]};
    gemm_phase256((const bf16_t*)(ws + O_W_CF_OUT), act, 1024, 1024, NLAT, smem, e);
    xcd_barrier(xb.bar, xb.x, xb.st, otid() == 0);
  }
  phase_final(p);
}

extern "C" void kernel_launch(void* const* d_in, const int* in_sizes, int n_in, void* d_out, int out_size, void* d_ws, size_t ws_size,
                              hipStream_t stream) {
  static int grid = 0;
  if (grid == 0) {
    if (n_in != 33 || ws_size < WS_NEED) {
      fprintf(stderr, "kernel_launch: need 33 inputs and >= %zu bytes of workspace; got n_in %d, ws %zu\n", (size_t)WS_NEED, n_in, ws_size);
      grid = -1;
      return;
    }
    int dev = 0, cus = 0, per_cu = 0;
    hipGetDevice(&dev);
    hipDeviceGetAttribute(&cus, hipDeviceAttributeMultiprocessorCount, dev);
    if (hipFuncSetAttribute((const void*)mega, hipFuncAttributeMaxDynamicSharedMemorySize, DYN_LDS) != hipSuccess) { fprintf(stderr, "hipFuncSetAttribute failed\n"); grid = -1; return; }
    hipOccupancyMaxActiveBlocksPerMultiprocessor(&per_cu, mega, NT, DYN_LDS);
    int g = cus * per_cu;
    if (g > 256) g = 256;
    if (g < 1) g = 256;
    grid = g;
  }
  if (grid < 0) return;
  P p{};
  for (int i = 0; i < 33; ++i) p.in[i] = (const float*)d_in[i];
  p.out = (float*)d_out;
  p.ws = (unsigned char*)d_ws;
  { const int r[8] = {PROBE_REPS}; for (int i = 0; i < 8; ++i) p.reps[i] = r[i]; }
  if (hipMemsetAsync((char*)d_ws + O_BAR, 0, XCD_BAR_BYTES, stream) != hipSuccess) { fprintf(stderr, "memset of barrier words failed\n"); return; }
  void* args[] = {&p};
  hipError_t e = hipLaunchCooperativeKernel((void*)mega, dim3(grid), dim3(NT), args, DYN_LDS, stream);
  if (e != hipSuccess) fprintf(stderr, "cooperative launch failed: %s (grid %d)\n", hipGetErrorString(e), grid);
}
```

```cpp
#include <hip/hip_runtime.h>
#include <hip/hip_cooperative_groups.h>
#include <cstdio>
#include <cstdint>
namespace cg = cooperative_groups;

typedef unsigned short bf16_t;
typedef __attribute__((ext_vector_type(8))) short bf16x8;
typedef __attribute__((ext_vector_type(4))) float f32x4;
typedef __attribute__((ext_vector_type(2))) float f32x2;
typedef __attribute__((ext_vector_type(4))) unsigned u32x4;
typedef __attribute__((ext_vector_type(2))) unsigned u32x2;

#define NT 512
#define DYN_LDS 139264
#ifndef PROBE_REPS
#define PROBE_REPS 1, 1, 1, 1, 1, 1, 1, 1
#endif
#define DI __device__ __forceinline__

constexpr int NLAT = 16384, NCTX = 1024, NTOK = 17408, SEQ = 4096, LCTX = 256, KEYS = 4352;
constexpr float LOG2E = 1.4426950408889634f;
constexpr size_t XCD_BAR_BYTES = 3456 * 4;

constexpr size_t al(size_t x) { return (x + 255) & ~(size_t)255; }
constexpr size_t O_W_MLA_IN = 0;
constexpr size_t O_W_UQ = O_W_MLA_IN + al((size_t)1792 * 1024 * 2);
constexpr size_t O_W_UKV = O_W_UQ + al((size_t)1536 * 384 * 2);
constexpr size_t O_W_MLA_OUT = O_W_UKV + al((size_t)2048 * 256 * 2);
constexpr size_t O_W_HY_IN = O_W_MLA_OUT + al((size_t)1024 * 1024 * 2);
constexpr size_t O_W_HY_OUT = O_W_HY_IN + al((size_t)4096 * 1024 * 2);
constexpr size_t O_W_SWA_IN = O_W_HY_OUT + al((size_t)1024 * 1024 * 2);
constexpr size_t O_W_SWA_OUT = O_W_SWA_IN + al((size_t)2560 * 1024 * 2);
constexpr size_t O_W_CF_IN = O_W_SWA_OUT + al((size_t)1024 * 1024 * 2);
constexpr size_t O_W_CF_OUT = O_W_CF_IN + al((size_t)3072 * 1024 * 2);
constexpr size_t O_MOD = O_W_CF_OUT + al((size_t)1024 * 1024 * 2);
constexpr size_t O_HDN = O_MOD + al((size_t)4 * 5 * 3072 * 4);
constexpr size_t O_HDNC = O_HDN + al((size_t)64 * 4096 * 4);
constexpr size_t O_HDNB = O_HDNC + al((size_t)64 * 256 * 4);
constexpr size_t O_ROPE = O_HDNB + al((size_t)4096 * 64 * 2);
constexpr size_t O_RSS = O_ROPE + al((size_t)4096 * 32 * 8);
constexpr size_t O_RSSL = O_RSS + al((size_t)2 * NTOK * 4);
constexpr size_t O_SW = O_RSSL + al((size_t)3 * NTOK * 4);
constexpr size_t O_XC = O_SW + al((size_t)5 * 9728 * 4);
constexpr size_t O_ACT = O_XC + al((size_t)NCTX * 1024 * 4);
constexpr size_t O_T = O_ACT + al((size_t)NTOK * 1024 * 2);
constexpr size_t O_CQ = O_T;
constexpr size_t O_CKV = O_CQ + al((size_t)NTOK * 384 * 2);
constexpr size_t O_SG0 = O_CKV + al((size_t)NTOK * 256 * 2);
constexpr size_t O_Q = O_SG0 + al((size_t)NTOK * 1024 * 2);
constexpr size_t O_KP = O_Q + al((size_t)NTOK * 1536 * 2);
constexpr size_t O_END0 = O_KP + al((size_t)NTOK * 1536 * 2);
constexpr size_t O_UT = O_T;
constexpr size_t O_FFT = O_UT + al((size_t)4096 * NTOK * 2);
constexpr size_t O_END1 = O_FFT + (size_t)256 * 131072;
constexpr size_t O_QS = O_T;
constexpr size_t O_KS = O_QS + al((size_t)NTOK * 1024 * 2);
constexpr size_t O_VT2 = O_KS + al((size_t)NTOK * 256 * 2);
constexpr size_t O_SG2 = O_VT2 + al((size_t)16 * 64 * KEYS * 2);
constexpr size_t O_U3 = O_T;
constexpr size_t O_SG3 = O_U3 + al((size_t)NLAT * 1024 * 2);
constexpr size_t O_BAR = (O_END0 > O_END1 ? O_END0 : O_END1);
constexpr size_t O_XG2 = O_T + (size_t)96 * 1024 * 1024;
constexpr size_t WS_NEED = O_BAR + XCD_BAR_BYTES;

struct P {
  const float* in[33];
  float* out;
  unsigned char* ws;
  int reps[8];
};

DI int otid() { int t = threadIdx.x; asm volatile("" : "+v"(t)); return t; }
template <class T> DI T* opq(T* p) { asm volatile("" : "+s"(p)); return p; }
DI bf16_t f2bf(float x) { unsigned r; asm("v_cvt_pk_bf16_f32 %0, %1, %1" : "=v"(r) : "v"(x)); return (bf16_t)r; }
DI float bf2f(bf16_t v) { return __uint_as_float(((unsigned)v) << 16); }
DI unsigned pack2(float a, float b) { unsigned r; asm("v_cvt_pk_bf16_f32 %0, %1, %2" : "=v"(r) : "v"(a), "v"(b)); return r; }
DI float siluf(float x) { return x * __builtin_amdgcn_rcpf(1.f + __expf(-x)); }
DI float sigmf(float x) { return __builtin_amdgcn_rcpf(1.f + __expf(-x)); }
DI float wave_sum(float v) {
#pragma unroll
  for (int o = 32; o >= 1; o >>= 1) v += __shfl_xor(v, o, 64);
  return v;
}
DI void store4bf(bf16_t* p, float a, float b, float c, float d) {
  uint2 v; v.x = pack2(a, b); v.y = pack2(c, d);
  *(uint2*)p = v;
}
DI f32x4 mfma16(bf16x8 a, bf16x8 b, f32x4 c) { return __builtin_amdgcn_mfma_f32_16x16x32_bf16(a, b, c, 0, 0, 0); }

DI int tok_modrow(int tok) { return tok < NLAT ? (tok >> 12) : 4; }
DI int tok_batch(int tok) { return tok < NLAT ? (tok >> 12) : ((tok - NLAT) >> 8); }
DI int tok_key(int tok) { return tok < NLAT ? (tok & 4095) : (SEQ + ((tok - NLAT) & 255)); }
DI int key_perm(int key) { const int x = key & 31; return (key & ~31) | (((x >> 2) & 3) * 8 + (x >> 4) * 4 + (x & 3)); }

constexpr int GLD = 72;
template <class Epi>
DI void gemm_tile(const bf16_t* __restrict__ W, const bf16_t* __restrict__ X, int K, int f0, int t0, char* smem, const Epi& epi) {
  bf16_t* sW = (bf16_t*)smem;
  bf16_t* sX = sW + 128 * GLD;
  const int tid = otid(), lane = tid & 63, wave = tid >> 6;
  const int wf = wave >> 2, wt = wave & 3;
  const int lr = lane & 15, lq = lane >> 4;
  f32x4 acc[4][4];
#pragma unroll
  for (int i = 0; i < 4; ++i)
#pragma unroll
    for (int j = 0; j < 4; ++j) acc[i][j] = (f32x4){0.f, 0.f, 0.f, 0.f};
  u32x4 rwA[2], rxA[4], rwB[2], rxB[4];
  const int crow = tid >> 3, ccol = (tid & 7) * 8;
  const bf16_t* Wp = W + (size_t)(f0 + crow) * K + ccol;
  const bf16_t* Xp = X + (size_t)(t0 + crow) * K + ccol;
#define G_LOAD(RW, RX, KOFF)                                                            \
  {                                                                                     \
    _Pragma("unroll") for (int i = 0; i < 2; ++i) RW[i] = *(const u32x4*)(Wp + (size_t)(64 * i) * K + (KOFF)); \
    _Pragma("unroll") for (int i = 0; i < 4; ++i) RX[i] = *(const u32x4*)(Xp + (size_t)(64 * i) * K + (KOFF)); \
  }
#define G_STORE(RW, RX)                                                                 \
  {                                                                                     \
    _Pragma("unroll") for (int i = 0; i < 2; ++i) *(u32x4*)(sW + (crow + 64 * i) * GLD + ccol) = RW[i]; \
    _Pragma("unroll") for (int i = 0; i < 4; ++i) *(u32x4*)(sX + (crow + 64 * i) * GLD + ccol) = RX[i]; \
  }
#define G_COMPUTE()                                                                     \
  {                                                                                     \
    _Pragma("unroll") for (int ks = 0; ks < 2; ++ks) {                                  \
      bf16x8 a[4], b[4];                                                                \
      _Pragma("unroll") for (int i = 0; i < 4; ++i) a[i] = *(const bf16x8*)(sW + (wf * 64 + i * 16 + lr) * GLD + ks * 32 + lq * 8); \
      _Pragma("unroll") for (int i = 0; i < 4; ++i) b[i] = *(const bf16x8*)(sX + (wt * 64 + i * 16 + lr) * GLD + ks * 32 + lq * 8); \
      _Pragma("unroll") for (int i = 0; i < 4; ++i)                                     \
        _Pragma("unroll") for (int j = 0; j < 4; ++j) acc[i][j] = mfma16(a[i], b[j], acc[i][j]); \
    }                                                                                   \
  }
  G_LOAD(rwA, rxA, 0);
  G_LOAD(rwB, rxB, 64);
  for (int k0 = 0; k0 < K; k0 += 128) {
    __syncthreads();
    G_STORE(rwA, rxA);
    __syncthreads();
    { const int kn = k0 + 128 < K ? k0 + 128 : K - 128; G_LOAD(rwA, rxA, kn); }
    G_COMPUTE();
    __syncthreads();
    G_STORE(rwB, rxB);
    __syncthreads();
    { const int kn = k0 + 192 < K ? k0 + 192 : K - 64; G_LOAD(rwB, rxB, kn); }
    G_COMPUTE();
  }
#undef G_LOAD
#undef G_STORE
#undef G_COMPUTE
  epi(f0 + wf * 64, t0 + wt * 64, acc);
}

struct TileWalk {
  int nft, start, ntl, u, nlb;
  DI TileWalk(int nft_, int ntt) {
    const int x = blockIdx.x & 7;
    nft = nft_;
    start = (x * ntt) >> 3;
    ntl = (((x + 1) * ntt) >> 3) - start;
    u = blockIdx.x >> 3;
    nlb = (gridDim.x - x + 7) >> 3;
  }
  DI bool next(int& ft, int& tt) {
    if (u >= ntl * nft) return false;
    const int grp = u / (4 * nft), rem = u - grp * 4 * nft;
    const int left = ntl - grp * 4, gsz = left < 4 ? left : 4;
    ft = rem / gsz;
    tt = start + grp * 4 + rem % gsz;
    u += nlb;
    return true;
  }
};

template <class Epi>
DI void gemm_phase(const bf16_t* W, const bf16_t* X, int K, int NF, int NTK, char* smem, const Epi& epi) {
  TileWalk tw(NF / 128, NTK / 256);
  int ft, tt;
  while (tw.next(ft, tt)) gemm_tile(W, X, K, ft * 128, tt * 256, smem, epi);
}


constexpr int G_BK = 64, G_HALF = 128, G_HT = G_HALF * G_BK;
DI int g_lds_byte(int r, int c) {
  int st = (r >> 4) * 2 + (c >> 5), rr = r & 15, cc = c & 31, ob = rr * 64 + cc * 2;
  return st * 1024 + (ob ^ (((ob >> 9) & 1) << 5));
}
DI void g_stage_rc(int b, int& R, int& C) {
  int st = b / 1024, sb = b % 1024, swz = sb ^ (((sb >> 9) & 1) << 5);
  R = (st >> 1) * 16 + swz / 64; C = (st & 1) * 32 + (swz % 64) / 2;
}
template <class Epi>
DI void gemm_tile256(const bf16_t* __restrict__ W, const bf16_t* __restrict__ X, int K, int f0, int t0, char* smem, const Epi& epi, bool dry = false) {
  const int tidx = otid();
  const int wid = tidx >> 6, lane = tidx & 63, wr = wid >> 2, wc = wid & 3, fr = lane & 15, fq = lane >> 4;
  f32x4 acc[8][4];
#pragma unroll
  for (int i = 0; i < 8; ++i)
#pragma unroll
    for (int j = 0; j < 4; ++j) acc[i][j] = (f32x4){0.f, 0.f, 0.f, 0.f};
  int r0, c0, r1, c1;
  g_stage_rc(tidx * 16, r0, c0);
  g_stage_rc(tidx * 16 + 8192, r1, c1);
  const bf16_t* Wg0 = W + (size_t)(f0 + r0) * K + c0;
  const bf16_t* Wg1 = W + (size_t)(f0 + r1) * K + c1;
  const bf16_t* Xg0 = X + (size_t)(t0 + r0) * K + c0;
  const bf16_t* Xg1 = X + (size_t)(t0 + r1) * K + c1;
  const size_t hk = (size_t)128 * K;
#define GLL(src, dst) __builtin_amdgcn_global_load_lds((const unsigned*)(src), (__attribute__((address_space(3))) unsigned*)(dst), 16, 0, 0)
#define STAGE_ALL(buf, kt)                                                     \
  {                                                                            \
    char* sb_ = smem + (buf) * 65536 + tidx * 16;                              \
    const size_t ko_ = (size_t)(kt) * 64;                                      \
    GLL(Wg0 + ko_, sb_);               GLL(Wg1 + ko_, sb_ + 8192);             \
    GLL(Wg0 + hk + ko_, sb_ + 16384);  GLL(Wg1 + hk + ko_, sb_ + 24576);       \
    GLL(Xg0 + ko_, sb_ + 32768);       GLL(Xg1 + ko_, sb_ + 40960);            \
    GLL(Xg0 + hk + ko_, sb_ + 49152);  GLL(Xg1 + hk + ko_, sb_ + 57344);       \
  }
  const int ob = fr * 64 + fq * 16;
  const int lane_off = ob ^ (((ob >> 9) & 1) << 5);
  const char* aBase = smem + wr * 16384 + lane_off;
  const char* bBase = smem + 32768 + (wc >> 1) * 16384 + (wc & 1) * 8192 + lane_off;
  const int nt = K / 64;
  STAGE_ALL(0, 0);
  for (int kt = 0; kt < nt; ++kt) {
    asm volatile("s_waitcnt vmcnt(0)" ::: "memory");
    __builtin_amdgcn_s_barrier();
    if (kt + 1 < nt) STAGE_ALL((kt + 1) & 1, kt + 1);
    const char* ab = aBase + (kt & 1) * 65536;
    const char* bb = bBase + (kt & 1) * 65536;
#pragma unroll
    for (int ks = 0; ks < 2; ++ks) {
      bf16x8 a[8], b[4];
#pragma unroll
      for (int m = 0; m < 8; ++m) a[m] = *(const bf16x8*)(ab + (m * 2 + ks) * 1024);
#pragma unroll
      for (int n = 0; n < 4; ++n) b[n] = *(const bf16x8*)(bb + (n * 2 + ks) * 1024);
#pragma unroll
      for (int m = 0; m < 8; ++m)
#pragma unroll
        for (int n = 0; n < 4; ++n) acc[m][n] = mfma16(a[m], b[n], acc[m][n]);
    }
  }
#undef GLL
#undef STAGE_ALL
  if (!dry) {
    f32x4 (&lo)[4][4] = *reinterpret_cast<f32x4 (*)[4][4]>(&acc[0]);
    f32x4 (&hi)[4][4] = *reinterpret_cast<f32x4 (*)[4][4]>(&acc[4]);
    epi(f0 + wr * 128, t0 + wc * 64, lo);
    epi(f0 + wr * 128 + 64, t0 + wc * 64, hi);
  }
}


template <class Epi>
DI void gemm_tile8p(const bf16_t* __restrict__ A, const bf16_t* __restrict__ Bt, int K, int brow, int bcol, char* smem, const Epi& epi, bool dry = false) {
  bf16_t* shm = (bf16_t*)smem;
  #define SA(b,h) (shm+((b)*2+(h))*G_HT)
  #define SB(b,h) (shm+(4+(b)*2+(h))*G_HT)
  #define STAGE(P,BASE,br,kt) do{long _g=(long)(br)*K+(long)(kt)*G_BK; \
    for(int _i=0;_i<2;++_i){int _b=tidx*16+_i*8192;int _r,_c;g_stage_rc(_b,_r,_c); \
      __builtin_amdgcn_global_load_lds((const unsigned*)(BASE+_g+(long)_r*K+_c), \
        (__attribute__((address_space(3))) unsigned*)((char*)(P)+_b),16,0,0);}}while(0)
  #define LDA(dst,b,h) for(int m=0;m<4;++m)for(int k=0;k<2;++k) \
    dst[m][k]=*reinterpret_cast<const bf16x8*>((char*)SA(b,h)+g_lds_byte(wr*64+m*16+fr,k*32+fq*8))
  #define LDB(dst,b,h) for(int n=0;n<2;++n)for(int k=0;k<2;++k) \
    dst[n][k]=*reinterpret_cast<const bf16x8*>((char*)SB(b,h)+g_lds_byte(wc*32+n*16+fr,k*32+fq*8))
  #define MMA(ai,bj,At,Bt_) do{__builtin_amdgcn_s_setprio(1); \
    for(int m=0;m<4;++m)for(int n=0;n<2;++n)for(int k=0;k<2;++k) \
      acc[ai][bj][m][n]=__builtin_amdgcn_mfma_f32_16x16x32_bf16(At[m][k],Bt_[n][k],acc[ai][bj][m][n],0,0,0); \
    __builtin_amdgcn_s_setprio(0);}while(0)
  #define WAIT_V(n) asm volatile("s_waitcnt vmcnt(" #n ")":::"memory")
  #define WAIT_L(n) asm volatile("s_waitcnt lgkmcnt(" #n ")":::"memory")
  #define BAR __builtin_amdgcn_s_barrier()
  #define SCHED __builtin_amdgcn_sched_barrier(0)
  const int tidx = otid();
  const int wid=tidx>>6,lane=tidx&63,wr=wid>>2,wc=wid&3,fr=lane&15,fq=lane>>4;
  f32x4 acc[2][2][4][2]={};
  bf16x8 At[4][2],B0[2][2],B1[2][2];
  const int nt=K/G_BK;
  asm volatile("s_waitcnt vmcnt(0) lgkmcnt(0)" ::: "memory");
  __syncthreads();
  STAGE(SB(0,0),Bt,bcol,0); STAGE(SA(0,0),A,brow,0);
  STAGE(SB(0,1),Bt,bcol+G_HALF,0); STAGE(SA(0,1),A,brow+G_HALF,0);
  if(wr==1)BAR;
  WAIT_V(4); BAR;
  STAGE(SB(1,0),Bt,bcol,1); STAGE(SA(1,0),A,brow,1); STAGE(SB(1,1),Bt,bcol+G_HALF,1);
  WAIT_V(6); BAR;
  for(int t=0;t<nt-2;t+=2){
    LDB(B0,0,0); SCHED; LDA(At,0,0); STAGE(SA(1,1),A,brow+G_HALF,t+1);
    WAIT_L(8); BAR; WAIT_L(0); MMA(0,0,At,B0); BAR; SCHED;
    LDB(B1,0,1); STAGE(SB(0,0),Bt,bcol,t+2);
    BAR; WAIT_L(0); MMA(0,1,At,B1); BAR;
    LDA(At,0,1); STAGE(SA(0,0),A,brow,t+2);
    BAR; WAIT_L(0); MMA(1,0,At,B0); BAR; SCHED;
    STAGE(SB(0,1),Bt,bcol+G_HALF,t+2);
    WAIT_V(6); BAR; MMA(1,1,At,B1); BAR;
    LDB(B0,1,0); SCHED; LDA(At,1,0); STAGE(SA(0,1),A,brow+G_HALF,t+2);
    WAIT_L(8); BAR; WAIT_L(0); MMA(0,0,At,B0); BAR; SCHED;
    LDB(B1,1,1); STAGE(SB(1,0),Bt,bcol,t+3);
    BAR; WAIT_L(0); MMA(0,1,At,B1); BAR;
    LDA(At,1,1); STAGE(SA(1,0),A,brow,t+3);
    BAR; WAIT_L(0); MMA(1,0,At,B0); BAR; SCHED;
    STAGE(SB(1,1),Bt,bcol+G_HALF,t+3);
    WAIT_V(6); BAR; MMA(1,1,At,B1); BAR;
  }
  { LDB(B0,0,0); LDA(At,0,0); STAGE(SA(1,1),A,brow+G_HALF,nt-1);
    BAR; WAIT_L(0); MMA(0,0,At,B0); BAR;
    LDB(B1,0,1); BAR; WAIT_L(0); MMA(0,1,At,B1); BAR;
    LDA(At,0,1); WAIT_V(4); BAR; WAIT_L(0); MMA(1,0,At,B0); MMA(1,1,At,B1); BAR; }
  { LDB(B0,1,0); LDA(At,1,0); WAIT_V(2); BAR; WAIT_L(0); MMA(0,0,At,B0); BAR;
    LDB(B1,1,1); WAIT_V(0); BAR; WAIT_L(0); MMA(0,1,At,B1); BAR;
    LDA(At,1,1); BAR; WAIT_L(0); MMA(1,0,At,B0); MMA(1,1,At,B1); BAR; }
  if(wr==0)BAR;
  if (!dry) {
#pragma unroll
    for(int ai=0;ai<2;++ai)
#pragma unroll
      for(int bj=0;bj<2;++bj) epi(brow+ai*G_HALF+wr*64, bcol+bj*G_HALF+wc*32, acc[ai][bj]);
  }
  #undef SA
  #undef SB
  #undef STAGE
  #undef LDA
  #undef LDB
  #undef MMA
  #undef WAIT_V
  #undef WAIT_L
  #undef BAR
  #undef SCHED
}

template <class Epi>
DI void gemm_phase256(const bf16_t* W, const bf16_t* X, int K, int NF, int NTK, char* smem, const Epi& epi, bool dry = false) {
  TileWalk tw(NF / 256, NTK / 256);
  int ft, tt;
  while (tw.next(ft, tt)) gemm_tile8p(W, X, K, ft * 256, tt * 256, smem, epi, dry);
}

struct EpiMlaIn {
  bf16_t *cq, *ckv, *kp, *sg; const float2* rope; float* rss;
  template <int NTI> DI void operator()(int f0, int t0, f32x4 (&acc)[4][NTI]) const {
    const int lane = otid() & 63, lr = lane & 15, lq = lane >> 4;
    if (f0 >= 1728) return;
    if (f0 == 640) {
#pragma unroll
      for (int ti = 0; ti < NTI; ++ti) {
        const int tok = t0 + ti * 16 + lr;
        const bool lat = tok < NLAT;
        const int pos = tok & 4095;
#pragma unroll
        for (int fi = 0; fi < 2; ++fi) {
          float o1[4], o2[4];
#pragma unroll
          for (int j = 0; j < 4; ++j) {
            const int d = fi * 16 + 4 * lq + j;
            float x1 = acc[fi][ti][j], x2 = acc[fi + 2][ti][j];
            if (lat) { float2 cs = rope[pos * 32 + d]; o1[j] = x1 * cs.x - x2 * cs.y; o2[j] = x1 * cs.y + x2 * cs.x; }
            else { o1[j] = x1; o2[j] = x2; }
          }
          const int d0 = fi * 16 + 4 * lq;
#pragma unroll
          for (int h = 0; h < 8; ++h) {
            bf16_t* base = kp + ((size_t)tok * 8 + h) * 192 + 128;
            store4bf(base + d0, o1[0], o1[1], o1[2], o1[3]);
            store4bf(base + 32 + d0, o2[0], o2[1], o2[2], o2[3]);
          }
        }
      }
      return;
    }
    if (f0 < 640) {
#pragma unroll
      for (int ti = 0; ti < NTI; ++ti) {
        const int tok = t0 + ti * 16 + lr;
        float ss = 0.f;
#pragma unroll
        for (int fi = 0; fi < 4; ++fi) {
          const int f = f0 + fi * 16 + 4 * lq;
          f32x4 v = acc[fi][ti];
          ss += v[0] * v[0] + v[1] * v[1] + v[2] * v[2] + v[3] * v[3];
          if (f0 < 384) store4bf(cq + (size_t)tok * 384 + f, v[0], v[1], v[2], v[3]);
          else store4bf(ckv + (size_t)tok * 256 + (f - 384), v[0], v[1], v[2], v[3]);
        }
        ss += __shfl_xor(ss, 16, 64);
        ss += __shfl_xor(ss, 32, 64);
        if (lq == 0) atomicAdd(rss + (f0 < 384 ? 0 : NTOK) + tok, ss);
      }
      return;
    }
#pragma unroll
    for (int fi = 0; fi < 4; ++fi)
#pragma unroll
      for (int ti = 0; ti < NTI; ++ti) {
        const int tok = t0 + ti * 16 + lr;
        const int f = f0 + fi * 16 + 4 * lq;
        f32x4 v = acc[fi][ti];
        store4bf(sg + (size_t)tok * 1024 + (f - 704), siluf(v[0]), siluf(v[1]), siluf(v[2]), siluf(v[3]));
      }
  }
};

struct EpiUq {
  bf16_t* q; const float2* rope; const float* rss;
  template <int NTI> DI void operator()(int f0, int t0, f32x4 (&acc)[4][NTI]) const {
    const int lane = otid() & 63, lr = lane & 15, lq = lane >> 4;
    const bool isrope = (f0 % 192) == 128;
#pragma unroll
    for (int ti = 0; ti < NTI; ++ti) {
      const int tok = t0 + ti * 16 + lr;
      const int pos = tok & 4095;
      const float sc = 0.07216878364870322f * LOG2E * rsqrtf(rss[tok] * (1.f / 384.f) + 1e-6f);
      if (isrope && tok < NLAT) {
#pragma unroll
        for (int fi = 0; fi < 2; ++fi) {
          float o1[4], o2[4];
#pragma unroll
          for (int j = 0; j < 4; ++j) {
            const int d = fi * 16 + 4 * lq + j;
            float2 cs = rope[pos * 32 + d];
            float x1 = acc[fi][ti][j], x2 = acc[fi + 2][ti][j];
            o1[j] = (x1 * cs.x - x2 * cs.y) * sc; o2[j] = (x1 * cs.y + x2 * cs.x) * sc;
          }
          bf16_t* base = q + (size_t)tok * 1536 + f0 + fi * 16 + 4 * lq;
          store4bf(base, o1[0], o1[1], o1[2], o1[3]);
          store4bf(base + 32, o2[0], o2[1], o2[2], o2[3]);
        }
      } else {
#pragma unroll
        for (int fi = 0; fi < 4; ++fi) {
          f32x4 v = acc[fi][ti];
          store4bf(q + (size_t)tok * 1536 + f0 + fi * 16 + 4 * lq, v[0] * sc, v[1] * sc, v[2] * sc, v[3] * sc);
        }
      }
    }
  }
};

struct EpiUkv {
  bf16_t *kp, *vt; const float* rss;
  template <int NTI> DI void operator()(int f0, int t0, f32x4 (&acc)[4][NTI]) const {
    const int lane = otid() & 63, lr = lane & 15, lq = lane >> 4;
    const int h = f0 >> 8, r = f0 & 255;
#pragma unroll
    for (int ti = 0; ti < NTI; ++ti) {
      const int tok = t0 + ti * 16 + lr;
      const float rs = rsqrtf(rss[NTOK + tok] * (1.f / 256.f) + 1e-6f);
      if (r < 128) {
#pragma unroll
        for (int fi = 0; fi < 4; ++fi) {
          f32x4 v = acc[fi][ti] * rs;
          store4bf(kp + ((size_t)tok * 8 + h) * 192 + r + fi * 16 + 4 * lq, v[0], v[1], v[2], v[3]);
        }
      } else {
        const int b = tok_batch(tok), key = key_perm(tok_key(tok));
#pragma unroll
        for (int fi = 0; fi < 4; ++fi)
#pragma unroll
          for (int j = 0; j < 4; ++j) {
            const int dv = r - 128 + fi * 16 + 4 * lq + j;
            vt[((size_t)(b * 8 + h) * 128 + dv) * KEYS + key] = f2bf(acc[fi][ti][j] * rs);
          }
      }
    }
  }
};

struct EpiRes {
  const float *sl, *sc; float *xl, *xc; const float* mod; bool dry;
  bf16_t* xg; const float* gn; const float* modn; float* rssn;
  template <int NTI> DI void operator()(int f0, int t0, f32x4 (&acc)[4][NTI]) const {
    if (dry) return;
    const int lane = otid() & 63, lr = lane & 15, lq = lane >> 4;
#pragma unroll
    for (int ti = 0; ti < NTI; ++ti) {
      const int tok = t0 + ti * 16 + lr;
      const size_t ro = tok < NLAT ? (size_t)tok * 1024 : (size_t)(tok - NLAT) * 1024;
      const float* xs = (tok < NLAT ? sl : sc) + ro;
      float* xr = (tok < NLAT ? xl : xc) + ro;
      const int mr = tok_modrow(tok);
      const float* g = mod + mr * 3072 + 2048;
      float ss = 0.f;
#pragma unroll
      for (int fi = 0; fi < 4; ++fi) {
        const int f = f0 + fi * 16 + 4 * lq;
        float4 xv = *(const float4*)(xs + f);
        float4 gv = *(const float4*)(g + f);
        f32x4 v = acc[fi][ti];
        xv.x += gv.x * v[0]; xv.y += gv.y * v[1]; xv.z += gv.z * v[2]; xv.w += gv.w * v[3];
        *(float4*)(xr + f) = xv;
        if (xg) {
          ss += xv.x * xv.x + xv.y * xv.y + xv.z * xv.z + xv.w * xv.w;
          const float4 gg = *(const float4*)(gn + f), sn = *(const float4*)(modn + mr * 3072 + 1024 + f);
          store4bf(xg + (size_t)tok * 1024 + f, xv.x * gg.x * (1.f + sn.x), xv.y * gg.y * (1.f + sn.y), xv.z * gg.z * (1.f + sn.z), xv.w * gg.w * (1.f + sn.w));
        }
      }
      if (xg) {
        ss += __shfl_xor(ss, 16, 64);
        ss += __shfl_xor(ss, 32, 64);
        if (lq == 0) atomicAdd(rssn + tok, ss);
      }
    }
  }
};
struct PreNorm {
  const float* rss; const float* sw; int nf;
  template <int NTI> DI void apply(int f0, int t0, f32x4 (&acc)[4][NTI]) const {
    const int lane = otid() & 63, lr = lane & 15, lq = lane >> 4;
#pragma unroll
    for (int ti = 0; ti < NTI; ++ti) {
      const int tok = t0 + ti * 16 + lr;
      const float rstd = rsqrtf(rss[tok] * (1.f / 1024.f) + 1e-6f);
      const float* sr = sw + (size_t)tok_modrow(tok) * nf + f0 + 4 * lq;
#pragma unroll
      for (int fi = 0; fi < 4; ++fi) {
        const float4 sv = *(const float4*)(sr + fi * 16);
        acc[fi][ti][0] = acc[fi][ti][0] * rstd + sv.x; acc[fi][ti][1] = acc[fi][ti][1] * rstd + sv.y;
        acc[fi][ti][2] = acc[fi][ti][2] * rstd + sv.z; acc[fi][ti][3] = acc[fi][ti][3] * rstd + sv.w;
      }
    }
  }
};

struct EpiHyIn {
  bf16_t* ut;
  PreNorm pn;
  template <int NTI> DI void operator()(int f0, int t0, f32x4 (&acc)[4][NTI]) const {
    pn.apply(f0, t0, acc);
    const int lane = otid() & 63, lr = lane & 15, lq = lane >> 4;
    const bool gate = f0 >= 3072;
#pragma unroll
    for (int fi = 0; fi < 4; ++fi)
#pragma unroll
      for (int ti = 0; ti < NTI; ++ti) {
        const int tok = t0 + ti * 16 + lr;
#pragma unroll
        for (int j = 0; j < 4; ++j) {
          const int f = f0 + fi * 16 + 4 * lq + j;
          float v = acc[fi][ti][j];
          if (gate) v = siluf(v);
          ut[(size_t)f * NTOK + tok] = f2bf(v);
        }
      }
  }
};

struct EpiSwaIn {
  bf16_t *qs, *ks, *vt, *sg; const float2* rope;
  PreNorm pn;
  template <int NTI> DI void operator()(int f0, int t0, f32x4 (&acc)[4][NTI]) const {
    pn.apply(f0, t0, acc);
    const int lane = otid() & 63, lr = lane & 15, lq = lane >> 4;
    const float sc = 0.125f * LOG2E;
#pragma unroll
    for (int ti = 0; ti < NTI; ++ti) {
      const int tok = t0 + ti * 16 + lr;
      const int pos = tok & 4095;
      if (f0 < 1280) {
        const bool isq = f0 < 1024;
        const float s = isq ? sc : 1.f;
        bf16_t* dst = isq ? qs + (size_t)tok * 1024 + f0 : ks + (size_t)tok * 256 + (f0 - 1024);
#pragma unroll
        for (int fi = 0; fi < 2; ++fi) {
          float o1[4], o2[4];
#pragma unroll
          for (int j = 0; j < 4; ++j) {
            const int d = fi * 16 + 4 * lq + j;
            float x1 = acc[fi][ti][j], x2 = acc[fi + 2][ti][j];
            if (tok < NLAT) { float2 cs = rope[pos * 32 + d]; o1[j] = (x1 * cs.x - x2 * cs.y) * s; o2[j] = (x1 * cs.y + x2 * cs.x) * s; }
            else { o1[j] = x1 * s; o2[j] = x2 * s; }
          }
          store4bf(dst + fi * 16 + 4 * lq, o1[0], o1[1], o1[2], o1[3]);
          store4bf(dst + 32 + fi * 16 + 4 * lq, o2[0], o2[1], o2[2], o2[3]);
        }
      } else if (f0 < 1536) {
        const int g = (f0 - 1280) >> 6;
        const int b = tok_batch(tok), key = key_perm(tok_key(tok));
#pragma unroll
        for (int fi = 0; fi < 4; ++fi)
#pragma unroll
          for (int j = 0; j < 4; ++j) {
            const int dv = fi * 16 + 4 * lq + j;
            vt[((size_t)(b * 4 + g) * 64 + dv) * KEYS + key] = f2bf(acc[fi][ti][j]);
          }
      } else {
#pragma unroll
        for (int fi = 0; fi < 4; ++fi) {
          f32x4 v = acc[fi][ti];
          store4bf(sg + (size_t)tok * 1024 + (f0 - 1536) + fi * 16 + 4 * lq, siluf(v[0]), siluf(v[1]), siluf(v[2]), siluf(v[3]));
        }
      }
    }
  }
};

struct EpiCfIn {
  bf16_t *u3, *sg;
  PreNorm pn;
  template <int NTI> DI void operator()(int f0, int t0, f32x4 (&acc)[4][NTI]) const {
    pn.apply(f0, t0, acc);
    const int lane = otid() & 63, lr = lane & 15, lq = lane >> 4;
#pragma unroll
    for (int ti = 0; ti < NTI; ++ti) {
      const int tok = t0 + ti * 16 + lr;
      if (f0 < 2048) {
        const int c0 = (f0 >> 6) * 32;
#pragma unroll
        for (int fi = 0; fi < 2; ++fi) {
          f32x4 a = acc[fi][ti], b = acc[fi + 2][ti];
          store4bf(u3 + (size_t)tok * 1024 + c0 + fi * 16 + 4 * lq, a[0] * sigmf(b[0]), a[1] * sigmf(b[1]), a[2] * sigmf(b[2]), a[3] * sigmf(b[3]));
        }
      } else {
#pragma unroll
        for (int fi = 0; fi < 4; ++fi) {
          f32x4 v = acc[fi][ti];
          store4bf(sg + (size_t)tok * 1024 + (f0 - 2048) + fi * 16 + 4 * lq, siluf(v[0]), siluf(v[1]), siluf(v[2]), siluf(v[3]));
        }
      }
    }
  }
};

template <int MODE>
DI void transpose_w(const float* __restrict__ src, int K, int N, bf16_t* __restrict__ dst, char* smem, const float* __restrict__ kscale = nullptr) {
  float* tile = (float*)smem;
  const int tid = otid();
  const int nkt = K / 64, nnt = N / 64;
  for (int t = blockIdx.x; t < nkt * nnt; t += gridDim.x) {
    const int k0 = (t % nkt) * 64, n0 = (t / nkt) * 64;
    __syncthreads();
#pragma unroll
    for (int i = 0; i < 8; ++i) {
      const int e = tid + NT * i, kk = e >> 6, nn = e & 63;
      tile[kk * 65 + nn] = src[(size_t)(k0 + kk) * N + n0 + nn] * (kscale ? kscale[k0 + kk] : 1.f);
    }
    __syncthreads();
    const int nn = tid >> 3, kc = tid & 7;
    int n = n0 + nn;
    if (MODE == 1) {
      if (n < 1024) n = (n >> 5) * 64 + (n & 31);
      else if (n < 2048) { const int c = n - 1024; n = (c >> 5) * 64 + 32 + (c & 31); }
    }
    uint4 v;
    v.x = pack2(tile[(kc * 8 + 0) * 65 + nn], tile[(kc * 8 + 1) * 65 + nn]);
    v.y = pack2(tile[(kc * 8 + 2) * 65 + nn], tile[(kc * 8 + 3) * 65 + nn]);
    v.z = pack2(tile[(kc * 8 + 4) * 65 + nn], tile[(kc * 8 + 5) * 65 + nn]);
    v.w = pack2(tile[(kc * 8 + 6) * 65 + nn], tile[(kc * 8 + 7) * 65 + nn]);
    *(uint4*)(dst + (size_t)n * K + k0 + kc * 8) = v;
  }
  __syncthreads();
}

DI void phase0(const P& p, char* smem) {
  const int tid = otid(), lane = tid & 63, wave = tid >> 6;
  unsigned char* ws = p.ws;
  transpose_w<0>(p.in[8], 1024, 1728, (bf16_t*)(ws + O_W_MLA_IN), smem);
  for (size_t i = (size_t)blockIdx.x * NT + tid; i < (size_t)64 * 1024 / 2; i += (size_t)gridDim.x * NT)
    ((unsigned*)(ws + O_W_MLA_IN + (size_t)1728 * 1024 * 2))[i] = 0u;
  transpose_w<0>(p.in[11], 384, 1536, (bf16_t*)(ws + O_W_UQ), smem, p.in[9]);
  transpose_w<0>(p.in[12], 256, 2048, (bf16_t*)(ws + O_W_UKV), smem, p.in[10]);
  for (int i = blockIdx.x * NT + tid; i < 5 * NTOK; i += gridDim.x * NT) ((float*)(ws + O_RSS))[i] = 0.f;
  transpose_w<0>(p.in[13], 1024, 1024, (bf16_t*)(ws + O_W_MLA_OUT), smem);
  transpose_w<0>(p.in[14], 1024, 4096, (bf16_t*)(ws + O_W_HY_IN), smem);
  transpose_w<0>(p.in[23], 1024, 1024, (bf16_t*)(ws + O_W_HY_OUT), smem);
  transpose_w<0>(p.in[24], 1024, 2560, (bf16_t*)(ws + O_W_SWA_IN), smem);
  transpose_w<0>(p.in[26], 1024, 1024, (bf16_t*)(ws + O_W_SWA_OUT), smem);
  transpose_w<1>(p.in[27], 1024, 3072, (bf16_t*)(ws + O_W_CF_IN), smem);
  transpose_w<0>(p.in[32], 1024, 1024, (bf16_t*)(ws + O_W_CF_OUT), smem);
  {
    float* sS = (float*)smem;
    float* red = sS + 5 * 1024;
    __syncthreads();
    for (int i = tid; i < 5 * 1024; i += NT) {
      const int r = i >> 10, k = i & 1023;
      const float v = r < 4 ? p.in[1][r * 1024 + k] : p.in[3][k];
      sS[i] = siluf(v);
    }
    __syncthreads();
    float* mod = (float*)(ws + O_MOD);
    for (int it = blockIdx.x; it < 4 * 48; it += gridDim.x) {
      const int layer = it / 48, col = (it % 48) * 64 + lane;
      const float* w = p.in[5] + ((size_t)layer * 1024 + wave * 128) * 3072 + col;
      float a0 = 0, a1 = 0, a2 = 0, a3 = 0, a4 = 0;
#pragma unroll 8
      for (int k = 0; k < 128; ++k) {
        const float wv = w[(size_t)k * 3072];
        const int kk = wave * 128 + k;
        a0 += sS[kk] * wv; a1 += sS[1024 + kk] * wv; a2 += sS[2048 + kk] * wv; a3 += sS[3072 + kk] * wv; a4 += sS[4096 + kk] * wv;
      }
      red[(wave * 5 + 0) * 64 + lane] = a0; red[(wave * 5 + 1) * 64 + lane] = a1; red[(wave * 5 + 2) * 64 + lane] = a2;
      red[(wave * 5 + 3) * 64 + lane] = a3; red[(wave * 5 + 4) * 64 + lane] = a4;
      __syncthreads();
      if (tid < 320) {
        const int r = tid >> 6, c = tid & 63;
        float s = 0;
#pragma unroll
        for (int w8 = 0; w8 < 8; ++w8) s += red[(w8 * 5 + r) * 64 + c];
        const int cc = (it % 48) * 64 + c;
        mod[(layer * 5 + r) * 3072 + cc] = s + p.in[6][layer * 3072 + cc];
      }
      __syncthreads();
    }
  }
  {
    float2* rope = (float2*)(ws + O_ROPE);
    for (int i = blockIdx.x * NT + tid; i < 4096 * 32; i += gridDim.x * NT) {
      const int pos = i >> 5, d = i & 31;
      const float inv = exp2f(-(float)(d & 15) * (13.287712379549449f / 16.f));
      const float ang = (float)(d < 16 ? (pos >> 6) : (pos & 63)) * inv;
      float s, c; sincosf(ang, &s, &c);
      rope[i] = make_float2(c, s);
    }
  }
  {
    float* swin = (float*)smem;
    float* swh = swin + 33 * 64;
    float* shall = swh + 2 * 64 * 64;
    float* sh = shall + wave * 64;
    const float* fb = p.in[19];
    const float* ff = p.in[20];
    __syncthreads();
    for (int i = tid; i < 33 * 64; i += NT) swin[i] = p.in[17][i];
    for (int i = tid; i < 2 * 64 * 64; i += NT) swh[i] = p.in[18][i];
    __syncthreads();
    const float f0 = ff[lane], f1 = ff[64 + lane], f2 = ff[128 + lane], b0 = fb[lane], b1 = fb[64 + lane], b2 = fb[128 + lane];
    for (int item = blockIdx.x * 8 + wave; item < SEQ + LCTX; item += gridDim.x * 8) {
      const bool isc = item >= SEQ;
      const int t = isc ? item - SEQ : item;
      const int Lf = isc ? LCTX : SEQ;
      const float tl = (float)t / (float)(Lf - 1);
      const float wpos = (6.283185307179586f / (float)Lf) * (float)t;
      float e = 0.f;
      if (lane == 0) e = tl;
      else if (lane < 33) {
        const int kb = (lane - 1) & 15;
        const float band = 1e-4f + (float)kb * ((15.f - 1e-4f) / 15.f);
        const float a = band * wpos;
        e = lane < 17 ? cosf(a) : -sinf(a);
      }
      sh[lane] = e;
      __builtin_amdgcn_wave_barrier();
      float acc = 0.f;
#pragma unroll 11
      for (int i = 0; i < 33; ++i) acc += sh[i] * swin[i * 64 + lane];
      float hv = sinf(f0 * (acc + b0));
      __builtin_amdgcn_wave_barrier();
      sh[lane] = hv;
      __builtin_amdgcn_wave_barrier();
      acc = 0.f;
#pragma unroll 16
      for (int i = 0; i < 64; ++i) acc += sh[i] * swh[i * 64 + lane];
      hv = sinf(f1 * (acc + b1));
      __builtin_amdgcn_wave_barrier();
      sh[lane] = hv;
      __builtin_amdgcn_wave_barrier();
      acc = 0.f;
#pragma unroll 16
      for (int i = 0; i < 64; ++i) acc += sh[i] * swh[4096 + i * 64 + lane];
      hv = sinf(f2 * (acc + b2));
      __builtin_amdgcn_wave_barrier();
      if (isc) ((float*)(ws + O_HDNC))[lane * LCTX + t] = hv;
      else { ((float*)(ws + O_HDN))[lane * SEQ + t] = hv; ((bf16_t*)(ws + O_HDNB))[t * 64 + lane] = f2bf(hv); }
    }
    __syncthreads();
  }
}

DI void phase_shiftw(const P& p, char* smem) {
  const int tid = otid(), lane = tid & 63, wave = tid >> 6;
  float* sS = (float*)smem;
  float* red = sS + 5 * 1024;
  const float* mod = (const float*)(p.ws + O_MOD);
  float* sw = (float*)(p.ws + O_SW);
  int cur = -1;
  for (int it = blockIdx.x; it < 64 + 40 + 48; it += gridDim.x) {
    const int L = it < 64 ? 1 : (it < 104 ? 2 : 3);
    const int chunk = it < 64 ? it : (it < 104 ? it - 64 : it - 104);
    const int N = L == 1 ? 4096 : (L == 2 ? 2560 : 3072);
    const float* W = L == 1 ? p.in[14] : (L == 2 ? p.in[24] : p.in[27]);
    float* out = sw + (L == 1 ? 0 : (L == 2 ? 5 * 4096 : 5 * (4096 + 2560)));
    __syncthreads();
    if (cur != L) {
      for (int i = tid; i < 5 * 1024; i += NT) sS[i] = mod[(L * 5 + (i >> 10)) * 3072 + (i & 1023)];
      cur = L;
    }
    __syncthreads();
    const int col = chunk * 64 + lane;
    const float* w = W + (size_t)(wave * 128) * N + col;
    float a0 = 0, a1 = 0, a2 = 0, a3 = 0, a4 = 0;
#pragma unroll 8
    for (int k = 0; k < 128; ++k) {
      const float wv = w[(size_t)k * N];
      const int kk = wave * 128 + k;
      a0 += sS[kk] * wv; a1 += sS[1024 + kk] * wv; a2 += sS[2048 + kk] * wv; a3 += sS[3072 + kk] * wv; a4 += sS[4096 + kk] * wv;
    }
    red[(wave * 5 + 0) * 64 + lane] = a0; red[(wave * 5 + 1) * 64 + lane] = a1; red[(wave * 5 + 2) * 64 + lane] = a2;
    red[(wave * 5 + 3) * 64 + lane] = a3; red[(wave * 5 + 4) * 64 + lane] = a4;
    __syncthreads();
    if (tid < 320) {
      const int r = tid >> 6, c = tid & 63;
      float sum = 0;
#pragma unroll
      for (int w8 = 0; w8 < 8; ++w8) sum += red[(w8 * 5 + r) * 64 + c];
      int n = chunk * 64 + c;
      if (L == 3) {
        if (n < 1024) n = (n >> 5) * 64 + (n & 31);
        else if (n < 2048) { const int cc = n - 1024; n = (cc >> 5) * 64 + 32 + (cc & 31); }
      }
      out[r * N + n] = sum;
    }
  }
  __syncthreads();
}

DI void phase_norm(const P& p, int layer, int ntok) {
  const int lane = otid() & 63, wave = otid() >> 6;
  const float* xc = layer == 0 ? p.in[2] : (const float*)(p.ws + O_XC);
  const float* xlat = layer == 0 ? p.in[0] : p.out;
  const float* mod = (const float*)(p.ws + O_MOD) + layer * 5 * 3072;
  const float* g = p.in[4] + layer * 1024;
  bf16_t* act = (bf16_t*)(p.ws + O_ACT);
  for (int row0 = (blockIdx.x * 8 + wave) * 4; row0 < ntok; row0 += gridDim.x * 32) {
    f32x4 v[4][4];
#pragma unroll
    for (int r = 0; r < 4; ++r) {
      const int row = row0 + r;
      const float* x = row < NLAT ? xlat + (size_t)row * 1024 : xc + (size_t)(row - NLAT) * 1024;
#pragma unroll
      for (int i = 0; i < 4; ++i) v[r][i] = ((const f32x4*)x)[lane + 64 * i];
    }
    const float* m = mod + tok_modrow(row0) * 3072;
#pragma unroll
    for (int r = 0; r < 4; ++r) {
      float ss = 0.f;
#pragma unroll
      for (int i = 0; i < 4; ++i) ss += v[r][i].x * v[r][i].x + v[r][i].y * v[r][i].y + v[r][i].z * v[r][i].z + v[r][i].w * v[r][i].w;
      ss = wave_sum(ss);
      const float rstd = rsqrtf(ss * (1.f / 1024.f) + 1e-6f);
#pragma unroll
      for (int i = 0; i < 4; ++i) {
        const int c = (lane + 64 * i) * 4;
        const f32x4 gv = *(const f32x4*)(g + c), sh = *(const f32x4*)(m + c), sc = *(const f32x4*)(m + 1024 + c);
        store4bf(act + (size_t)(row0 + r) * 1024 + c, v[r][i].x * rstd * gv.x * (1.f + sc.x) + sh.x, v[r][i].y * rstd * gv.y * (1.f + sc.y) + sh.y,
                 v[r][i].z * rstd * gv.z * (1.f + sc.z) + sh.z, v[r][i].w * rstd * gv.w * (1.f + sc.w) + sh.w);
      }
    }
  }
}

template <int PER>
DI void small_norm(bf16_t* buf, const float* g) {
  const int lane = otid() & 63, wave = otid() >> 6;
  for (int row = blockIdx.x * 8 + wave; row < NTOK; row += gridDim.x * 8) {
    bf16_t* r = buf + (size_t)row * (64 * PER);
    float v[PER]; float ss = 0.f;
#pragma unroll
    for (int i = 0; i < PER; ++i) { v[i] = bf2f(r[lane + 64 * i]); ss += v[i] * v[i]; }
    ss = wave_sum(ss);
    const float rstd = rsqrtf(ss / (float)(64 * PER) + 1e-6f);
#pragma unroll
    for (int i = 0; i < PER; ++i) r[lane + 64 * i] = f2bf(v[i] * rstd * g[lane + 64 * i]);
  }
}

DI void phase_final(const P& p) {
  const int lane = otid() & 63, wave = otid() >> 6;
  const float* g = p.in[7];
  for (int row = blockIdx.x * 8 + wave; row < NLAT; row += gridDim.x * 8) {
    float* x = p.out + (size_t)row * 1024;
    f32x4 v[4]; float ss = 0.f;
#pragma unroll
    for (int i = 0; i < 4; ++i) { v[i] = ((const f32x4*)x)[lane + 64 * i]; ss += v[i].x * v[i].x + v[i].y * v[i].y + v[i].z * v[i].z + v[i].w * v[i].w; }
    ss = wave_sum(ss);
    const float rstd = rsqrtf(ss * (1.f / 1024.f) + 1e-6f);
#pragma unroll
    for (int i = 0; i < 4; ++i) {
      const int c = (lane + 64 * i) * 4;
      const float4 gv = *(const float4*)(g + c);
      float4 o; o.x = v[i].x * rstd * gv.x; o.y = v[i].y * rstd * gv.y; o.z = v[i].z * rstd * gv.z; o.w = v[i].w * rstd * gv.w;
      ((float4*)x)[lane + 64 * i] = o;
    }
  }
}

struct AttnItem {
  const bf16_t* Kbase; int kld;
  const bf16_t* Vt;
  int b; int a0, n1, n2;
  const bf16_t* Q; int qld;
  int qtok0; int qpos0;
  float minit, linit;
  bf16_t* og; int ocol;
  bool dry;
};

template <int DQK, int DV, bool MASK>
DI void attn_item(const AttnItem& a, char* smem) {
  constexpr int NKS = DQK / 32, NDB = DV / 16;
  constexpr int KBYTES = 64 * DQK * 2, VBYTES = DV * 64 * 2, STG = KBYTES + VBYTES;
  constexpr int KCH = KBYTES / 8192, VCH = VBYTES / 8192;
  const int tid = otid(), lane = tid & 63, lr = lane & 15, lq = lane >> 4;
  bf16x8 qf[2][NKS];
#pragma unroll
  for (int nb = 0; nb < 2; ++nb)
#pragma unroll
    for (int ks = 0; ks < NKS; ++ks) qf[nb][ks] = *(const bf16x8*)(a.Q + (size_t)(nb * 16 + lr) * a.qld + ks * 32 + lq * 8);
  f32x4 o[NDB][2];
#pragma unroll
  for (int i = 0; i < NDB; ++i) { o[i][0] = (f32x4){0.f, 0.f, 0.f, 0.f}; o[i][1] = (f32x4){0.f, 0.f, 0.f, 0.f}; }
  float m[2] = {a.minit, a.minit};
  float l[2] = {lq == 0 ? a.linit : 0.f, lq == 0 ? a.linit : 0.f};
  int kR[KCH], kC[KCH], vOff[VCH];
#pragma unroll
  for (int c = 0; c < KCH; ++c) {
    const int bb = tid * 16 + c * 8192, st = bb >> 10, sb = bb & 1023, swz = sb ^ (((sb >> 9) & 1) << 5);
    kR[c] = (st / NKS) * 16 + (swz >> 6); kC[c] = (st % NKS) * 32 + ((swz & 63) >> 1);
  }
#pragma unroll
  for (int c = 0; c < VCH; ++c) {
    const int bb = tid * 16 + c * 8192, st = bb >> 10, sb = bb & 1023, swz = sb ^ (((sb >> 9) & 1) << 5);
    vOff[c] = ((st >> 1) * 16 + (swz >> 6)) * KEYS + (st & 1) * 32 + ((swz & 63) >> 1);
  }
  const int ntile = a.n1 + a.n2;
#define ATT_STAGE(buf, i)                                                                                     \
  {                                                                                                           \
    const int kt_ = (i) < a.n1 ? a.a0 + (i) : 64 + ((i) - a.n1);                                              \
    const int key0_ = kt_ * 64;                                                                               \
    const int tokb_ = key0_ < SEQ ? a.b * SEQ + key0_ : NLAT + a.b * LCTX + (key0_ - SEQ);                    \
    char* sb_ = smem + (buf) * STG + tid * 16;                                                                \
    _Pragma("unroll") for (int c = 0; c < KCH; ++c)                                                           \
      __builtin_amdgcn_global_load_lds((const unsigned*)(a.Kbase + (size_t)(tokb_ + kR[c]) * a.kld + kC[c]),  \
                                       (__attribute__((address_space(3))) unsigned*)(sb_ + c * 8192), 16, 0, 0); \
    _Pragma("unroll") for (int c = 0; c < VCH; ++c)                                                           \
      __builtin_amdgcn_global_load_lds((const unsigned*)(a.Vt + vOff[c] + key0_),                             \
                                       (__attribute__((address_space(3))) unsigned*)(sb_ + KBYTES + c * 8192), 16, 0, 0); \
  }
  const int ob = lr * 64 + lq * 16;
  const int lane_off = ob ^ (((ob >> 9) & 1) << 5);
  __syncthreads();
  ATT_STAGE(0, 0);
  for (int it = 0; it < ntile; ++it) {
    asm volatile("s_waitcnt vmcnt(0)" ::: "memory");
    __builtin_amdgcn_s_barrier();
    if (it + 1 < ntile) ATT_STAGE((it + 1) & 1, it + 1);
    const char* sK = smem + (it & 1) * STG + lane_off;
    const char* sV = sK + KBYTES;
    f32x4 s[4][2];
#pragma unroll
    for (int kb = 0; kb < 4; ++kb) { s[kb][0] = (f32x4){0.f, 0.f, 0.f, 0.f}; s[kb][1] = (f32x4){0.f, 0.f, 0.f, 0.f}; }
#pragma unroll
    for (int ks = 0; ks < NKS; ++ks)
#pragma unroll
      for (int kb = 0; kb < 4; ++kb) {
        const bf16x8 kf = *(const bf16x8*)(sK + (kb * NKS + ks) * 1024);
        s[kb][0] = mfma16(kf, qf[0][ks], s[kb][0]);
        s[kb][1] = mfma16(kf, qf[1][ks], s[kb][1]);
      }
    if (MASK) {
      const int kt = it < a.n1 ? a.a0 + it : 64;
      const int dq = kt - (a.qpos0 >> 6);
      if (kt < 64 && (dq <= -2 || dq >= 2)) {
#pragma unroll
        for (int nb = 0; nb < 2; ++nb) {
          const int qp = a.qpos0 + nb * 16 + lr;
#pragma unroll
          for (int kb = 0; kb < 4; ++kb)
#pragma unroll
            for (int j = 0; j < 4; ++j) {
              const int kp = kt * 64 + kb * 16 + 4 * lq + j;
              const int dlt = kp - qp;
              if (dlt > 128 || dlt < -128) s[kb][nb][j] = -INFINITY;
            }
        }
      }
    }
    bf16x8 pf[2][2];
#pragma unroll
    for (int nb = 0; nb < 2; ++nb) {
      float mx = -INFINITY;
#pragma unroll
      for (int kb = 0; kb < 4; ++kb)
#pragma unroll
        for (int j = 0; j < 4; ++j) mx = fmaxf(mx, s[kb][nb][j]);
      mx = fmaxf(mx, __shfl_xor(mx, 16, 64));
      mx = fmaxf(mx, __shfl_xor(mx, 32, 64));
      const float mn = fmaxf(m[nb], mx);
      const float alpha = __builtin_amdgcn_exp2f(m[nb] - mn);
      m[nb] = mn;
      float rs = 0.f;
      float pv[4][4];
#pragma unroll
      for (int kb = 0; kb < 4; ++kb)
#pragma unroll
        for (int j = 0; j < 4; ++j) { pv[kb][j] = __builtin_amdgcn_exp2f(s[kb][nb][j] - mn); rs += pv[kb][j]; }
      l[nb] = l[nb] * alpha + rs;
#pragma unroll
      for (int st = 0; st < 2; ++st) {
        u32x4 u;
        u.x = pack2(pv[2 * st][0], pv[2 * st][1]); u.y = pack2(pv[2 * st][2], pv[2 * st][3]);
        u.z = pack2(pv[2 * st + 1][0], pv[2 * st + 1][1]); u.w = pack2(pv[2 * st + 1][2], pv[2 * st + 1][3]);
        pf[nb][st] = __builtin_bit_cast(bf16x8, u);
      }
      if (__builtin_amdgcn_ballot_w64(alpha != 1.f) != 0ull) {
#pragma unroll
        for (int db = 0; db < NDB; ++db) { o[db][nb][0] *= alpha; o[db][nb][1] *= alpha; o[db][nb][2] *= alpha; o[db][nb][3] *= alpha; }
      }
    }
#pragma unroll
    for (int st = 0; st < 2; ++st)
#pragma unroll
      for (int db = 0; db < NDB; ++db) {
        const bf16x8 vf = *(const bf16x8*)(sV + (db * 2 + st) * 1024);
        o[db][0] = mfma16(vf, pf[0][st], o[db][0]);
        o[db][1] = mfma16(vf, pf[1][st], o[db][1]);
      }
  }
#undef ATT_STAGE
  if (a.dry) return;
#pragma unroll
  for (int nb = 0; nb < 2; ++nb) {
    float lt = l[nb];
    lt += __shfl_xor(lt, 16, 64);
    lt += __shfl_xor(lt, 32, 64);
    const float inv = 1.f / lt;
    const int tok = a.qtok0 + nb * 16 + lr;
#pragma unroll
    for (int db = 0; db < NDB; ++db) {
      bf16_t* dst = a.og + (size_t)tok * 1024 + a.ocol + db * 16 + 4 * lq;
      const uint2 g = *(const uint2*)dst;
      const float g0 = __uint_as_float(g.x << 16), g1 = __uint_as_float(g.x & 0xffff0000u);
      const float g2 = __uint_as_float(g.y << 16), g3 = __uint_as_float(g.y & 0xffff0000u);
      store4bf(dst, o[db][nb][0] * inv * g0, o[db][nb][1] * inv * g1, o[db][nb][2] * inv * g2, o[db][nb][3] * inv * g3);
    }
  }
}

DI void phase_mla_attn(const P& p, char* smem, bool dry) {
  const int wave = otid() >> 6;
  const bf16_t* q = (const bf16_t*)(p.ws + O_Q);
  const bf16_t* kp = (const bf16_t*)(p.ws + O_KP);
  const bf16_t* vt = (const bf16_t*)(p.ws + O_ACT);
  bf16_t* og = (bf16_t*)(p.ws + O_SG0);
  const int xcd = blockIdx.x & 7, lb = blockIdx.x >> 3, nlb = (gridDim.x - xcd + 7) >> 3;
  for (int li = lb; li < 68; li += nlb) {
    AttnItem a;
    int b, h, qtok;
    if (li < 64) { const int pair = (li >> 4) * 8 + xcd; b = pair >> 3; h = pair & 7; qtok = b * SEQ + (li & 15) * 256; a.a0 = 0; a.n1 = 64; }
    else { const int pair = (li - 64) * 8 + xcd; b = pair >> 3; h = pair & 7; qtok = NLAT + b * LCTX; a.a0 = 0; a.n1 = 0; }
    a.n2 = 4; a.b = b;
    a.Kbase = kp + h * 192; a.kld = 1536;
    a.Vt = vt + (size_t)(b * 8 + h) * 128 * KEYS;
    a.qtok0 = qtok + wave * 32; a.qpos0 = 0;
    a.Q = q + (size_t)a.qtok0 * 1536 + h * 192; a.qld = 1536;
    a.minit = -INFINITY; a.linit = 0.f;
    a.og = og; a.ocol = h * 128; a.dry = dry;
    attn_item<192, 128, false>(a, smem);
  }
}

DI void phase_swa_attn(const P& p, char* smem, bool dry) {
  const int wave = otid() >> 6;
  const bf16_t* qs = (const bf16_t*)(p.ws + O_QS);
  const bf16_t* ks = (const bf16_t*)(p.ws + O_KS);
  const bf16_t* vt = (const bf16_t*)(p.ws + O_VT2);
  bf16_t* og = (bf16_t*)(p.ws + O_SG2);
  const float* sink = p.in[25];
  for (int it = blockIdx.x; it < 1024; it += gridDim.x) {
    AttnItem a;
    int b, g, qtok, pos0;
    if (it < 1024) {
      b = it >> 8; g = (it >> 6) & 3; const int qb = it & 63;
      pos0 = qb * 64; qtok = b * SEQ + pos0;
      a.a0 = qb - 2 < 0 ? 0 : qb - 2; const int a1 = qb + 3 > 64 ? 64 : qb + 3; a.n1 = a1 - a.a0;
    } else {
      const int j = it - 1024; b = j >> 4; g = (j >> 2) & 3; pos0 = (j & 3) * 64; qtok = NLAT + b * LCTX + pos0;
      a.a0 = 0; a.n1 = 0;
    }
    const int head = g * 4 + (wave >> 1);
    a.n2 = 4; a.b = b;
    a.Kbase = ks + g * 64; a.kld = 256;
    a.Vt = vt + (size_t)(b * 4 + g) * 64 * KEYS;
    a.qtok0 = qtok + (wave & 1) * 32; a.qpos0 = pos0 + (wave & 1) * 32;
    a.Q = qs + (size_t)a.qtok0 * 1024 + head * 64; a.qld = 1024;
    a.minit = sink[head] * LOG2E; a.linit = 1.f;
    a.og = og; a.ocol = head * 64; a.dry = dry;
    attn_item<64, 64, true>(a, smem);
  }
}

typedef f32x2 c32;
DI c32 cmul(c32 a, c32 b) { return (c32){a.x * b.x - a.y * b.y, a.x * b.y + a.y * b.x}; }
DI c32 cmulc(c32 a, c32 b) { return (c32){a.x * b.x + a.y * b.y, a.y * b.x - a.x * b.y}; }
DI int phys(int i) { return i + (i >> 5); }
DI c32 w16(int k) {
  const float c1 = 0.9238795325112867f, s1 = 0.3826834323650898f, r = 0.7071067811865476f;
  switch (k & 7) {
    case 0: return (c32){1.f, 0.f};
    case 1: return (c32){c1, -s1};
    case 2: return (c32){r, -r};
    case 3: return (c32){s1, -c1};
    case 4: return (c32){0.f, -1.f};
    case 5: return (c32){-s1, -c1};
    case 6: return (c32){-r, -r};
    default: return (c32){-c1, -s1};
  }
}
DI c32 w16g(int m) {
  const c32 w = w16(m & 7);
  return (m & 8) ? (c32){-w.x, -w.y} : w;
}
template <bool ZHI>
DI void r4_fwd(c32& x0, c32& x1, c32& x2, c32& x3, c32 t1, c32 t2, c32 t3) {
  const c32 s02 = ZHI ? x0 : x0 + x2, s13 = ZHI ? x1 : x1 + x3, d02 = ZHI ? x0 : x0 - x2, d13 = ZHI ? x1 : x1 - x3;
  const c32 e = (c32){d13.y, -d13.x};
  x0 = s02 + s13; x1 = cmul(s02 - s13, t1); x2 = cmul(d02 + e, t2); x3 = cmul(d02 - e, t3);
}
template <bool LOONLY>
DI void r4_inv(c32& x0, c32& x1, c32& x2, c32& x3, c32 t1, c32 t2, c32 t3) {
  const c32 p1 = cmulc(x1, t1), p2 = cmulc(x2, t2), p3 = cmulc(x3, t3);
  const c32 a = x0 + p1, b = x0 - p1, c = p2 + p3, dd = p2 - p3;
  const c32 d = (c32){-dd.y, dd.x};
  x0 = a + c; x1 = b + d;
  if (!LOONLY) { x2 = a - c; x3 = b - d; }
}
template <bool ZHI>
DI void fft16_fwd2(c32 (&v0)[16], c32 (&v1)[16], c32 w1) {
  const c32 w2 = cmul(w1, w1), w3 = cmul(w1, w2), w4 = cmul(w2, w2), w8 = cmul(w4, w4), w48 = cmul(w4, w8);
#pragma unroll
  for (int k = 0; k < 4; ++k) {
    const c32 tB = k ? cmul(w2, w16g(2 * k)) : w2, tA = k ? cmul(w1, w16g(k)) : w1, tAB = k ? cmul(w3, w16g(3 * k)) : w3;
    r4_fwd<ZHI>(v0[k], v0[k + 4], v0[k + 8], v0[k + 12], tB, tA, tAB);
    r4_fwd<ZHI>(v1[k], v1[k + 4], v1[k + 8], v1[k + 12], tB, tA, tAB);
  }
#pragma unroll
  for (int q = 0; q < 16; q += 4) {
    r4_fwd<false>(v0[q], v0[q + 1], v0[q + 2], v0[q + 3], w8, w4, w48);
    r4_fwd<false>(v1[q], v1[q + 1], v1[q + 2], v1[q + 3], w8, w4, w48);
  }
}
template <bool LOONLY>
DI void fft16_inv2(c32 (&v0)[16], c32 (&v1)[16], c32 w1) {
  const c32 w2 = cmul(w1, w1), w3 = cmul(w1, w2), w4 = cmul(w2, w2), w8 = cmul(w4, w4), w48 = cmul(w4, w8);
#pragma unroll
  for (int q = 0; q < 16; q += 4) {
    r4_inv<false>(v0[q], v0[q + 1], v0[q + 2], v0[q + 3], w8, w4, w48);
    r4_inv<false>(v1[q], v1[q + 1], v1[q + 2], v1[q + 3], w8, w4, w48);
  }
#pragma unroll
  for (int k = 0; k < 4; ++k) {
    const c32 tB = k ? cmul(w2, w16g(2 * k)) : w2, tA = k ? cmul(w1, w16g(k)) : w1, tAB = k ? cmul(w3, w16g(3 * k)) : w3;
    r4_inv<LOONLY>(v0[k], v0[k + 4], v0[k + 8], v0[k + 12], tB, tA, tAB);
    r4_inv<LOONLY>(v1[k], v1[k + 4], v1[k + 8], v1[k + 12], tB, tA, tAB);
  }
}
template <int H, bool INV, bool PRUNE>
DI void fft_pass16(c32* X0, c32* X1) {
  constexpr int ST = H / 16;
  const int tid = otid();
  const int jb = tid & (ST - 1), base = (tid / ST) * H + jb;
  c32 v0[16], v1[16];
  constexpr int NLD = (PRUNE && !INV) ? 8 : 16, NSTR = (PRUNE && INV) ? 8 : 16;
#pragma unroll
  for (int k = 0; k < NLD; ++k) { v0[k] = X0[phys(base + k * ST)]; v1[k] = X1[phys(base + k * ST)]; }
#pragma unroll
  for (int k = NLD; k < 16; ++k) { v0[k] = (c32){0.f, 0.f}; v1[k] = (c32){0.f, 0.f}; }
  const float fr = (float)jb * (1.f / (float)H);
  const c32 w1 = (c32){__builtin_amdgcn_cosf(fr), -__builtin_amdgcn_sinf(fr)};
  if (INV) fft16_inv2<PRUNE>(v0, v1, w1); else fft16_fwd2<PRUNE>(v0, v1, w1);
#pragma unroll
  for (int k = 0; k < NSTR; ++k) { X0[phys(base + k * ST)] = v0[k]; X1[phys(base + k * ST)] = v1[k]; }
  __syncthreads();
}
DI void fft_pass2(c32* X0, c32* X1) {
  const int tid = otid();
#pragma unroll
  for (int i = 0; i < 8; ++i) {
    const int i0 = phys(2 * (tid + NT * i));
    const c32 a = X0[i0], b = X0[i0 + 1], c = X1[i0], d = X1[i0 + 1];
    X0[i0] = a + b; X0[i0 + 1] = a - b; X1[i0] = c + d; X1[i0 + 1] = c - d;
  }
  __syncthreads();
}
template <bool PRUNE>
DI void fft_fwd(c32* X0, c32* X1) { fft_pass16<8192, false, PRUNE>(X0, X1); fft_pass16<512, false, false>(X0, X1); fft_pass16<32, false, false>(X0, X1); fft_pass2(X0, X1); }
DI void fft_conv(c32* X0, c32* X1, const c32* __restrict__ Ks) {
  fft_pass16<8192, false, true>(X0, X1); fft_pass16<512, false, false>(X0, X1); fft_pass16<32, false, false>(X0, X1);
  {
    const int tid = otid();
#pragma unroll
    for (int i = 0; i < 8; ++i) {
      const int mm = tid + NT * i, i0 = phys(2 * mm);
      const f32x4 kk = *(const f32x4*)(Ks + 2 * mm);
      const c32 k0 = (c32){kk.x, kk.y}, k1 = (c32){kk.z, kk.w};
      const c32 a = X0[i0], b = X0[i0 + 1], c = X1[i0], d = X1[i0 + 1];
      const c32 pa = cmul(a + b, k0), pb = cmul(a - b, k1), pc = cmul(c + d, k0), pd = cmul(c - d, k1);
      X0[i0] = pa + pb; X0[i0 + 1] = pa - pb; X1[i0] = pc + pd; X1[i0 + 1] = pc - pd;
    }
    __syncthreads();
  }
  fft_pass16<32, true, false>(X0, X1); fft_pass16<512, true, false>(X0, X1); fft_pass16<8192, true, true>(X0, X1);
}
DI void spec_mul(c32* X0, c32* X1, const c32* __restrict__ Ks) {
  const int tid = otid();
#pragma unroll 8
  for (int i = 0; i < 16; ++i) {
    const c32 k = Ks[tid + NT * i];
    const int n = phys(tid + NT * i);
    X0[n] = cmul(X0[n], k); X1[n] = cmul(X1[n], k);
  }
  __syncthreads();
}
DI float sconv(const bf16_t* u, int t, int len, float w0, float w1, float w2, float cb) {
  float r = cb + w1 * bf2f(u[t]);
  if (t > 0) r += w0 * bf2f(u[t - 1]);
  if (t + 1 < len) r += w2 * bf2f(u[t + 1]);
  return r;
}

DI void sconv8(const bf16_t* u, int t0, int len, float w0, float w1, float w2, float cb, float (&out)[8]) {
  const u32x4 raw = *(const u32x4*)(u + t0);
  float x[10];
  x[0] = t0 > 0 ? bf2f(u[t0 - 1]) : 0.f;
  x[9] = t0 + 8 < len ? bf2f(u[t0 + 8]) : 0.f;
#pragma unroll
  for (int i = 0; i < 4; ++i) { x[1 + 2 * i] = __uint_as_float(raw[i] << 16); x[2 + 2 * i] = __uint_as_float(raw[i] & 0xffff0000u); }
#pragma unroll
  for (int i = 0; i < 8; ++i) out[i] = cb + w0 * x[i] + w1 * x[i + 1] + w2 * x[i + 2];
}

DI void phase_hyena(const P& p, char* smem, float* aux, bool dry) {
  const int tid = otid();
  c32* X0 = (c32*)smem; c32* X1 = (c32*)(smem + 67584);
  bf16_t* ut = (bf16_t*)(p.ws + O_UT);
  const float* hdn = (const float*)(p.ws + O_HDN);
  const float* hdnc = (const float*)(p.ws + O_HDNC);
  c32* Ksp = (c32*)(p.ws + O_FFT + (size_t)blockIdx.x * 131072);
  const float* cw = p.in[15];
  const float* cbv = p.in[16];
  const float* fwo = p.in[21];
  const float* hb = p.in[22];
  for (int c = blockIdx.x; c < 1024; c += gridDim.x) {
    __syncthreads();
    { const int ta = otid(); if (ta < 256) aux[ta] = fwo[(size_t)(ta >> 2) * 4096 + (ta & 3) * 1024 + c]; }
    __syncthreads();
    const float la0 = -15.350567286626973f, la1 = -3.0701134573253945f;
    const float delta = fabsf(la0 + (la1 - la0) * ((float)c / 1023.f));
    const float bias0 = hb[c], bias1 = hb[1024 + c];
    float w0[3], w1[3], w2[3], cb[3];
#pragma unroll
    for (int r = 0; r < 3; ++r) { const int f = r * 1024 + c; w0[r] = cw[f]; w1[r] = cw[3072 + f]; w2[r] = cw[6144 + f]; cb[r] = cbv[f]; }
    const int t0 = tid * 8;
    {
      const int lane = tid & 63, wv = tid >> 6, lr = lane & 15, lq = lane >> 4;
      const bf16_t* hdnb = (const bf16_t*)(p.ws + O_HDNB);
      bf16x8 bfr[2];
#pragma unroll
      for (int ks = 0; ks < 2; ++ks) {
        u32x4 u;
#pragma unroll
        for (int e = 0; e < 4; ++e) {
          const int j0 = ks * 32 + lq * 8 + 2 * e;
          const float wa = lr < 4 ? aux[j0 * 4 + lr] : 0.f, wb = lr < 4 ? aux[(j0 + 1) * 4 + lr] : 0.f;
          u[e] = pack2(wa, wb);
        }
        bfr[ks] = __builtin_bit_cast(bf16x8, u);
      }
      const int o = (lr >> 1) & 1, dir = lr & 1;
      c32* Xo = o ? X1 : X0;
#pragma unroll 1
      for (int mb0 = 0; mb0 < 32; mb0 += 8) {
        bf16x8 a0[8], a1[8];
#pragma unroll
        for (int i = 0; i < 8; ++i) {
          const bf16_t* src = hdnb + (size_t)((wv * 32 + mb0 + i) * 16 + lr) * 64 + lq * 8;
          a0[i] = *(const bf16x8*)src; a1[i] = *(const bf16x8*)(src + 32);
        }
#pragma unroll
        for (int i = 0; i < 8; ++i) {
          f32x4 cc = (f32x4){0.f, 0.f, 0.f, 0.f};
          cc = mfma16(a0[i], bfr[0], cc);
          cc = mfma16(a1[i], bfr[1], cc);
#pragma unroll
          for (int j = 0; j < 4; ++j) {
            const int t = (wv * 32 + mb0 + i) * 16 + 4 * lq + j;
            const float val = cc[j] * __expf(-((float)t / 4095.f) * delta);
            const float partner = __shfl_xor(val, 1, 64);
            if (lr < 4) {
              if (t == 0) { if (dir == 0) Xo[0] = (c32){val + partner, 0.f}; else Xo[phys(4096)] = (c32){0.f, 0.f}; }
              else Xo[phys(dir ? 8192 - t : t)] = (c32){val, 0.f};
            }
          }
        }
      }
      __syncthreads();
      fft_fwd<false>(X0, X1);
#pragma unroll 4
      for (int i = 0; i < 16; ++i) { Ksp[tid + NT * i] = X0[phys(tid + NT * i)]; Ksp[8192 + tid + NT * i] = X1[phys(tid + NT * i)]; }
      __syncthreads();
    }
    const bf16_t* uv = ut + (size_t)c * NTOK;
    const bf16_t* ug0 = ut + (size_t)(1024 + c) * NTOK;
    const bf16_t* ug1 = ut + (size_t)(2048 + c) * NTOK;
    bf16_t* usg = ut + (size_t)(3072 + c) * NTOK;
    {
      float z[4][8], g[4][8];
#pragma unroll
      for (int bb = 0; bb < 4; ++bb) sconv8(uv + bb * SEQ, t0, SEQ, w0[0], w1[0], w2[0], cb[0], z[bb]);
#pragma unroll
      for (int i = 0; i < 8; ++i) {
        X0[phys(t0 + i)] = (c32){z[0][i], z[1][i]};
        X1[phys(t0 + i)] = (c32){z[2][i], z[3][i]};
      }
      __syncthreads();
      fft_conv(X0, X1, Ksp);
      const int t0b = otid() * 8;
#pragma unroll
      for (int bb = 0; bb < 4; ++bb) sconv8(ug0 + bb * SEQ, t0b, SEQ, w0[1], w1[1], w2[1], cb[1], g[bb]);
#pragma unroll
      for (int i = 0; i < 8; ++i) {
        const c32 y0 = X0[phys(t0b + i)], y1 = X1[phys(t0b + i)];
        z[0][i] = g[0][i] * (y0.x * (1.f / 8192.f) + z[0][i] * bias0);
        z[1][i] = g[1][i] * (y0.y * (1.f / 8192.f) + z[1][i] * bias0);
        z[2][i] = g[2][i] * (y1.x * (1.f / 8192.f) + z[2][i] * bias0);
        z[3][i] = g[3][i] * (y1.y * (1.f / 8192.f) + z[3][i] * bias0);
      }
      __syncthreads();
#pragma unroll
      for (int i = 0; i < 8; ++i) {
        X0[phys(t0b + i)] = (c32){z[0][i], z[1][i]};
        X1[phys(t0b + i)] = (c32){z[2][i], z[3][i]};
      }
      __syncthreads();
      fft_conv(X0, X1, Ksp + 8192);
      const int t0c = otid() * 8;
#pragma unroll
      for (int bb = 0; bb < 4; ++bb) sconv8(ug1 + bb * SEQ, t0c, SEQ, w0[2], w1[2], w2[2], cb[2], g[bb]);
#pragma unroll
      for (int bb = 0; bb < 4; ++bb) {
        const u32x4 sgv = *(const u32x4*)(usg + bb * SEQ + t0c);
        float oo[8];
#pragma unroll
        for (int i = 0; i < 8; ++i) {
          const c32 y = (bb < 2) ? X0[phys(t0c + i)] : X1[phys(t0c + i)];
          const float yy = (bb & 1) ? y.y : y.x;
          const float zz = g[bb][i] * (yy * (1.f / 8192.f) + z[bb][i] * bias1);
          const unsigned ra = sgv[i >> 1];
          const float fa = (i & 1) ? __uint_as_float(ra & 0xffff0000u) : __uint_as_float(ra << 16);
          oo[i] = zz * fa;
        }
        u32x4 wv;
        wv.x = pack2(oo[0], oo[1]); wv.y = pack2(oo[2], oo[3]); wv.z = pack2(oo[4], oo[5]); wv.w = pack2(oo[6], oo[7]);
        if (!dry) *(u32x4*)(usg + bb * SEQ + t0c) = wv;
      }
      __syncthreads();
    }
  }
  for (int cb0 = blockIdx.x; cb0 < 1024; cb0 += 4 * gridDim.x) {
    float* aux4 = (float*)smem;
    float* klag = aux4 + 1024;
    f32x4* su = (f32x4*)(klag + 4096);
    f32x4* sz4 = su + 1024;
    f32x4* part = sz4 + 1024;
    int cch[4];
#pragma unroll
    for (int ch = 0; ch < 4; ++ch) { const int cc = cb0 + ch * gridDim.x; cch[ch] = cc < 1024 ? cc : cb0; }
    __syncthreads();
    {
      const int ta = otid();
      if (ta < 256) {
#pragma unroll
        for (int ch = 0; ch < 4; ++ch) aux4[ch * 256 + ta] = fwo[(size_t)(ta >> 2) * 4096 + (ta & 3) * 1024 + cch[ch]];
      }
    }
    __syncthreads();
    {
      const int tf = otid();
      const int t = tf & 255, o = tf >> 8;
      float a0[4] = {0.f, 0.f, 0.f, 0.f}, a1[4] = {0.f, 0.f, 0.f, 0.f};
#pragma unroll 16
      for (int j = 0; j < 64; ++j) {
        const float hv = hdnc[j * LCTX + t];
#pragma unroll
        for (int ch = 0; ch < 4; ++ch) { a0[ch] += hv * aux4[ch * 256 + j * 4 + 2 * o]; a1[ch] += hv * aux4[ch * 256 + j * 4 + 2 * o + 1]; }
      }
#pragma unroll
      for (int ch = 0; ch < 4; ++ch) {
        const float la0 = -15.350567286626973f, la1 = -3.0701134573253945f;
        const float delta = fabsf(la0 + (la1 - la0) * ((float)cch[ch] / 1023.f));
        const float dec = __expf(-((float)t / 255.f) * delta);
        float* kl = klag + ch * 1024 + o * 512;
        if (t == 0) kl[255] = (a0[ch] + a1[ch]) * dec;
        else { kl[255 + t] = a0[ch] * dec; kl[255 - t] = a1[ch] * dec; }
      }
    }
    const int tc = otid();
    const int t = tc & 255, half = tc >> 8;
    float vreg[4][2], g0r[4][2], g1r[4][2], z1[4][2];
#pragma unroll
    for (int ch = 0; ch < 4; ++ch) {
      const int c = cch[ch];
      const bf16_t* uv = ut + (size_t)c * NTOK;
      const bf16_t* ug0 = ut + (size_t)(1024 + c) * NTOK;
      const bf16_t* ug1 = ut + (size_t)(2048 + c) * NTOK;
#pragma unroll
      for (int i = 0; i < 2; ++i) {
        const int base = NLAT + (2 * half + i) * LCTX;
        vreg[ch][i] = sconv(uv + base, t, LCTX, cw[c], cw[3072 + c], cw[6144 + c], cbv[c]);
        g0r[ch][i] = sconv(ug0 + base, t, LCTX, cw[1024 + c], cw[3072 + 1024 + c], cw[6144 + 1024 + c], cbv[1024 + c]);
        g1r[ch][i] = sconv(ug1 + base, t, LCTX, cw[2048 + c], cw[3072 + 2048 + c], cw[6144 + 2048 + c], cbv[2048 + c]);
        ((float*)(su + ch * 256))[t * 4 + 2 * half + i] = vreg[ch][i];
      }
    }
    __syncthreads();
#pragma unroll
    for (int o = 0; o < 2; ++o) {
#pragma unroll
      for (int ch = 0; ch < 4; ++ch) {
        const f32x4* src = (o == 0 ? su : sz4) + ch * 256;
        const float* kl = klag + ch * 1024 + o * 512 + t + 255 - half * 128;
        f32x4 acc = (f32x4){0.f, 0.f, 0.f, 0.f};
#pragma unroll 8
        for (int s2 = 0; s2 < 128; ++s2) acc += kl[-s2] * src[half * 128 + s2];
        part[ch * 512 + half * 256 + t] = acc;
      }
      __syncthreads();
#pragma unroll
      for (int ch = 0; ch < 4; ++ch) {
        const int c = cch[ch];
        const f32x4 p0 = part[ch * 512 + t], p1 = part[ch * 512 + 256 + t];
        const float bias0 = hb[c], bias1 = hb[1024 + c];
        bf16_t* usg = ut + (size_t)(3072 + c) * NTOK;
#pragma unroll
        for (int i = 0; i < 2; ++i) {
          const int bsel = 2 * half + i;
          const float y = (bsel == 0 ? p0.x + p1.x : bsel == 1 ? p0.y + p1.y : bsel == 2 ? p0.z + p1.z : p0.w + p1.w);
          if (o == 0) {
            z1[ch][i] = g0r[ch][i] * (y + vreg[ch][i] * bias0);
            ((float*)(sz4 + ch * 256))[t * 4 + bsel] = z1[ch][i];
          } else {
            const float z2 = g1r[ch][i] * (y + z1[ch][i] * bias1);
            const int tok = NLAT + bsel * LCTX + t;
            if (!dry && (ch == 0 || cb0 + ch * (int)gridDim.x < 1024)) usg[tok] = f2bf(z2 * bf2f(usg[tok]));
          }
        }
      }
      __syncthreads();
    }
  }
}

DI void phase_hy_transpose(const P& p, char* smem) {
  const int tid = otid();
  const bf16_t* z = (const bf16_t*)(p.ws + O_UT) + (size_t)3072 * NTOK;
  bf16_t* og = (bf16_t*)(p.ws + O_ACT);
  bf16_t* tile = (bf16_t*)smem;
  for (int t = blockIdx.x; t < 272 * 16; t += gridDim.x) {
    const int tk0 = (t >> 4) * 64, c0 = (t & 15) * 64;
    __syncthreads();
    { const int ch = tid >> 3, kc = tid & 7;
      *(u32x4*)(tile + ch * 72 + kc * 8) = *(const u32x4*)(z + (size_t)(c0 + ch) * NTOK + tk0 + kc * 8); }
    __syncthreads();
    { const int tk = tid >> 3, cc = tid & 7;
      u32x4 v;
      v.x = (unsigned)tile[(cc * 8 + 0) * 72 + tk] | ((unsigned)tile[(cc * 8 + 1) * 72 + tk] << 16);
      v.y = (unsigned)tile[(cc * 8 + 2) * 72 + tk] | ((unsigned)tile[(cc * 8 + 3) * 72 + tk] << 16);
      v.z = (unsigned)tile[(cc * 8 + 4) * 72 + tk] | ((unsigned)tile[(cc * 8 + 5) * 72 + tk] << 16);
      v.w = (unsigned)tile[(cc * 8 + 6) * 72 + tk] | ((unsigned)tile[(cc * 8 + 7) * 72 + tk] << 16);
      *(u32x4*)(og + (size_t)(tk0 + tk) * 1024 + c0 + cc * 8) = v; }
  }
}

DI void phase_cfconv(const P& p, char* smem) {
  const int tid = otid(), lane = tid & 63, wave = tid >> 6;
  const bf16_t* u3 = (const bf16_t*)(p.ws + O_U3);
  const bf16_t* sg = (const bf16_t*)(p.ws + O_SG3);
  bf16_t* og = (bf16_t*)(p.ws + O_ACT);
  float* red = (float*)smem;
  float* red2 = red + 256;
  const int c0 = tid * 2;
  float w[31][2];
#pragma unroll
  for (int k = 0; k < 31; ++k) { const float2 t = *(const float2*)(p.in[28] + k * 1024 + c0); w[k][0] = t.x; w[k][1] = t.y; }
  const float2 bb = *(const float2*)(p.in[29] + c0), lg = *(const float2*)(p.in[30] + c0), lb = *(const float2*)(p.in[31] + c0);
  for (int tile = blockIdx.x; tile < 1024; tile += gridDim.x) {
    const int tok0 = tile * 16, b = tok0 >> 12, pos0 = tok0 & 4095;
    float acc[16][2];
#pragma unroll
    for (int o = 0; o < 16; ++o) { acc[o][0] = bb.x; acc[o][1] = bb.y; }
#pragma unroll
    for (int r = 0; r < 46; ++r) {
      const int pos = pos0 - 15 + r;
      const int pc = pos < 0 ? 0 : (pos > 4095 ? 4095 : pos);
      unsigned raw = *(const unsigned*)(u3 + (size_t)(b * SEQ + pc) * 1024 + c0);
      if (pos != pc) raw = 0u;
      const float x0 = __uint_as_float(raw << 16), x1 = __uint_as_float(raw & 0xffff0000u);
#pragma unroll
      for (int o = 0; o < 16; ++o) {
        const int j = r - o;
        if (j >= 0 && j <= 30) { acc[o][0] += w[j][0] * x0; acc[o][1] += w[j][1] * x1; }
      }
    }
    __syncthreads();
#pragma unroll
    for (int o = 0; o < 16; ++o) {
      float s1 = acc[o][0] + acc[o][1];
      float s2 = acc[o][0] * acc[o][0] + acc[o][1] * acc[o][1];
      s1 = wave_sum(s1); s2 = wave_sum(s2);
      if (lane == 0) { red[wave * 32 + o] = s1; red[wave * 32 + 16 + o] = s2; }
    }
    __syncthreads();
    if (tid < 32) {
      float s = 0.f;
#pragma unroll
      for (int w8 = 0; w8 < 8; ++w8) s += red[w8 * 32 + tid];
      red2[tid] = s;
    }
    __syncthreads();
#pragma unroll
    for (int o = 0; o < 16; ++o) {
      const float mean = red2[o] * (1.f / 1024.f);
      const float var = red2[16 + o] * (1.f / 1024.f) - mean * mean;
      const float rstd = rsqrtf(fmaxf(var, 0.f) + 1e-6f);
      const int tok = tok0 + o;
      const unsigned graw = *(const unsigned*)(sg + (size_t)tok * 1024 + c0);
      const float y0 = siluf((acc[o][0] - mean) * rstd * lg.x + lb.x) * __uint_as_float(graw << 16);
      const float y1 = siluf((acc[o][1] - mean) * rstd * lg.y + lb.y) * __uint_as_float(graw & 0xffff0000u);
      *(unsigned*)(og + (size_t)tok * 1024 + c0) = pack2(y0, y1);
    }
  }
}


#define XB_TMO      128
#define XB_XCNT(j)  (256  + 64 * (j))
#define XB_XSUB(j)  (1280 + 64 * (j))
#define XB_XGEN(j)  (2304 + 64 * (j))
#define XB_TOP      3328
#define XB_TOPGEN   3392
#define XCD_BAR_WORDS 3456
#define XB_SPIN_CAP (1u << 22)
#define LAS __attribute__((address_space(3)))
DI unsigned xb_ld(unsigned* p) { return __hip_atomic_load(p, __ATOMIC_RELAXED, __HIP_MEMORY_SCOPE_AGENT); }
DI unsigned xb_add(unsigned* p, unsigned v) { return __hip_atomic_fetch_add(p, v, __ATOMIC_RELAXED, __HIP_MEMORY_SCOPE_AGENT); }
DI unsigned xb_xcc_id() { return (unsigned)__builtin_amdgcn_s_getreg((3 << 11) | 20) & 0xFu; }
#define XB_SPIN(cond, bar) do { unsigned _sp = 0; while (cond) { __builtin_amdgcn_s_sleep(1); \
    if ((++_sp & 255u) == 0u) { if (xb_ld(&(bar)[XB_TMO])) break; if (_sp > XB_SPIN_CAP) { atomicAdd(&(bar)[XB_TMO], 1u); break; } } } } while (0)
struct XcdBarrier { unsigned* bar; unsigned x; volatile LAS unsigned* st; };
DI XcdBarrier xcd_barrier_post(unsigned* bar, volatile LAS unsigned* st) {
  XcdBarrier b; b.bar = bar; b.x = xb_xcc_id(); b.st = st;
  if (threadIdx.x == 0) (void)xb_add(&bar[XB_XCNT(b.x)], 1u);
  return b;
}
DI void xcd_barrier_complete(unsigned* bar, unsigned x, unsigned& nloc, unsigned& nx) {
  const unsigned G = gridDim.x * gridDim.y * gridDim.z;
  unsigned sum, cnt, mine, sp = 0u;
  for (;;) {
    sum = 0u; cnt = 0u; mine = 0u;
#pragma unroll
    for (unsigned j = 0; j < 16; ++j) { const unsigned c = xb_ld(&bar[XB_XCNT(j)]); sum += c; cnt += (c > 0u) ? 1u : 0u; mine = (j == x) ? c : mine; }
    if (sum == G) break;
    __builtin_amdgcn_s_sleep(1);
    if ((++sp & 255u) == 0u) { if (xb_ld(&bar[XB_TMO])) break; if (sp > XB_SPIN_CAP) { atomicAdd(&bar[XB_TMO], 1u); break; } }
  }
  nloc = mine > 0u ? mine : 1u; nx = cnt > 0u ? cnt : 1u;
}
__device__ __attribute__((noinline)) void xcd_barrier(unsigned* bbar, unsigned bx, volatile LAS unsigned* bst, bool leader) {
  XcdBarrier b; b.bar = bbar; b.x = bx; b.st = bst;
  asm volatile("s_waitcnt vmcnt(0)" ::: "memory");
  __syncthreads();
  if (leader) {
    unsigned* bar = b.bar;
    __builtin_amdgcn_s_waitcnt(0);
    unsigned nloc = b.st[0], nx = b.st[1];
    if (nloc == 0u) { xcd_barrier_complete(bar, b.x, nloc, nx); b.st[0] = nloc; b.st[1] = nx; }
    const unsigned old = xb_add(&bar[XB_XSUB(b.x)], 1u);
    const unsigned gen = old / nloc;
    if (old + 1u == (gen + 1u) * nloc) {
      __builtin_amdgcn_fence(__ATOMIC_RELEASE, "agent");
      asm volatile("s_waitcnt vmcnt(0)" ::: "memory");
      const unsigned og = xb_add(&bar[XB_TOP], 1u);
      const unsigned tg = og / nx;
      if (og + 1u == (tg + 1u) * nx) xb_add(&bar[XB_TOPGEN], 1u);
      else XB_SPIN(xb_ld(&bar[XB_TOPGEN]) == tg, bar);
      __builtin_amdgcn_fence(__ATOMIC_ACQUIRE, "agent");
      xb_add(&bar[XB_XGEN(b.x)], 1u);
      asm volatile("s_waitcnt vmcnt(0)" ::: "memory");
    } else {
      XB_SPIN(xb_ld(&bar[XB_XGEN(b.x)]) == gen, bar);
      __builtin_amdgcn_fence(__ATOMIC_ACQUIRE, "agent");
      asm volatile("s_waitcnt vmcnt(0)" ::: "memory");
    }
  }
  __syncthreads();
}

__global__ void __launch_bounds__(NT) mega(P p) {
  cg::grid_group grid = cg::this_grid();
  extern __shared__ __attribute__((aligned(16))) char smem[];
  __shared__ float aux[256];
  __shared__ uint4 xb_words;
  if (threadIdx.x == 0) xb_words = make_uint4(0u, 0u, 0u, 0u);
  __syncthreads();
  const XcdBarrier xb = xcd_barrier_post((unsigned*)(p.ws + O_BAR), (volatile LAS unsigned*)&xb_words);
  if (p.reps[7] == 0x7fffffff) grid.sync();

#define REP(g) for (int rep_ = 0; rep_ < p.reps[g]; ++rep_)
  REP(0) { phase0(p, smem); xcd_barrier(xb.bar, xb.x, xb.st, otid() == 0); }
  REP(1) { phase_norm(p, 0, NTOK); phase_shiftw(p, smem); xcd_barrier(xb.bar, xb.x, xb.st, otid() == 0); }
  REP(2) {
    unsigned char* ws = opq(p.ws); const bf16_t* act = (const bf16_t*)(ws + O_ACT); const float2* rope = (const float2*)(ws + O_ROPE); (void)act; (void)rope;
    EpiMlaIn e{(bf16_t*)(ws + O_CQ), (bf16_t*)(ws + O_CKV), (bf16_t*)(ws + O_KP), (bf16_t*)(ws + O_SG0), rope, (float*)(ws + O_RSS)};
    gemm_phase256((const bf16_t*)(ws + O_W_MLA_IN), act, 1024, 1792, NTOK, smem, e, rep_ + 1 < p.reps[2]);
    xcd_barrier(xb.bar, xb.x, xb.st, otid() == 0);
  }
  REP(2) {
    unsigned char* ws = opq(p.ws); const bf16_t* act = (const bf16_t*)(ws + O_ACT); const float2* rope = (const float2*)(ws + O_ROPE); (void)act; (void)rope;
    EpiUq e1{(bf16_t*)(ws + O_Q), rope, (const float*)(ws + O_RSS)};
    EpiUkv e2{(bf16_t*)(ws + O_KP), (bf16_t*)(ws + O_ACT), (const float*)(ws + O_RSS)};
    TileWalk tw(14, 68);
    int ft, tt;
    while (tw.next(ft, tt)) {
      if (ft < 6) gemm_tile8p((const bf16_t*)(ws + O_W_UQ), (const bf16_t*)(ws + O_CQ), 384, ft * 256, tt * 256, smem, e1, rep_ + 1 < p.reps[2]);
      else gemm_tile8p((const bf16_t*)(ws + O_W_UKV), (const bf16_t*)(ws + O_CKV), 256, (ft - 6) * 256, tt * 256, smem, e2, rep_ + 1 < p.reps[2]);
    }
    xcd_barrier(xb.bar, xb.x, xb.st, otid() == 0);
  }
  REP(4) { phase_mla_attn(p, smem, rep_ + 1 < p.reps[4]); xcd_barrier(xb.bar, xb.x, xb.st, otid() == 0); }
  REP(3) {
    unsigned char* ws = opq(p.ws); const bf16_t* act = (const bf16_t*)(ws + O_ACT); float* xc = (float*)(ws + O_XC); float* mod = (float*)(ws + O_MOD); (void)act;
    EpiRes e{p.in[0], p.in[2], p.out, xc, mod + 0 * 5 * 3072, rep_ + 1 < p.reps[3], (bf16_t*)(ws + O_ACT), p.in[4] + 1 * 1024, mod + 1 * 5 * 3072, (float*)(ws + O_RSSL) + 0 * NTOK};
    gemm_phase256((const bf16_t*)(ws + O_W_MLA_OUT), (const bf16_t*)(ws + O_SG0), 1024, 1024, NTOK, smem, e);
    xcd_barrier(xb.bar, xb.x, xb.st, otid() == 0);
  }
  REP(2) {
    unsigned char* ws = opq(p.ws); const bf16_t* act = (const bf16_t*)(ws + O_ACT); const float2* rope = (const float2*)(ws + O_ROPE); (void)act; (void)rope;
    EpiHyIn e{(bf16_t*)(ws + O_UT), PreNorm{(const float*)(ws + O_RSSL) + 0 * NTOK, (const float*)(ws + O_SW), 4096}};
    gemm_phase256((const bf16_t*)(ws + O_W_HY_IN), act, 1024, 4096, NTOK, smem, e, rep_ + 1 < p.reps[2]);
    xcd_barrier(xb.bar, xb.x, xb.st, otid() == 0);
  }
  REP(5) { phase_hyena(p, smem, aux, rep_ + 1 < p.reps[5]); xcd_barrier(xb.bar, xb.x, xb.st, otid() == 0); }
  phase_hy_transpose(p, smem);
  xcd_barrier(xb.bar, xb.x, xb.st, otid() == 0);
  REP(3) {
    unsigned char* ws = opq(p.ws); const bf16_t* act = (const bf16_t*)(ws + O_ACT); float* xc = (float*)(ws + O_XC); float* mod = (float*)(ws + O_MOD); (void)act;
    EpiRes e{p.out, xc, p.out, xc, mod + 1 * 5 * 3072, rep_ + 1 < p.reps[3], (bf16_t*)(ws + O_XG2), p.in[4] + 2 * 1024, mod + 2 * 5 * 3072, (float*)(ws + O_RSSL) + 1 * NTOK};
    gemm_phase256((const bf16_t*)(ws + O_W_HY_OUT), act, 1024, 1024, NTOK, smem, e);
    xcd_barrier(xb.bar, xb.x, xb.st, otid() == 0);
  }
  REP(2) {
    unsigned char* ws = opq(p.ws); const bf16_t* act = (const bf16_t*)(ws + O_ACT); const float2* rope = (const float2*)(ws + O_ROPE); (void)act; (void)rope;
    EpiSwaIn e{(bf16_t*)(ws + O_QS), (bf16_t*)(ws + O_KS), (bf16_t*)(ws + O_VT2), (bf16_t*)(ws + O_SG2), rope, PreNorm{(const float*)(ws + O_RSSL) + 1 * NTOK, (const float*)(ws + O_SW) + 5 * 4096, 2560}};
    gemm_phase256((const bf16_t*)(ws + O_W_SWA_IN), (const bf16_t*)(ws + O_XG2), 1024, 2560, NTOK, smem, e, rep_ + 1 < p.reps[2]);
    xcd_barrier(xb.bar, xb.x, xb.st, otid() == 0);
  }
  REP(6) { phase_swa_attn(p, smem, rep_ + 1 < p.reps[6]); xcd_barrier(xb.bar, xb.x, xb.st, otid() == 0); }
  REP(3) {
    unsigned char* ws = opq(p.ws); const bf16_t* act = (const bf16_t*)(ws + O_ACT); float* xc = (float*)(ws + O_XC); float* mod = (float*)(ws + O_MOD); (void)act;
    EpiRes e{p.out, xc, p.out, xc, mod + 2 * 5 * 3072, rep_ + 1 < p.reps[3], (bf16_t*)(ws + O_ACT), p.in[4] + 3 * 1024, mod + 3 * 5 * 3072, (float*)(ws + O_RSSL) + 2 * NTOK};
    gemm_phase256((const bf16_t*)(ws + O_W_SWA_OUT), (const bf16_t*)(ws + O_SG2), 1024, 1024, NLAT, smem, e);
    xcd_barrier(xb.bar, xb.x, xb.st, otid() == 0);
  }
  REP(2) {
    unsigned char* ws = opq(p.ws); const bf16_t* act = (const bf16_t*)(ws + O_ACT); const float2* rope = (const float2*)(ws + O_ROPE); (void)act; (void)rope;
    EpiCfIn e{(bf16_t*)(ws + O_U3), (bf16_t*)(ws + O_SG3), PreNorm{(const float*)(ws + O_RSSL) + 2 * NTOK, (const float*)(ws + O_SW) + 5 * (4096 + 2560), 3072}};
    gemm_phase256((const bf16_t*)(ws + O_W_CF_IN), act, 1024, 3072, NLAT, smem, e, rep_ + 1 < p.reps[2]);
    xcd_barrier(xb.bar, xb.x, xb.st, otid() == 0);
  }
  REP(7) { phase_cfconv(p, smem); xcd_barrier(xb.bar, xb.x, xb.st, otid() == 0); }
  REP(3) {
    unsigned char* ws = opq(p.ws); const bf16_t* act = (const bf16_t*)(ws + O_ACT); float* xc = (float*)(ws + O_XC); float* mod = (float*)(ws + O_MOD); (void)act;
    EpiRes e{p.out, xc, p.out, xc, mod + 3 * 5 * 3072, rep_ + 1 < p.reps[3], nullptr, nullptr, nullptr, nullptr};
    gemm_phase256((const bf16_t*)(ws + O_W_CF_OUT), act, 1024, 1024, NLAT, smem, e);
    xcd_barrier(xb.bar, xb.x, xb.st, otid() == 0);
  }
  phase_final(p);
}

extern "C" void kernel_launch(void* const* d_in, const int* in_sizes, int n_in, void* d_out, int out_size, void* d_ws, size_t ws_size,
                              hipStream_t stream) {
  static int grid = 0;
  if (grid == 0) {
    if (n_in != 33 || ws_size < WS_NEED) {
      fprintf(stderr, "kernel_launch: need 33 inputs and >= %zu bytes of workspace; got n_in %d, ws %zu\n", (size_t)WS_NEED, n_in, ws_size);
      grid = -1;
      return;
    }
    int dev = 0, cus = 0, per_cu = 0;
    hipGetDevice(&dev);
    hipDeviceGetAttribute(&cus, hipDeviceAttributeMultiprocessorCount, dev);
    if (hipFuncSetAttribute((const void*)mega, hipFuncAttributeMaxDynamicSharedMemorySize, DYN_LDS) != hipSuccess) { fprintf(stderr, "hipFuncSetAttribute failed\n"); grid = -1; return; }
    hipOccupancyMaxActiveBlocksPerMultiprocessor(&per_cu, mega, NT, DYN_LDS);
    int g = cus * per_cu;
    if (g > 256) g = 256;
    if (g < 1) g = 256;
    grid = g;
  }
  if (grid < 0) return;
  P p{};
  for (int i = 0; i < 33; ++i) p.in[i] = (const float*)d_in[i];
  p.out = (float*)d_out;
  p.ws = (unsigned char*)d_ws;
  { const int r[8] = {PROBE_REPS}; for (int i = 0; i < 8; ++i) p.reps[i] = r[i]; }
  if (hipMemsetAsync((char*)d_ws + O_BAR, 0, XCD_BAR_BYTES, stream) != hipSuccess) { fprintf(stderr, "memset of barrier words failed\n"); return; }
  void* args[] = {&p};
  hipError_t e = hipLaunchCooperativeKernel((void*)mega, dim3(grid), dim3(NT), args, DYN_LDS, stream);
  if (e != hipSuccess) fprintf(stderr, "cooperative launch failed: %s (grid %d)\n", hipGetErrorString(e), grid);
}
```

```cpp
#include <hip/hip_runtime.h>
#include <hip/hip_cooperative_groups.h>
#include <cstdio>
#include <cstdint>
namespace cg = cooperative_groups;

typedef unsigned short bf16_t;
typedef __attribute__((ext_vector_type(8))) short bf16x8;
typedef __attribute__((ext_vector_type(4))) float f32x4;
typedef __attribute__((ext_vector_type(2))) float f32x2;
typedef __attribute__((ext_vector_type(4))) unsigned u32x4;
typedef __attribute__((ext_vector_type(2))) unsigned u32x2;

#define NT 512
#define DYN_LDS 139264
#ifndef PROBE_REPS
#define PROBE_REPS 1, 1, 1, 1, 1, 1, 1, 1
#endif
#define DI __device__ __forceinline__

constexpr int NLAT = 16384, NCTX = 1024, NTOK = 17408, SEQ = 4096, LCTX = 256, KEYS = 4352;
constexpr float LOG2E = 1.4426950408889634f;
constexpr size_t XCD_BAR_BYTES = 3456 * 4;

constexpr size_t al(size_t x) { return (x + 255) & ~(size_t)255; }
constexpr size_t O_W_MLA_IN = 0;
constexpr size_t O_W_UQ = O_W_MLA_IN + al((size_t)1792 * 1024 * 2);
constexpr size_t O_W_UKV = O_W_UQ + al((size_t)1536 * 384 * 2);
constexpr size_t O_W_MLA_OUT = O_W_UKV + al((size_t)2048 * 256 * 2);
constexpr size_t O_W_HY_IN = O_W_MLA_OUT + al((size_t)1024 * 1024 * 2);
constexpr size_t O_W_HY_OUT = O_W_HY_IN + al((size_t)4096 * 1024 * 2);
constexpr size_t O_W_SWA_IN = O_W_HY_OUT + al((size_t)1024 * 1024 * 2);
constexpr size_t O_W_SWA_OUT = O_W_SWA_IN + al((size_t)2560 * 1024 * 2);
constexpr size_t O_W_CF_IN = O_W_SWA_OUT + al((size_t)1024 * 1024 * 2);
constexpr size_t O_W_CF_OUT = O_W_CF_IN + al((size_t)3072 * 1024 * 2);
constexpr size_t O_MOD = O_W_CF_OUT + al((size_t)1024 * 1024 * 2);
constexpr size_t O_HDN = O_MOD + al((size_t)4 * 5 * 3072 * 4);
constexpr size_t O_HDNC = O_HDN + al((size_t)64 * 4096 * 4);
constexpr size_t O_HDNB = O_HDNC + al((size_t)64 * 256 * 4);
constexpr size_t O_ROPE = O_HDNB + al((size_t)4096 * 64 * 2);
constexpr size_t O_RSS = O_ROPE + al((size_t)4096 * 32 * 8);
constexpr size_t O_RSSL = O_RSS + al((size_t)2 * NTOK * 4);
constexpr size_t O_SW = O_RSSL + al((size_t)3 * NTOK * 4);
constexpr size_t O_XC = O_SW + al((size_t)5 * 9728 * 4);
constexpr size_t O_ACT = O_XC + al((size_t)NCTX * 1024 * 4);
constexpr size_t O_T = O_ACT + al((size_t)NTOK * 1024 * 2);
constexpr size_t O_CQ = O_T;
constexpr size_t O_CKV = O_CQ + al((size_t)NTOK * 384 * 2);
constexpr size_t O_SG0 = O_CKV + al((size_t)NTOK * 256 * 2);
constexpr size_t O_Q = O_SG0 + al((size_t)NTOK * 1024 * 2);
constexpr size_t O_KP = O_Q + al((size_t)NTOK * 1536 * 2);
constexpr size_t O_END0 = O_KP + al((size_t)NTOK * 1536 * 2);
constexpr size_t O_UT = O_T;
constexpr size_t O_FFT = O_UT + al((size_t)4096 * NTOK * 2);
constexpr size_t O_END1 = O_FFT + (size_t)256 * 131072;
constexpr size_t O_QS = O_T;
constexpr size_t O_KS = O_QS + al((size_t)NTOK * 1024 * 2);
constexpr size_t O_VT2 = O_KS + al((size_t)NTOK * 256 * 2);
constexpr size_t O_SG2 = O_VT2 + al((size_t)16 * 64 * KEYS * 2);
constexpr size_t O_U3 = O_T;
constexpr size_t O_SG3 = O_U3 + al((size_t)NLAT * 1024 * 2);
constexpr size_t O_BAR = (O_END0 > O_END1 ? O_END0 : O_END1);
constexpr size_t O_XG2 = O_T + (size_t)96 * 1024 * 1024;
constexpr size_t WS_NEED = O_BAR + XCD_BAR_BYTES;

struct P {
  const float* in[33];
  float* out;
  unsigned char* ws;
  int reps[8];
};

DI int otid() { int t = threadIdx.x; asm volatile("" : "+v"(t)); return t; }
template <class T> DI T* opq(T* p) { asm volatile("" : "+s"(p)); return p; }
DI bf16_t f2bf(float x) { unsigned r; asm("v_cvt_pk_bf16_f32 %0, %1, %1" : "=v"(r) : "v"(x)); return (bf16_t)r; }
DI float bf2f(bf16_t v) { return __uint_as_float(((unsigned)v) << 16); }
DI unsigned pack2(float a, float b) { unsigned r; asm("v_cvt_pk_bf16_f32 %0, %1, %2" : "=v"(r) : "v"(a), "v"(b)); return r; }
DI float siluf(float x) { return x * __builtin_amdgcn_rcpf(1.f + __expf(-x)); }
DI float sigmf(float x) { return __builtin_amdgcn_rcpf(1.f + __expf(-x)); }
DI float wave_sum(float v) {
#pragma unroll
  for (int o = 32; o >= 1; o >>= 1) v += __shfl_xor(v, o, 64);
  return v;
}
DI void store4bf(bf16_t* p, float a, float b, float c, float d) {
  uint2 v; v.x = pack2(a, b); v.y = pack2(c, d);
  *(uint2*)p = v;
}
struct PairW {
  unsigned ax, ay;
  DI void put(int fi, bf16_t* row64, int lq, float a, float b, float c, float d) {
    const unsigned px = pack2(a, b), py = pack2(c, d);
    if ((fi & 1) == 0) { ax = px; ay = py; }
    else {
      const auto rx = __builtin_amdgcn_permlane16_swap(ax, px, false, false);
      const auto ry = __builtin_amdgcn_permlane16_swap(ay, py, false, false);
      u32x4 v; v.x = rx[0]; v.y = ry[0]; v.z = rx[1]; v.w = ry[1];
      const int col = (lq & 1) ? fi * 16 + 4 * (lq - 1) : (fi - 1) * 16 + 4 * lq;
      *(u32x4*)(row64 + col) = v;
    }
  }
};
DI f32x4 mfma16(bf16x8 a, bf16x8 b, f32x4 c) { return __builtin_amdgcn_mfma_f32_16x16x32_bf16(a, b, c, 0, 0, 0); }

DI int tok_modrow(int tok) { return tok < NLAT ? (tok >> 12) : 4; }
DI int tok_batch(int tok) { return tok < NLAT ? (tok >> 12) : ((tok - NLAT) >> 8); }
DI int tok_key(int tok) { return tok < NLAT ? (tok & 4095) : (SEQ + ((tok - NLAT) & 255)); }
DI int key_perm(int key) { const int x = key & 31; return (key & ~31) | (((x >> 2) & 3) * 8 + (x >> 4) * 4 + (x & 3)); }

constexpr int GLD = 72;
template <class Epi>
DI void gemm_tile(const bf16_t* __restrict__ W, const bf16_t* __restrict__ X, int K, int f0, int t0, char* smem, const Epi& epi) {
  bf16_t* sW = (bf16_t*)smem;
  bf16_t* sX = sW + 128 * GLD;
  const int tid = otid(), lane = tid & 63, wave = tid >> 6;
  const int wf = wave >> 2, wt = wave & 3;
  const int lr = lane & 15, lq = lane >> 4;
  f32x4 acc[4][4];
#pragma unroll
  for (int i = 0; i < 4; ++i)
#pragma unroll
    for (int j = 0; j < 4; ++j) acc[i][j] = (f32x4){0.f, 0.f, 0.f, 0.f};
  u32x4 rwA[2], rxA[4], rwB[2], rxB[4];
  const int crow = tid >> 3, ccol = (tid & 7) * 8;
  const bf16_t* Wp = W + (size_t)(f0 + crow) * K + ccol;
  const bf16_t* Xp = X + (size_t)(t0 + crow) * K + ccol;
#define G_LOAD(RW, RX, KOFF)                                                            \
  {                                                                                     \
    _Pragma("unroll") for (int i = 0; i < 2; ++i) RW[i] = *(const u32x4*)(Wp + (size_t)(64 * i) * K + (KOFF)); \
    _Pragma("unroll") for (int i = 0; i < 4; ++i) RX[i] = *(const u32x4*)(Xp + (size_t)(64 * i) * K + (KOFF)); \
  }
#define G_STORE(RW, RX)                                                                 \
  {                                                                                     \
    _Pragma("unroll") for (int i = 0; i < 2; ++i) *(u32x4*)(sW + (crow + 64 * i) * GLD + ccol) = RW[i]; \
    _Pragma("unroll") for (int i = 0; i < 4; ++i) *(u32x4*)(sX + (crow + 64 * i) * GLD + ccol) = RX[i]; \
  }
#define G_COMPUTE()                                                                     \
  {                                                                                     \
    _Pragma("unroll") for (int ks = 0; ks < 2; ++ks) {                                  \
      bf16x8 a[4], b[4];                                                                \
      _Pragma("unroll") for (int i = 0; i < 4; ++i) a[i] = *(const bf16x8*)(sW + (wf * 64 + i * 16 + lr) * GLD + ks * 32 + lq * 8); \
      _Pragma("unroll") for (int i = 0; i < 4; ++i) b[i] = *(const bf16x8*)(sX + (wt * 64 + i * 16 + lr) * GLD + ks * 32 + lq * 8); \
      _Pragma("unroll") for (int i = 0; i < 4; ++i)                                     \
        _Pragma("unroll") for (int j = 0; j < 4; ++j) acc[i][j] = mfma16(a[i], b[j], acc[i][j]); \
    }                                                                                   \
  }
  G_LOAD(rwA, rxA, 0);
  G_LOAD(rwB, rxB, 64);
  for (int k0 = 0; k0 < K; k0 += 128) {
    __syncthreads();
    G_STORE(rwA, rxA);
    __syncthreads();
    { const int kn = k0 + 128 < K ? k0 + 128 : K - 128; G_LOAD(rwA, rxA, kn); }
    G_COMPUTE();
    __syncthreads();
    G_STORE(rwB, rxB);
    __syncthreads();
    { const int kn = k0 + 192 < K ? k0 + 192 : K - 64; G_LOAD(rwB, rxB, kn); }
    G_COMPUTE();
  }
#undef G_LOAD
#undef G_STORE
#undef G_COMPUTE
  epi(f0 + wf * 64, t0 + wt * 64, acc);
}

struct TileWalk {
  int nft, start, ntl, u, nlb;
  DI TileWalk(int nft_, int ntt) {
    const int x = blockIdx.x & 7;
    nft = nft_;
    start = (x * ntt) >> 3;
    ntl = (((x + 1) * ntt) >> 3) - start;
    u = blockIdx.x >> 3;
    nlb = (gridDim.x - x + 7) >> 3;
  }
  DI bool next(int& ft, int& tt) {
    if (u >= ntl * nft) return false;
    const int grp = u / (4 * nft), rem = u - grp * 4 * nft;
    const int left = ntl - grp * 4, gsz = left < 4 ? left : 4;
    ft = rem / gsz;
    tt = start + grp * 4 + rem % gsz;
    u += nlb;
    return true;
  }
};

template <class Epi>
DI void gemm_phase(const bf16_t* W, const bf16_t* X, int K, int NF, int NTK, char* smem, const Epi& epi) {
  TileWalk tw(NF / 128, NTK / 256);
  int ft, tt;
  while (tw.next(ft, tt)) gemm_tile(W, X, K, ft * 128, tt * 256, smem, epi);
}


constexpr int G_BK = 64, G_HALF = 128, G_HT = G_HALF * G_BK;
DI int g_lds_byte(int r, int c) {
  int st = (r >> 4) * 2 + (c >> 5), rr = r & 15, cc = c & 31, ob = rr * 64 + cc * 2;
  return st * 1024 + (ob ^ (((ob >> 9) & 1) << 5));
}
DI void g_stage_rc(int b, int& R, int& C) {
  int st = b / 1024, sb = b % 1024, swz = sb ^ (((sb >> 9) & 1) << 5);
  R = (st >> 1) * 16 + swz / 64; C = (st & 1) * 32 + (swz % 64) / 2;
}
template <class Epi>
DI void gemm_tile256(const bf16_t* __restrict__ W, const bf16_t* __restrict__ X, int K, int f0, int t0, char* smem, const Epi& epi, bool dry = false) {
  const int tidx = otid();
  const int wid = tidx >> 6, lane = tidx & 63, wr = wid >> 2, wc = wid & 3, fr = lane & 15, fq = lane >> 4;
  f32x4 acc[8][4];
#pragma unroll
  for (int i = 0; i < 8; ++i)
#pragma unroll
    for (int j = 0; j < 4; ++j) acc[i][j] = (f32x4){0.f, 0.f, 0.f, 0.f};
  int r0, c0, r1, c1;
  g_stage_rc(tidx * 16, r0, c0);
  g_stage_rc(tidx * 16 + 8192, r1, c1);
  const bf16_t* Wg0 = W + (size_t)(f0 + r0) * K + c0;
  const bf16_t* Wg1 = W + (size_t)(f0 + r1) * K + c1;
  const bf16_t* Xg0 = X + (size_t)(t0 + r0) * K + c0;
  const bf16_t* Xg1 = X + (size_t)(t0 + r1) * K + c1;
  const size_t hk = (size_t)128 * K;
#define GLL(src, dst) __builtin_amdgcn_global_load_lds((const unsigned*)(src), (__attribute__((address_space(3))) unsigned*)(dst), 16, 0, 0)
#define STAGE_ALL(buf, kt)                                                     \
  {                                                                            \
    char* sb_ = smem + (buf) * 65536 + tidx * 16;                              \
    const size_t ko_ = (size_t)(kt) * 64;                                      \
    GLL(Wg0 + ko_, sb_);               GLL(Wg1 + ko_, sb_ + 8192);             \
    GLL(Wg0 + hk + ko_, sb_ + 16384);  GLL(Wg1 + hk + ko_, sb_ + 24576);       \
    GLL(Xg0 + ko_, sb_ + 32768);       GLL(Xg1 + ko_, sb_ + 40960);            \
    GLL(Xg0 + hk + ko_, sb_ + 49152);  GLL(Xg1 + hk + ko_, sb_ + 57344);       \
  }
  const int ob = fr * 64 + fq * 16;
  const int lane_off = ob ^ (((ob >> 9) & 1) << 5);
  const char* aBase = smem + wr * 16384 + lane_off;
  const char* bBase = smem + 32768 + (wc >> 1) * 16384 + (wc & 1) * 8192 + lane_off;
  const int nt = K / 64;
  STAGE_ALL(0, 0);
  for (int kt = 0; kt < nt; ++kt) {
    asm volatile("s_waitcnt vmcnt(0)" ::: "memory");
    __builtin_amdgcn_s_barrier();
    if (kt + 1 < nt) STAGE_ALL((kt + 1) & 1, kt + 1);
    const char* ab = aBase + (kt & 1) * 65536;
    const char* bb = bBase + (kt & 1) * 65536;
#pragma unroll
    for (int ks = 0; ks < 2; ++ks) {
      bf16x8 a[8], b[4];
#pragma unroll
      for (int m = 0; m < 8; ++m) a[m] = *(const bf16x8*)(ab + (m * 2 + ks) * 1024);
#pragma unroll
      for (int n = 0; n < 4; ++n) b[n] = *(const bf16x8*)(bb + (n * 2 + ks) * 1024);
#pragma unroll
      for (int m = 0; m < 8; ++m)
#pragma unroll
        for (int n = 0; n < 4; ++n) acc[m][n] = mfma16(a[m], b[n], acc[m][n]);
    }
  }
#undef GLL
#undef STAGE_ALL
  if (!dry) {
    f32x4 (&lo)[4][4] = *reinterpret_cast<f32x4 (*)[4][4]>(&acc[0]);
    f32x4 (&hi)[4][4] = *reinterpret_cast<f32x4 (*)[4][4]>(&acc[4]);
    epi(f0 + wr * 128, t0 + wc * 64, lo);
    epi(f0 + wr * 128 + 64, t0 + wc * 64, hi);
  }
}


template <class Epi>
DI void gemm_tile8p(const bf16_t* __restrict__ A, const bf16_t* __restrict__ Bt, int K, int brow, int bcol, char* smem, const Epi& epi, bool dry = false) {
  bf16_t* shm = (bf16_t*)smem;
  #define SA(b,h) (shm+((b)*2+(h))*G_HT)
  #define SB(b,h) (shm+(4+(b)*2+(h))*G_HT)
  #define STAGE(P,BASE,br,kt) do{long _g=(long)(br)*K+(long)(kt)*G_BK; \
    for(int _i=0;_i<2;++_i){int _b=tidx*16+_i*8192;int _r,_c;g_stage_rc(_b,_r,_c); \
      __builtin_amdgcn_global_load_lds((const unsigned*)(BASE+_g+(long)_r*K+_c), \
        (__attribute__((address_space(3))) unsigned*)((char*)(P)+_b),16,0,0);}}while(0)
  #define LDA(dst,b,h) for(int m=0;m<4;++m)for(int k=0;k<2;++k) \
    dst[m][k]=*reinterpret_cast<const bf16x8*>((char*)SA(b,h)+g_lds_byte(wr*64+m*16+fr,k*32+fq*8))
  #define LDB(dst,b,h) for(int n=0;n<2;++n)for(int k=0;k<2;++k) \
    dst[n][k]=*reinterpret_cast<const bf16x8*>((char*)SB(b,h)+g_lds_byte(wc*32+n*16+fr,k*32+fq*8))
  #define MMA(ai,bj,At,Bt_) do{__builtin_amdgcn_s_setprio(1); \
    for(int m=0;m<4;++m)for(int n=0;n<2;++n)for(int k=0;k<2;++k) \
      acc[ai][bj][m][n]=__builtin_amdgcn_mfma_f32_16x16x32_bf16(At[m][k],Bt_[n][k],acc[ai][bj][m][n],0,0,0); \
    __builtin_amdgcn_s_setprio(0);}while(0)
  #define WAIT_V(n) asm volatile("s_waitcnt vmcnt(" #n ")":::"memory")
  #define WAIT_L(n) asm volatile("s_waitcnt lgkmcnt(" #n ")":::"memory")
  #define BAR __builtin_amdgcn_s_barrier()
  #define SCHED __builtin_amdgcn_sched_barrier(0)
  const int tidx = otid();
  const int wid=tidx>>6,lane=tidx&63,wr=wid>>2,wc=wid&3,fr=lane&15,fq=lane>>4;
  f32x4 acc[2][2][4][2]={};
  bf16x8 At[4][2],B0[2][2],B1[2][2];
  const int nt=K/G_BK;
  asm volatile("s_waitcnt vmcnt(0) lgkmcnt(0)" ::: "memory");
  __syncthreads();
  STAGE(SB(0,0),Bt,bcol,0); STAGE(SA(0,0),A,brow,0);
  STAGE(SB(0,1),Bt,bcol+G_HALF,0); STAGE(SA(0,1),A,brow+G_HALF,0);
  if(wr==1)BAR;
  WAIT_V(4); BAR;
  STAGE(SB(1,0),Bt,bcol,1); STAGE(SA(1,0),A,brow,1); STAGE(SB(1,1),Bt,bcol+G_HALF,1);
  WAIT_V(6); BAR;
  for(int t=0;t<nt-2;t+=2){
    LDB(B0,0,0); SCHED; LDA(At,0,0); STAGE(SA(1,1),A,brow+G_HALF,t+1);
    WAIT_L(8); BAR; WAIT_L(0); MMA(0,0,At,B0); BAR; SCHED;
    LDB(B1,0,1); STAGE(SB(0,0),Bt,bcol,t+2);
    BAR; WAIT_L(0); MMA(0,1,At,B1); BAR;
    LDA(At,0,1); STAGE(SA(0,0),A,brow,t+2);
    BAR; WAIT_L(0); MMA(1,0,At,B0); BAR; SCHED;
    STAGE(SB(0,1),Bt,bcol+G_HALF,t+2);
    WAIT_V(6); BAR; MMA(1,1,At,B1); BAR;
    LDB(B0,1,0); SCHED; LDA(At,1,0); STAGE(SA(0,1),A,brow+G_HALF,t+2);
    WAIT_L(8); BAR; WAIT_L(0); MMA(0,0,At,B0); BAR; SCHED;
    LDB(B1,1,1); STAGE(SB(1,0),Bt,bcol,t+3);
    BAR; WAIT_L(0); MMA(0,1,At,B1); BAR;
    LDA(At,1,1); STAGE(SA(1,0),A,brow,t+3);
    BAR; WAIT_L(0); MMA(1,0,At,B0); BAR; SCHED;
    STAGE(SB(1,1),Bt,bcol+G_HALF,t+3);
    WAIT_V(6); BAR; MMA(1,1,At,B1); BAR;
  }
  { LDB(B0,0,0); LDA(At,0,0); STAGE(SA(1,1),A,brow+G_HALF,nt-1);
    BAR; WAIT_L(0); MMA(0,0,At,B0); BAR;
    LDB(B1,0,1); BAR; WAIT_L(0); MMA(0,1,At,B1); BAR;
    LDA(At,0,1); WAIT_V(4); BAR; WAIT_L(0); MMA(1,0,At,B0); MMA(1,1,At,B1); BAR; }
  { LDB(B0,1,0); LDA(At,1,0); WAIT_V(2); BAR; WAIT_L(0); MMA(0,0,At,B0); BAR;
    LDB(B1,1,1); WAIT_V(0); BAR; WAIT_L(0); MMA(0,1,At,B1); BAR;
    LDA(At,1,1); BAR; WAIT_L(0); MMA(1,0,At,B0); MMA(1,1,At,B1); BAR; }
  if(wr==0)BAR;
  if (!dry) {
#pragma unroll
    for(int ai=0;ai<2;++ai)
#pragma unroll
      for(int bj=0;bj<2;++bj) epi(brow+ai*G_HALF+wr*64, bcol+bj*G_HALF+wc*32, acc[ai][bj]);
  }
  #undef SA
  #undef SB
  #undef STAGE
  #undef LDA
  #undef LDB
  #undef MMA
  #undef WAIT_V
  #undef WAIT_L
  #undef BAR
  #undef SCHED
}

template <class Epi>
DI void gemm_phase256(const bf16_t* W, const bf16_t* X, int K, int NF, int NTK, char* smem, const Epi& epi, bool dry = false) {
  TileWalk tw(NF / 256, NTK / 256);
  int ft, tt;
  while (tw.next(ft, tt)) gemm_tile8p(W, X, K, ft * 256, tt * 256, smem, epi, dry);
}

struct EpiMlaIn {
  bf16_t *cq, *ckv, *kp, *sg; const float2* rope; float* rss;
  template <int NTI> DI void operator()(int f0, int t0, f32x4 (&acc)[4][NTI]) const {
    const int lane = otid() & 63, lr = lane & 15, lq = lane >> 4;
    if (f0 >= 1728) return;
    if (f0 == 640) {
#pragma unroll
      for (int ti = 0; ti < NTI; ++ti) {
        const int tok = t0 + ti * 16 + lr;
        const bool lat = tok < NLAT;
        const int pos = tok & 4095;
#pragma unroll
        for (int fi = 0; fi < 2; ++fi) {
          float o1[4], o2[4];
#pragma unroll
          for (int j = 0; j < 4; ++j) {
            const int d = fi * 16 + 4 * lq + j;
            float x1 = acc[fi][ti][j], x2 = acc[fi + 2][ti][j];
            if (lat) { float2 cs = rope[pos * 32 + d]; o1[j] = x1 * cs.x - x2 * cs.y; o2[j] = x1 * cs.y + x2 * cs.x; }
            else { o1[j] = x1; o2[j] = x2; }
          }
          const int d0 = fi * 16 + 4 * lq;
#pragma unroll
          for (int h = 0; h < 8; ++h) {
            bf16_t* base = kp + ((size_t)tok * 8 + h) * 192 + 128;
            store4bf(base + d0, o1[0], o1[1], o1[2], o1[3]);
            store4bf(base + 32 + d0, o2[0], o2[1], o2[2], o2[3]);
          }
        }
      }
      return;
    }
    if (f0 < 640) {
#pragma unroll
      for (int ti = 0; ti < NTI; ++ti) {
        const int tok = t0 + ti * 16 + lr;
        float ss = 0.f;
        PairW pw;
        bf16_t* row64 = f0 < 384 ? cq + (size_t)tok * 384 + f0 : ckv + (size_t)tok * 256 + (f0 - 384);
#pragma unroll
        for (int fi = 0; fi < 4; ++fi) {
          f32x4 v = acc[fi][ti];
          ss += v[0] * v[0] + v[1] * v[1] + v[2] * v[2] + v[3] * v[3];
          pw.put(fi, row64, lq, v[0], v[1], v[2], v[3]);
        }
        ss += __shfl_xor(ss, 16, 64);
        ss += __shfl_xor(ss, 32, 64);
        if (lq == 0) atomicAdd(rss + (f0 < 384 ? 0 : NTOK) + tok, ss);
      }
      return;
    }
#pragma unroll
    for (int ti = 0; ti < NTI; ++ti) {
      const int tok = t0 + ti * 16 + lr;
      PairW pw;
      bf16_t* row64 = sg + (size_t)tok * 1024 + (f0 - 704);
#pragma unroll
      for (int fi = 0; fi < 4; ++fi) {
        f32x4 v = acc[fi][ti];
        pw.put(fi, row64, lq, siluf(v[0]), siluf(v[1]), siluf(v[2]), siluf(v[3]));
      }
    }
  }
};

struct EpiUq {
  bf16_t* q; const float2* rope; const float* rss;
  template <int NTI> DI void operator()(int f0, int t0, f32x4 (&acc)[4][NTI]) const {
    const int lane = otid() & 63, lr = lane & 15, lq = lane >> 4;
    const bool isrope = (f0 % 192) == 128;
#pragma unroll
    for (int ti = 0; ti < NTI; ++ti) {
      const int tok = t0 + ti * 16 + lr;
      const int pos = tok & 4095;
      const float sc = 0.07216878364870322f * LOG2E * rsqrtf(rss[tok] * (1.f / 384.f) + 1e-6f);
      bf16_t* row64 = q + (size_t)tok * 1536 + f0;
      if (isrope && tok < NLAT) {
        PairW p1, p2;
#pragma unroll
        for (int fi = 0; fi < 2; ++fi) {
          float o1[4], o2[4];
#pragma unroll
          for (int j = 0; j < 4; ++j) {
            const int d = fi * 16 + 4 * lq + j;
            float2 cs = rope[pos * 32 + d];
            float x1 = acc[fi][ti][j], x2 = acc[fi + 2][ti][j];
            o1[j] = (x1 * cs.x - x2 * cs.y) * sc; o2[j] = (x1 * cs.y + x2 * cs.x) * sc;
          }
          p1.put(fi, row64, lq, o1[0], o1[1], o1[2], o1[3]);
          p2.put(fi, row64 + 32, lq, o2[0], o2[1], o2[2], o2[3]);
        }
      } else {
        PairW pw;
#pragma unroll
        for (int fi = 0; fi < 4; ++fi) {
          f32x4 v = acc[fi][ti];
          pw.put(fi, row64, lq, v[0] * sc, v[1] * sc, v[2] * sc, v[3] * sc);
        }
      }
    }
  }
};

struct EpiUkv {
  bf16_t *kp, *vt; const float* rss;
  template <int NTI> DI void operator()(int f0, int t0, f32x4 (&acc)[4][NTI]) const {
    const int lane = otid() & 63, lr = lane & 15, lq = lane >> 4;
    const int h = f0 >> 8, r = f0 & 255;
#pragma unroll
    for (int ti = 0; ti < NTI; ++ti) {
      const int tok = t0 + ti * 16 + lr;
      const float rs = rsqrtf(rss[NTOK + tok] * (1.f / 256.f) + 1e-6f);
      if (r < 128) {
        PairW pw;
        bf16_t* row64 = kp + ((size_t)tok * 8 + h) * 192 + r;
#pragma unroll
        for (int fi = 0; fi < 4; ++fi) {
          f32x4 v = acc[fi][ti] * rs;
          pw.put(fi, row64, lq, v[0], v[1], v[2], v[3]);
        }
      } else {
        const int b = tok_batch(tok), key = key_perm(tok_key(tok));
#pragma unroll
        for (int fi = 0; fi < 4; ++fi)
#pragma unroll
          for (int j = 0; j < 4; ++j) {
            const int dv = r - 128 + fi * 16 + 4 * lq + j;
            vt[((size_t)(b * 8 + h) * 128 + dv) * KEYS + key] = f2bf(acc[fi][ti][j] * rs);
          }
      }
    }
  }
};

struct EpiRes {
  const float *sl, *sc; float *xl, *xc; const float* mod; bool dry;
  bf16_t* xg; const float* gn; const float* modn; float* rssn;
  template <int NTI> DI void operator()(int f0, int t0, f32x4 (&acc)[4][NTI]) const {
    if (dry) return;
    const int lane = otid() & 63, lr = lane & 15, lq = lane >> 4;
#pragma unroll
    for (int ti = 0; ti < NTI; ++ti) {
      const int tok = t0 + ti * 16 + lr;
      const size_t ro = tok < NLAT ? (size_t)tok * 1024 : (size_t)(tok - NLAT) * 1024;
      const float* xs = (tok < NLAT ? sl : sc) + ro;
      float* xr = (tok < NLAT ? xl : xc) + ro;
      const int mr = tok_modrow(tok);
      const float* g = mod + mr * 3072 + 2048;
      float ss = 0.f;
      PairW pw;
#pragma unroll
      for (int fi = 0; fi < 4; ++fi) {
        const int f = f0 + fi * 16 + 4 * lq;
        float4 xv = *(const float4*)(xs + f);
        float4 gv = *(const float4*)(g + f);
        f32x4 v = acc[fi][ti];
        xv.x += gv.x * v[0]; xv.y += gv.y * v[1]; xv.z += gv.z * v[2]; xv.w += gv.w * v[3];
        *(float4*)(xr + f) = xv;
        if (xg) {
          ss += xv.x * xv.x + xv.y * xv.y + xv.z * xv.z + xv.w * xv.w;
          const float4 gg = *(const float4*)(gn + f), sn = *(const float4*)(modn + mr * 3072 + 1024 + f);
          pw.put(fi, xg + (size_t)tok * 1024 + f0, lq, xv.x * gg.x * (1.f + sn.x), xv.y * gg.y * (1.f + sn.y), xv.z * gg.z * (1.f + sn.z), xv.w * gg.w * (1.f + sn.w));
        }
      }
      if (xg) {
        ss += __shfl_xor(ss, 16, 64);
        ss += __shfl_xor(ss, 32, 64);
        if (lq == 0) atomicAdd(rssn + tok, ss);
      }
    }
  }
};
struct PreNorm {
  const float* rss; const float* sw; int nf;
  template <int NTI> DI void apply(int f0, int t0, f32x4 (&acc)[4][NTI]) const {
    const int lane = otid() & 63, lr = lane & 15, lq = lane >> 4;
#pragma unroll
    for (int ti = 0; ti < NTI; ++ti) {
      const int tok = t0 + ti * 16 + lr;
      const float rstd = rsqrtf(rss[tok] * (1.f / 1024.f) + 1e-6f);
      const float* sr = sw + (size_t)tok_modrow(tok) * nf + f0 + 4 * lq;
#pragma unroll
      for (int fi = 0; fi < 4; ++fi) {
        const float4 sv = *(const float4*)(sr + fi * 16);
        acc[fi][ti][0] = acc[fi][ti][0] * rstd + sv.x; acc[fi][ti][1] = acc[fi][ti][1] * rstd + sv.y;
        acc[fi][ti][2] = acc[fi][ti][2] * rstd + sv.z; acc[fi][ti][3] = acc[fi][ti][3] * rstd + sv.w;
      }
    }
  }
};

struct EpiHyIn {
  bf16_t* ut;
  PreNorm pn;
  template <int NTI> DI void operator()(int f0, int t0, f32x4 (&acc)[4][NTI]) const {
    pn.apply(f0, t0, acc);
    const int lane = otid() & 63, lr = lane & 15, lq = lane >> 4;
    const bool gate = f0 >= 3072;
#pragma unroll
    for (int fi = 0; fi < 4; ++fi)
#pragma unroll
      for (int ti = 0; ti < NTI; ++ti) {
        const int tok = t0 + ti * 16 + lr;
#pragma unroll
        for (int j = 0; j < 4; ++j) {
          const int f = f0 + fi * 16 + 4 * lq + j;
          float v = acc[fi][ti][j];
          if (gate) v = siluf(v);
          ut[(size_t)f * NTOK + tok] = f2bf(v);
        }
      }
  }
};

struct EpiSwaIn {
  bf16_t *qs, *ks, *vt, *sg; const float2* rope;
  PreNorm pn;
  template <int NTI> DI void operator()(int f0, int t0, f32x4 (&acc)[4][NTI]) const {
    pn.apply(f0, t0, acc);
    const int lane = otid() & 63, lr = lane & 15, lq = lane >> 4;
    const float sc = 0.125f * LOG2E;
#pragma unroll
    for (int ti = 0; ti < NTI; ++ti) {
      const int tok = t0 + ti * 16 + lr;
      const int pos = tok & 4095;
      if (f0 < 1280) {
        const bool isq = f0 < 1024;
        const float s = isq ? sc : 1.f;
        bf16_t* dst = isq ? qs + (size_t)tok * 1024 + f0 : ks + (size_t)tok * 256 + (f0 - 1024);
        PairW p1, p2;
#pragma unroll
        for (int fi = 0; fi < 2; ++fi) {
          float o1[4], o2[4];
#pragma unroll
          for (int j = 0; j < 4; ++j) {
            const int d = fi * 16 + 4 * lq + j;
            float x1 = acc[fi][ti][j], x2 = acc[fi + 2][ti][j];
            if (tok < NLAT) { float2 cs = rope[pos * 32 + d]; o1[j] = (x1 * cs.x - x2 * cs.y) * s; o2[j] = (x1 * cs.y + x2 * cs.x) * s; }
            else { o1[j] = x1 * s; o2[j] = x2 * s; }
          }
          p1.put(fi, dst, lq, o1[0], o1[1], o1[2], o1[3]);
          p2.put(fi, dst + 32, lq, o2[0], o2[1], o2[2], o2[3]);
        }
      } else if (f0 < 1536) {
        const int g = (f0 - 1280) >> 6;
        const int b = tok_batch(tok), key = key_perm(tok_key(tok));
#pragma unroll
        for (int fi = 0; fi < 4; ++fi)
#pragma unroll
          for (int j = 0; j < 4; ++j) {
            const int dv = fi * 16 + 4 * lq + j;
            vt[((size_t)(b * 4 + g) * 64 + dv) * KEYS + key] = f2bf(acc[fi][ti][j]);
          }
      } else {
        PairW pw;
        bf16_t* row64 = sg + (size_t)tok * 1024 + (f0 - 1536);
#pragma unroll
        for (int fi = 0; fi < 4; ++fi) {
          f32x4 v = acc[fi][ti];
          pw.put(fi, row64, lq, siluf(v[0]), siluf(v[1]), siluf(v[2]), siluf(v[3]));
        }
      }
    }
  }
};

struct EpiCfIn {
  bf16_t *u3, *sg;
  PreNorm pn;
  template <int NTI> DI void operator()(int f0, int t0, f32x4 (&acc)[4][NTI]) const {
    pn.apply(f0, t0, acc);
    const int lane = otid() & 63, lr = lane & 15, lq = lane >> 4;
#pragma unroll
    for (int ti = 0; ti < NTI; ++ti) {
      const int tok = t0 + ti * 16 + lr;
      if (f0 < 2048) {
        const int c0 = (f0 >> 6) * 32;
        PairW pw;
#pragma unroll
        for (int fi = 0; fi < 2; ++fi) {
          f32x4 a = acc[fi][ti], b = acc[fi + 2][ti];
          pw.put(fi, u3 + (size_t)tok * 1024 + c0, lq, a[0] * sigmf(b[0]), a[1] * sigmf(b[1]), a[2] * sigmf(b[2]), a[3] * sigmf(b[3]));
        }
      } else {
        PairW pw;
        bf16_t* row64 = sg + (size_t)tok * 1024 + (f0 - 2048);
#pragma unroll
        for (int fi = 0; fi < 4; ++fi) {
          f32x4 v = acc[fi][ti];
          pw.put(fi, row64, lq, siluf(v[0]), siluf(v[1]), siluf(v[2]), siluf(v[3]));
        }
      }
    }
  }
};

template <int MODE>
DI void transpose_w(const float* __restrict__ src, int K, int N, bf16_t* __restrict__ dst, char* smem, const float* __restrict__ kscale = nullptr) {
  float* tile = (float*)smem;
  const int tid = otid();
  const int nkt = K / 64, nnt = N / 64;
  for (int t = blockIdx.x; t < nkt * nnt; t += gridDim.x) {
    const int k0 = (t % nkt) * 64, n0 = (t / nkt) * 64;
    __syncthreads();
#pragma unroll
    for (int i = 0; i < 8; ++i) {
      const int e = tid + NT * i, kk = e >> 6, nn = e & 63;
      tile[kk * 65 + nn] = src[(size_t)(k0 + kk) * N + n0 + nn] * (kscale ? kscale[k0 + kk] : 1.f);
    }
    __syncthreads();
    const int nn = tid >> 3, kc = tid & 7;
    int n = n0 + nn;
    if (MODE == 1) {
      if (n < 1024) n = (n >> 5) * 64 + (n & 31);
      else if (n < 2048) { const int c = n - 1024; n = (c >> 5) * 64 + 32 + (c & 31); }
    }
    uint4 v;
    v.x = pack2(tile[(kc * 8 + 0) * 65 + nn], tile[(kc * 8 + 1) * 65 + nn]);
    v.y = pack2(tile[(kc * 8 + 2) * 65 + nn], tile[(kc * 8 + 3) * 65 + nn]);
    v.z = pack2(tile[(kc * 8 + 4) * 65 + nn], tile[(kc * 8 + 5) * 65 + nn]);
    v.w = pack2(tile[(kc * 8 + 6) * 65 + nn], tile[(kc * 8 + 7) * 65 + nn]);
    *(uint4*)(dst + (size_t)n * K + k0 + kc * 8) = v;
  }
  __syncthreads();
}

DI void phase0(const P& p, char* smem) {
  const int tid = otid(), lane = tid & 63, wave = tid >> 6;
  unsigned char* ws = p.ws;
  transpose_w<0>(p.in[8], 1024, 1728, (bf16_t*)(ws + O_W_MLA_IN), smem);
  for (size_t i = (size_t)blockIdx.x * NT + tid; i < (size_t)64 * 1024 / 2; i += (size_t)gridDim.x * NT)
    ((unsigned*)(ws + O_W_MLA_IN + (size_t)1728 * 1024 * 2))[i] = 0u;
  transpose_w<0>(p.in[11], 384, 1536, (bf16_t*)(ws + O_W_UQ), smem, p.in[9]);
  transpose_w<0>(p.in[12], 256, 2048, (bf16_t*)(ws + O_W_UKV), smem, p.in[10]);
  for (int i = blockIdx.x * NT + tid; i < 5 * NTOK; i += gridDim.x * NT) ((float*)(ws + O_RSS))[i] = 0.f;
  transpose_w<0>(p.in[13], 1024, 1024, (bf16_t*)(ws + O_W_MLA_OUT), smem);
  transpose_w<0>(p.in[14], 1024, 4096, (bf16_t*)(ws + O_W_HY_IN), smem);
  transpose_w<0>(p.in[23], 1024, 1024, (bf16_t*)(ws + O_W_HY_OUT), smem);
  transpose_w<0>(p.in[24], 1024, 2560, (bf16_t*)(ws + O_W_SWA_IN), smem);
  transpose_w<0>(p.in[26], 1024, 1024, (bf16_t*)(ws + O_W_SWA_OUT), smem);
  transpose_w<1>(p.in[27], 1024, 3072, (bf16_t*)(ws + O_W_CF_IN), smem);
  transpose_w<0>(p.in[32], 1024, 1024, (bf16_t*)(ws + O_W_CF_OUT), smem);
  {
    float* sS = (float*)smem;
    float* red = sS + 5 * 1024;
    __syncthreads();
    for (int i = tid; i < 5 * 1024; i += NT) {
      const int r = i >> 10, k = i & 1023;
      const float v = r < 4 ? p.in[1][r * 1024 + k] : p.in[3][k];
      sS[i] = siluf(v);
    }
    __syncthreads();
    float* mod = (float*)(ws + O_MOD);
    for (int it = blockIdx.x; it < 4 * 48; it += gridDim.x) {
      const int layer = it / 48, col = (it % 48) * 64 + lane;
      const float* w = p.in[5] + ((size_t)layer * 1024 + wave * 128) * 3072 + col;
      float a0 = 0, a1 = 0, a2 = 0, a3 = 0, a4 = 0;
#pragma unroll 8
      for (int k = 0; k < 128; ++k) {
        const float wv = w[(size_t)k * 3072];
        const int kk = wave * 128 + k;
        a0 += sS[kk] * wv; a1 += sS[1024 + kk] * wv; a2 += sS[2048 + kk] * wv; a3 += sS[3072 + kk] * wv; a4 += sS[4096 + kk] * wv;
      }
      red[(wave * 5 + 0) * 64 + lane] = a0; red[(wave * 5 + 1) * 64 + lane] = a1; red[(wave * 5 + 2) * 64 + lane] = a2;
      red[(wave * 5 + 3) * 64 + lane] = a3; red[(wave * 5 + 4) * 64 + lane] = a4;
      __syncthreads();
      if (tid < 320) {
        const int r = tid >> 6, c = tid & 63;
        float s = 0;
#pragma unroll
        for (int w8 = 0; w8 < 8; ++w8) s += red[(w8 * 5 + r) * 64 + c];
        const int cc = (it % 48) * 64 + c;
        mod[(layer * 5 + r) * 3072 + cc] = s + p.in[6][layer * 3072 + cc];
      }
      __syncthreads();
    }
  }
  {
    float2* rope = (float2*)(ws + O_ROPE);
    for (int i = blockIdx.x * NT + tid; i < 4096 * 32; i += gridDim.x * NT) {
      const int pos = i >> 5, d = i & 31;
      const float inv = exp2f(-(float)(d & 15) * (13.287712379549449f / 16.f));
      const float ang = (float)(d < 16 ? (pos >> 6) : (pos & 63)) * inv;
      float s, c; sincosf(ang, &s, &c);
      rope[i] = make_float2(c, s);
    }
  }
  {
    float* swin = (float*)smem;
    float* swh = swin + 33 * 64;
    float* shall = swh + 2 * 64 * 64;
    float* sh = shall + wave * 64;
    const float* fb = p.in[19];
    const float* ff = p.in[20];
    __syncthreads();
    for (int i = tid; i < 33 * 64; i += NT) swin[i] = p.in[17][i];
    for (int i = tid; i < 2 * 64 * 64; i += NT) swh[i] = p.in[18][i];
    __syncthreads();
    const float f0 = ff[lane], f1 = ff[64 + lane], f2 = ff[128 + lane], b0 = fb[lane], b1 = fb[64 + lane], b2 = fb[128 + lane];
    for (int item = blockIdx.x * 8 + wave; item < SEQ + LCTX; item += gridDim.x * 8) {
      const bool isc = item >= SEQ;
      const int t = isc ? item - SEQ : item;
      const int Lf = isc ? LCTX : SEQ;
      const float tl = (float)t / (float)(Lf - 1);
      const float wpos = (6.283185307179586f / (float)Lf) * (float)t;
      float e = 0.f;
      if (lane == 0) e = tl;
      else if (lane < 33) {
        const int kb = (lane - 1) & 15;
        const float band = 1e-4f + (float)kb * ((15.f - 1e-4f) / 15.f);
        const float a = band * wpos;
        e = lane < 17 ? cosf(a) : -sinf(a);
      }
      sh[lane] = e;
      __builtin_amdgcn_wave_barrier();
      float acc = 0.f;
#pragma unroll 11
      for (int i = 0; i < 33; ++i) acc += sh[i] * swin[i * 64 + lane];
      float hv = sinf(f0 * (acc + b0));
      __builtin_amdgcn_wave_barrier();
      sh[lane] = hv;
      __builtin_amdgcn_wave_barrier();
      acc = 0.f;
#pragma unroll 16
      for (int i = 0; i < 64; ++i) acc += sh[i] * swh[i * 64 + lane];
      hv = sinf(f1 * (acc + b1));
      __builtin_amdgcn_wave_barrier();
      sh[lane] = hv;
      __builtin_amdgcn_wave_barrier();
      acc = 0.f;
#pragma unroll 16
      for (int i = 0; i < 64; ++i) acc += sh[i] * swh[4096 + i * 64 + lane];
      hv = sinf(f2 * (acc + b2));
      __builtin_amdgcn_wave_barrier();
      if (isc) ((float*)(ws + O_HDNC))[lane * LCTX + t] = hv;
      else { ((float*)(ws + O_HDN))[lane * SEQ + t] = hv; ((bf16_t*)(ws + O_HDNB))[t * 64 + lane] = f2bf(hv); }
    }
    __syncthreads();
  }
}

DI void phase_shiftw(const P& p, char* smem) {
  const int tid = otid(), lane = tid & 63, wave = tid >> 6;
  float* sS = (float*)smem;
  float* red = sS + 5 * 1024;
  const float* mod = (const float*)(p.ws + O_MOD);
  float* sw = (float*)(p.ws + O_SW);
  int cur = -1;
  for (int it = blockIdx.x; it < 64 + 40 + 48; it += gridDim.x) {
    const int L = it < 64 ? 1 : (it < 104 ? 2 : 3);
    const int chunk = it < 64 ? it : (it < 104 ? it - 64 : it - 104);
    const int N = L == 1 ? 4096 : (L == 2 ? 2560 : 3072);
    const float* W = L == 1 ? p.in[14] : (L == 2 ? p.in[24] : p.in[27]);
    float* out = sw + (L == 1 ? 0 : (L == 2 ? 5 * 4096 : 5 * (4096 + 2560)));
    __syncthreads();
    if (cur != L) {
      for (int i = tid; i < 5 * 1024; i += NT) sS[i] = mod[(L * 5 + (i >> 10)) * 3072 + (i & 1023)];
      cur = L;
    }
    __syncthreads();
    const int col = chunk * 64 + lane;
    const float* w = W + (size_t)(wave * 128) * N + col;
    float a0 = 0, a1 = 0, a2 = 0, a3 = 0, a4 = 0;
#pragma unroll 8
    for (int k = 0; k < 128; ++k) {
      const float wv = w[(size_t)k * N];
      const int kk = wave * 128 + k;
      a0 += sS[kk] * wv; a1 += sS[1024 + kk] * wv; a2 += sS[2048 + kk] * wv; a3 += sS[3072 + kk] * wv; a4 += sS[4096 + kk] * wv;
    }
    red[(wave * 5 + 0) * 64 + lane] = a0; red[(wave * 5 + 1) * 64 + lane] = a1; red[(wave * 5 + 2) * 64 + lane] = a2;
    red[(wave * 5 + 3) * 64 + lane] = a3; red[(wave * 5 + 4) * 64 + lane] = a4;
    __syncthreads();
    if (tid < 320) {
      const int r = tid >> 6, c = tid & 63;
      float sum = 0;
#pragma unroll
      for (int w8 = 0; w8 < 8; ++w8) sum += red[(w8 * 5 + r) * 64 + c];
      int n = chunk * 64 + c;
      if (L == 3) {
        if (n < 1024) n = (n >> 5) * 64 + (n & 31);
        else if (n < 2048) { const int cc = n - 1024; n = (cc >> 5) * 64 + 32 + (cc & 31); }
      }
      out[r * N + n] = sum;
    }
  }
  __syncthreads();
}

DI void phase_norm(const P& p, int layer, int ntok) {
  const int lane = otid() & 63, wave = otid() >> 6;
  const float* xc = layer == 0 ? p.in[2] : (const float*)(p.ws + O_XC);
  const float* xlat = layer == 0 ? p.in[0] : p.out;
  const float* mod = (const float*)(p.ws + O_MOD) + layer * 5 * 3072;
  const float* g = p.in[4] + layer * 1024;
  bf16_t* act = (bf16_t*)(p.ws + O_ACT);
  for (int row0 = (blockIdx.x * 8 + wave) * 4; row0 < ntok; row0 += gridDim.x * 32) {
    f32x4 v[4][4];
#pragma unroll
    for (int r = 0; r < 4; ++r) {
      const int row = row0 + r;
      const float* x = row < NLAT ? xlat + (size_t)row * 1024 : xc + (size_t)(row - NLAT) * 1024;
#pragma unroll
      for (int i = 0; i < 4; ++i) v[r][i] = ((const f32x4*)x)[lane + 64 * i];
    }
    const float* m = mod + tok_modrow(row0) * 3072;
#pragma unroll
    for (int r = 0; r < 4; ++r) {
      float ss = 0.f;
#pragma unroll
      for (int i = 0; i < 4; ++i) ss += v[r][i].x * v[r][i].x + v[r][i].y * v[r][i].y + v[r][i].z * v[r][i].z + v[r][i].w * v[r][i].w;
      ss = wave_sum(ss);
      const float rstd = rsqrtf(ss * (1.f / 1024.f) + 1e-6f);
#pragma unroll
      for (int i = 0; i < 4; ++i) {
        const int c = (lane + 64 * i) * 4;
        const f32x4 gv = *(const f32x4*)(g + c), sh = *(const f32x4*)(m + c), sc = *(const f32x4*)(m + 1024 + c);
        store4bf(act + (size_t)(row0 + r) * 1024 + c, v[r][i].x * rstd * gv.x * (1.f + sc.x) + sh.x, v[r][i].y * rstd * gv.y * (1.f + sc.y) + sh.y,
                 v[r][i].z * rstd * gv.z * (1.f + sc.z) + sh.z, v[r][i].w * rstd * gv.w * (1.f + sc.w) + sh.w);
      }
    }
  }
}

template <int PER>
DI void small_norm(bf16_t* buf, const float* g) {
  const int lane = otid() & 63, wave = otid() >> 6;
  for (int row = blockIdx.x * 8 + wave; row < NTOK; row += gridDim.x * 8) {
    bf16_t* r = buf + (size_t)row * (64 * PER);
    float v[PER]; float ss = 0.f;
#pragma unroll
    for (int i = 0; i < PER; ++i) { v[i] = bf2f(r[lane + 64 * i]); ss += v[i] * v[i]; }
    ss = wave_sum(ss);
    const float rstd = rsqrtf(ss / (float)(64 * PER) + 1e-6f);
#pragma unroll
    for (int i = 0; i < PER; ++i) r[lane + 64 * i] = f2bf(v[i] * rstd * g[lane + 64 * i]);
  }
}

DI void phase_final(const P& p) {
  const int lane = otid() & 63, wave = otid() >> 6;
  const float* g = p.in[7];
  for (int row = blockIdx.x * 8 + wave; row < NLAT; row += gridDim.x * 8) {
    float* x = p.out + (size_t)row * 1024;
    f32x4 v[4]; float ss = 0.f;
#pragma unroll
    for (int i = 0; i < 4; ++i) { v[i] = ((const f32x4*)x)[lane + 64 * i]; ss += v[i].x * v[i].x + v[i].y * v[i].y + v[i].z * v[i].z + v[i].w * v[i].w; }
    ss = wave_sum(ss);
    const float rstd = rsqrtf(ss * (1.f / 1024.f) + 1e-6f);
#pragma unroll
    for (int i = 0; i < 4; ++i) {
      const int c = (lane + 64 * i) * 4;
      const float4 gv = *(const float4*)(g + c);
      float4 o; o.x = v[i].x * rstd * gv.x; o.y = v[i].y * rstd * gv.y; o.z = v[i].z * rstd * gv.z; o.w = v[i].w * rstd * gv.w;
      ((float4*)x)[lane + 64 * i] = o;
    }
  }
}

struct AttnItem {
  const bf16_t* Kbase; int kld;
  const bf16_t* Vt;
  int b; int a0, n1, n2;
  const bf16_t* Q; int qld;
  int qtok0; int qpos0;
  float minit, linit;
  bf16_t* og; int ocol;
  bool dry;
};

template <int DQK, int DV, bool MASK>
DI void attn_item(const AttnItem& a, char* smem) {
  constexpr int NKS = DQK / 32, NDB = DV / 16;
  constexpr int KBYTES = 64 * DQK * 2, VBYTES = DV * 64 * 2, STG = KBYTES + VBYTES;
  constexpr int KCH = KBYTES / 8192, VCH = VBYTES / 8192;
  const int tid = otid(), lane = tid & 63, lr = lane & 15, lq = lane >> 4;
  bf16x8 qf[2][NKS];
#pragma unroll
  for (int nb = 0; nb < 2; ++nb)
#pragma unroll
    for (int ks = 0; ks < NKS; ++ks) qf[nb][ks] = *(const bf16x8*)(a.Q + (size_t)(nb * 16 + lr) * a.qld + ks * 32 + lq * 8);
  f32x4 o[NDB][2];
#pragma unroll
  for (int i = 0; i < NDB; ++i) { o[i][0] = (f32x4){0.f, 0.f, 0.f, 0.f}; o[i][1] = (f32x4){0.f, 0.f, 0.f, 0.f}; }
  float m[2] = {a.minit, a.minit};
  float l[2] = {lq == 0 ? a.linit : 0.f, lq == 0 ? a.linit : 0.f};
  int kR[KCH], kC[KCH], vOff[VCH];
#pragma unroll
  for (int c = 0; c < KCH; ++c) {
    const int bb = tid * 16 + c * 8192, st = bb >> 10, sb = bb & 1023, swz = sb ^ (((sb >> 9) & 1) << 5);
    kR[c] = (st / NKS) * 16 + (swz >> 6); kC[c] = (st % NKS) * 32 + ((swz & 63) >> 1);
  }
#pragma unroll
  for (int c = 0; c < VCH; ++c) {
    const int bb = tid * 16 + c * 8192, st = bb >> 10, sb = bb & 1023, swz = sb ^ (((sb >> 9) & 1) << 5);
    vOff[c] = ((st >> 1) * 16 + (swz >> 6)) * KEYS + (st & 1) * 32 + ((swz & 63) >> 1);
  }
  const int ntile = a.n1 + a.n2;
#define ATT_STAGE(buf, i)                                                                                     \
  {                                                                                                           \
    const int kt_ = (i) < a.n1 ? a.a0 + (i) : 64 + ((i) - a.n1);                                              \
    const int key0_ = kt_ * 64;                                                                               \
    const int tokb_ = key0_ < SEQ ? a.b * SEQ + key0_ : NLAT + a.b * LCTX + (key0_ - SEQ);                    \
    char* sb_ = smem + (buf) * STG + tid * 16;                                                                \
    _Pragma("unroll") for (int c = 0; c < KCH; ++c)                                                           \
      __builtin_amdgcn_global_load_lds((const unsigned*)(a.Kbase + (size_t)(tokb_ + kR[c]) * a.kld + kC[c]),  \
                                       (__attribute__((address_space(3))) unsigned*)(sb_ + c * 8192), 16, 0, 0); \
    _Pragma("unroll") for (int c = 0; c < VCH; ++c)                                                           \
      __builtin_amdgcn_global_load_lds((const unsigned*)(a.Vt + vOff[c] + key0_),                             \
                                       (__attribute__((address_space(3))) unsigned*)(sb_ + KBYTES + c * 8192), 16, 0, 0); \
  }
  const int ob = lr * 64 + lq * 16;
  const int lane_off = ob ^ (((ob >> 9) & 1) << 5);
  __syncthreads();
  ATT_STAGE(0, 0);
  for (int it = 0; it < ntile; ++it) {
    asm volatile("s_waitcnt vmcnt(0)" ::: "memory");
    __builtin_amdgcn_s_barrier();
    if (it + 1 < ntile) ATT_STAGE((it + 1) & 1, it + 1);
    const char* sK = smem + (it & 1) * STG + lane_off;
    const char* sV = sK + KBYTES;
    f32x4 s[4][2];
#pragma unroll
    for (int kb = 0; kb < 4; ++kb) { s[kb][0] = (f32x4){0.f, 0.f, 0.f, 0.f}; s[kb][1] = (f32x4){0.f, 0.f, 0.f, 0.f}; }
#pragma unroll
    for (int ks = 0; ks < NKS; ++ks)
#pragma unroll
      for (int kb = 0; kb < 4; ++kb) {
        const bf16x8 kf = *(const bf16x8*)(sK + (kb * NKS + ks) * 1024);
        s[kb][0] = mfma16(kf, qf[0][ks], s[kb][0]);
        s[kb][1] = mfma16(kf, qf[1][ks], s[kb][1]);
      }
    if (MASK) {
      const int kt = it < a.n1 ? a.a0 + it : 64;
      const int dq = kt - (a.qpos0 >> 6);
      if (kt < 64 && (dq <= -2 || dq >= 2)) {
#pragma unroll
        for (int nb = 0; nb < 2; ++nb) {
          const int qp = a.qpos0 + nb * 16 + lr;
#pragma unroll
          for (int kb = 0; kb < 4; ++kb)
#pragma unroll
            for (int j = 0; j < 4; ++j) {
              const int kp = kt * 64 + kb * 16 + 4 * lq + j;
              const int dlt = kp - qp;
              if (dlt > 128 || dlt < -128) s[kb][nb][j] = -INFINITY;
            }
        }
      }
    }
    bf16x8 pf[2][2];
#pragma unroll
    for (int nb = 0; nb < 2; ++nb) {
      float mx = -INFINITY;
#pragma unroll
      for (int kb = 0; kb < 4; ++kb)
#pragma unroll
        for (int j = 0; j < 4; ++j) mx = fmaxf(mx, s[kb][nb][j]);
      mx = fmaxf(mx, __shfl_xor(mx, 16, 64));
      mx = fmaxf(mx, __shfl_xor(mx, 32, 64));
      const float mn = fmaxf(m[nb], mx);
      const float alpha = __builtin_amdgcn_exp2f(m[nb] - mn);
      m[nb] = mn;
      float rs = 0.f;
      float pv[4][4];
#pragma unroll
      for (int kb = 0; kb < 4; ++kb)
#pragma unroll
        for (int j = 0; j < 4; ++j) { pv[kb][j] = __builtin_amdgcn_exp2f(s[kb][nb][j] - mn); rs += pv[kb][j]; }
      l[nb] = l[nb] * alpha + rs;
#pragma unroll
      for (int st = 0; st < 2; ++st) {
        u32x4 u;
        u.x = pack2(pv[2 * st][0], pv[2 * st][1]); u.y = pack2(pv[2 * st][2], pv[2 * st][3]);
        u.z = pack2(pv[2 * st + 1][0], pv[2 * st + 1][1]); u.w = pack2(pv[2 * st + 1][2], pv[2 * st + 1][3]);
        pf[nb][st] = __builtin_bit_cast(bf16x8, u);
      }
      if (__builtin_amdgcn_ballot_w64(alpha != 1.f) != 0ull) {
#pragma unroll
        for (int db = 0; db < NDB; ++db) { o[db][nb][0] *= alpha; o[db][nb][1] *= alpha; o[db][nb][2] *= alpha; o[db][nb][3] *= alpha; }
      }
    }
#pragma unroll
    for (int st = 0; st < 2; ++st)
#pragma unroll
      for (int db = 0; db < NDB; ++db) {
        const bf16x8 vf = *(const bf16x8*)(sV + (db * 2 + st) * 1024);
        o[db][0] = mfma16(vf, pf[0][st], o[db][0]);
        o[db][1] = mfma16(vf, pf[1][st], o[db][1]);
      }
  }
#undef ATT_STAGE
  if (a.dry) return;
#pragma unroll
  for (int nb = 0; nb < 2; ++nb) {
    float lt = l[nb];
    lt += __shfl_xor(lt, 16, 64);
    lt += __shfl_xor(lt, 32, 64);
    const float inv = 1.f / lt;
    const int tok = a.qtok0 + nb * 16 + lr;
#pragma unroll
    for (int db = 0; db < NDB; ++db) {
      bf16_t* dst = a.og + (size_t)tok * 1024 + a.ocol + db * 16 + 4 * lq;
      const uint2 g = *(const uint2*)dst;
      const float g0 = __uint_as_float(g.x << 16), g1 = __uint_as_float(g.x & 0xffff0000u);
      const float g2 = __uint_as_float(g.y << 16), g3 = __uint_as_float(g.y & 0xffff0000u);
      store4bf(dst, o[db][nb][0] * inv * g0, o[db][nb][1] * inv * g1, o[db][nb][2] * inv * g2, o[db][nb][3] * inv * g3);
    }
  }
}

DI void phase_mla_attn(const P& p, char* smem, bool dry) {
  const int wave = otid() >> 6;
  const bf16_t* q = (const bf16_t*)(p.ws + O_Q);
  const bf16_t* kp = (const bf16_t*)(p.ws + O_KP);
  const bf16_t* vt = (const bf16_t*)(p.ws + O_ACT);
  bf16_t* og = (bf16_t*)(p.ws + O_SG0);
  const int xcd = blockIdx.x & 7, lb = blockIdx.x >> 3, nlb = (gridDim.x - xcd + 7) >> 3;
  for (int li = lb; li < 68; li += nlb) {
    AttnItem a;
    int b, h, qtok;
    if (li < 64) { const int pair = (li >> 4) * 8 + xcd; b = pair >> 3; h = pair & 7; qtok = b * SEQ + (li & 15) * 256; a.a0 = 0; a.n1 = 64; }
    else { const int pair = (li - 64) * 8 + xcd; b = pair >> 3; h = pair & 7; qtok = NLAT + b * LCTX; a.a0 = 0; a.n1 = 0; }
    a.n2 = 4; a.b = b;
    a.Kbase = kp + h * 192; a.kld = 1536;
    a.Vt = vt + (size_t)(b * 8 + h) * 128 * KEYS;
    a.qtok0 = qtok + wave * 32; a.qpos0 = 0;
    a.Q = q + (size_t)a.qtok0 * 1536 + h * 192; a.qld = 1536;
    a.minit = -INFINITY; a.linit = 0.f;
    a.og = og; a.ocol = h * 128; a.dry = dry;
    attn_item<192, 128, false>(a, smem);
  }
}

DI void phase_swa_attn(const P& p, char* smem, bool dry) {
  const int wave = otid() >> 6;
  const bf16_t* qs = (const bf16_t*)(p.ws + O_QS);
  const bf16_t* ks = (const bf16_t*)(p.ws + O_KS);
  const bf16_t* vt = (const bf16_t*)(p.ws + O_VT2);
  bf16_t* og = (bf16_t*)(p.ws + O_SG2);
  const float* sink = p.in[25];
  for (int it = blockIdx.x; it < 1024; it += gridDim.x) {
    AttnItem a;
    int b, g, qtok, pos0;
    if (it < 1024) {
      b = it >> 8; g = (it >> 6) & 3; const int qb = it & 63;
      pos0 = qb * 64; qtok = b * SEQ + pos0;
      a.a0 = qb - 2 < 0 ? 0 : qb - 2; const int a1 = qb + 3 > 64 ? 64 : qb + 3; a.n1 = a1 - a.a0;
    } else {
      const int j = it - 1024; b = j >> 4; g = (j >> 2) & 3; pos0 = (j & 3) * 64; qtok = NLAT + b * LCTX + pos0;
      a.a0 = 0; a.n1 = 0;
    }
    const int head = g * 4 + (wave >> 1);
    a.n2 = 4; a.b = b;
    a.Kbase = ks + g * 64; a.kld = 256;
    a.Vt = vt + (size_t)(b * 4 + g) * 64 * KEYS;
    a.qtok0 = qtok + (wave & 1) * 32; a.qpos0 = pos0 + (wave & 1) * 32;
    a.Q = qs + (size_t)a.qtok0 * 1024 + head * 64; a.qld = 1024;
    a.minit = sink[head] * LOG2E; a.linit = 1.f;
    a.og = og; a.ocol = head * 64; a.dry = dry;
    attn_item<64, 64, true>(a, smem);
  }
}

typedef f32x2 c32;
DI c32 cmul(c32 a, c32 b) { return (c32){a.x * b.x - a.y * b.y, a.x * b.y + a.y * b.x}; }
DI c32 cmulc(c32 a, c32 b) { return (c32){a.x * b.x + a.y * b.y, a.y * b.x - a.x * b.y}; }
DI int phys(int i) { return i + (i >> 5); }
DI c32 w16(int k) {
  const float c1 = 0.9238795325112867f, s1 = 0.3826834323650898f, r = 0.7071067811865476f;
  switch (k & 7) {
    case 0: return (c32){1.f, 0.f};
    case 1: return (c32){c1, -s1};
    case 2: return (c32){r, -r};
    case 3: return (c32){s1, -c1};
    case 4: return (c32){0.f, -1.f};
    case 5: return (c32){-s1, -c1};
    case 6: return (c32){-r, -r};
    default: return (c32){-c1, -s1};
  }
}
DI c32 w16g(int m) {
  const c32 w = w16(m & 7);
  return (m & 8) ? (c32){-w.x, -w.y} : w;
}
template <bool ZHI>
DI void r4_fwd(c32& x0, c32& x1, c32& x2, c32& x3, c32 t1, c32 t2, c32 t3) {
  const c32 s02 = ZHI ? x0 : x0 + x2, s13 = ZHI ? x1 : x1 + x3, d02 = ZHI ? x0 : x0 - x2, d13 = ZHI ? x1 : x1 - x3;
  const c32 e = (c32){d13.y, -d13.x};
  x0 = s02 + s13; x1 = cmul(s02 - s13, t1); x2 = cmul(d02 + e, t2); x3 = cmul(d02 - e, t3);
}
template <bool LOONLY>
DI void r4_inv(c32& x0, c32& x1, c32& x2, c32& x3, c32 t1, c32 t2, c32 t3) {
  const c32 p1 = cmulc(x1, t1), p2 = cmulc(x2, t2), p3 = cmulc(x3, t3);
  const c32 a = x0 + p1, b = x0 - p1, c = p2 + p3, dd = p2 - p3;
  const c32 d = (c32){-dd.y, dd.x};
  x0 = a + c; x1 = b + d;
  if (!LOONLY) { x2 = a - c; x3 = b - d; }
}
template <bool ZHI>
DI void fft16_fwd2(c32 (&v0)[16], c32 (&v1)[16], c32 w1) {
  const c32 w2 = cmul(w1, w1), w3 = cmul(w1, w2), w4 = cmul(w2, w2), w8 = cmul(w4, w4), w48 = cmul(w4, w8);
#pragma unroll
  for (int k = 0; k < 4; ++k) {
    const c32 tB = k ? cmul(w2, w16g(2 * k)) : w2, tA = k ? cmul(w1, w16g(k)) : w1, tAB = k ? cmul(w3, w16g(3 * k)) : w3;
    r4_fwd<ZHI>(v0[k], v0[k + 4], v0[k + 8], v0[k + 12], tB, tA, tAB);
    r4_fwd<ZHI>(v1[k], v1[k + 4], v1[k + 8], v1[k + 12], tB, tA, tAB);
  }
#pragma unroll
  for (int q = 0; q < 16; q += 4) {
    r4_fwd<false>(v0[q], v0[q + 1], v0[q + 2], v0[q + 3], w8, w4, w48);
    r4_fwd<false>(v1[q], v1[q + 1], v1[q + 2], v1[q + 3], w8, w4, w48);
  }
}
template <bool LOONLY>
DI void fft16_inv2(c32 (&v0)[16], c32 (&v1)[16], c32 w1) {
  const c32 w2 = cmul(w1, w1), w3 = cmul(w1, w2), w4 = cmul(w2, w2), w8 = cmul(w4, w4), w48 = cmul(w4, w8);
#pragma unroll
  for (int q = 0; q < 16; q += 4) {
    r4_inv<false>(v0[q], v0[q + 1], v0[q + 2], v0[q + 3], w8, w4, w48);
    r4_inv<false>(v1[q], v1[q + 1], v1[q + 2], v1[q + 3], w8, w4, w48);
  }
#pragma unroll
  for (int k = 0; k < 4; ++k) {
    const c32 tB = k ? cmul(w2, w16g(2 * k)) : w2, tA = k ? cmul(w1, w16g(k)) : w1, tAB = k ? cmul(w3, w16g(3 * k)) : w3;
    r4_inv<LOONLY>(v0[k], v0[k + 4], v0[k + 8], v0[k + 12], tB, tA, tAB);
    r4_inv<LOONLY>(v1[k], v1[k + 4], v1[k + 8], v1[k + 12], tB, tA, tAB);
  }
}
template <int H, bool INV, bool PRUNE>
DI void fft_pass16(c32* X0, c32* X1) {
  constexpr int ST = H / 16;
  const int tid = otid();
  const int jb = tid & (ST - 1), base = (tid / ST) * H + jb;
  c32 v0[16], v1[16];
  constexpr int NLD = (PRUNE && !INV) ? 8 : 16, NSTR = (PRUNE && INV) ? 8 : 16;
#pragma unroll
  for (int k = 0; k < NLD; ++k) { v0[k] = X0[phys(base + k * ST)]; v1[k] = X1[phys(base + k * ST)]; }
#pragma unroll
  for (int k = NLD; k < 16; ++k) { v0[k] = (c32){0.f, 0.f}; v1[k] = (c32){0.f, 0.f}; }
  const float fr = (float)jb * (1.f / (float)H);
  const c32 w1 = (c32){__builtin_amdgcn_cosf(fr), -__builtin_amdgcn_sinf(fr)};
  if (INV) fft16_inv2<PRUNE>(v0, v1, w1); else fft16_fwd2<PRUNE>(v0, v1, w1);
#pragma unroll
  for (int k = 0; k < NSTR; ++k) { X0[phys(base + k * ST)] = v0[k]; X1[phys(base + k * ST)] = v1[k]; }
  __syncthreads();
}
DI void fft_pass2(c32* X0, c32* X1) {
  const int tid = otid();
#pragma unroll
  for (int i = 0; i < 8; ++i) {
    const int i0 = phys(2 * (tid + NT * i));
    const c32 a = X0[i0], b = X0[i0 + 1], c = X1[i0], d = X1[i0 + 1];
    X0[i0] = a + b; X0[i0 + 1] = a - b; X1[i0] = c + d; X1[i0 + 1] = c - d;
  }
  __syncthreads();
}
template <bool PRUNE>
DI void fft_fwd(c32* X0, c32* X1) { fft_pass16<8192, false, PRUNE>(X0, X1); fft_pass16<512, false, false>(X0, X1); fft_pass16<32, false, false>(X0, X1); fft_pass2(X0, X1); }
DI void fft_conv(c32* X0, c32* X1, const c32* __restrict__ Ks) {
  fft_pass16<8192, false, true>(X0, X1); fft_pass16<512, false, false>(X0, X1); fft_pass16<32, false, false>(X0, X1);
  {
    const int tid = otid();
#pragma unroll
    for (int i = 0; i < 8; ++i) {
      const int mm = tid + NT * i, i0 = phys(2 * mm);
      const f32x4 kk = *(const f32x4*)(Ks + 2 * mm);
      const c32 k0 = (c32){kk.x, kk.y}, k1 = (c32){kk.z, kk.w};
      const c32 a = X0[i0], b = X0[i0 + 1], c = X1[i0], d = X1[i0 + 1];
      const c32 pa = cmul(a + b, k0), pb = cmul(a - b, k1), pc = cmul(c + d, k0), pd = cmul(c - d, k1);
      X0[i0] = pa + pb; X0[i0 + 1] = pa - pb; X1[i0] = pc + pd; X1[i0 + 1] = pc - pd;
    }
    __syncthreads();
  }
  fft_pass16<32, true, false>(X0, X1); fft_pass16<512, true, false>(X0, X1); fft_pass16<8192, true, true>(X0, X1);
}
DI void spec_mul(c32* X0, c32* X1, const c32* __restrict__ Ks) {
  const int tid = otid();
#pragma unroll 8
  for (int i = 0; i < 16; ++i) {
    const c32 k = Ks[tid + NT * i];
    const int n = phys(tid + NT * i);
    X0[n] = cmul(X0[n], k); X1[n] = cmul(X1[n], k);
  }
  __syncthreads();
}
DI float sconv(const bf16_t* u, int t, int len, float w0, float w1, float w2, float cb) {
  float r = cb + w1 * bf2f(u[t]);
  if (t > 0) r += w0 * bf2f(u[t - 1]);
  if (t + 1 < len) r += w2 * bf2f(u[t + 1]);
  return r;
}

DI void sconv8(const bf16_t* u, int t0, int len, float w0, float w1, float w2, float cb, float (&out)[8]) {
  const u32x4 raw = *(const u32x4*)(u + t0);
  float x[10];
  x[0] = t0 > 0 ? bf2f(u[t0 - 1]) : 0.f;
  x[9] = t0 + 8 < len ? bf2f(u[t0 + 8]) : 0.f;
#pragma unroll
  for (int i = 0; i < 4; ++i) { x[1 + 2 * i] = __uint_as_float(raw[i] << 16); x[2 + 2 * i] = __uint_as_float(raw[i] & 0xffff0000u); }
#pragma unroll
  for (int i = 0; i < 8; ++i) out[i] = cb + w0 * x[i] + w1 * x[i + 1] + w2 * x[i + 2];
}

DI void phase_hyena(const P& p, char* smem, float* aux, bool dry) {
  const int tid = otid();
  c32* X0 = (c32*)smem; c32* X1 = (c32*)(smem + 67584);
  bf16_t* ut = (bf16_t*)(p.ws + O_UT);
  const float* hdn = (const float*)(p.ws + O_HDN);
  const float* hdnc = (const float*)(p.ws + O_HDNC);
  c32* Ksp = (c32*)(p.ws + O_FFT + (size_t)blockIdx.x * 131072);
  const float* cw = p.in[15];
  const float* cbv = p.in[16];
  const float* fwo = p.in[21];
  const float* hb = p.in[22];
  for (int c = blockIdx.x; c < 1024; c += gridDim.x) {
    __syncthreads();
    { const int ta = otid(); if (ta < 256) aux[ta] = fwo[(size_t)(ta >> 2) * 4096 + (ta & 3) * 1024 + c]; }
    __syncthreads();
    const float la0 = -15.350567286626973f, la1 = -3.0701134573253945f;
    const float delta = fabsf(la0 + (la1 - la0) * ((float)c / 1023.f));
    const float bias0 = hb[c], bias1 = hb[1024 + c];
    float w0[3], w1[3], w2[3], cb[3];
#pragma unroll
    for (int r = 0; r < 3; ++r) { const int f = r * 1024 + c; w0[r] = cw[f]; w1[r] = cw[3072 + f]; w2[r] = cw[6144 + f]; cb[r] = cbv[f]; }
    const int t0 = tid * 8;
    {
      const int lane = tid & 63, wv = tid >> 6, lr = lane & 15, lq = lane >> 4;
      const bf16_t* hdnb = (const bf16_t*)(p.ws + O_HDNB);
      bf16x8 bfr[2];
#pragma unroll
      for (int ks = 0; ks < 2; ++ks) {
        u32x4 u;
#pragma unroll
        for (int e = 0; e < 4; ++e) {
          const int j0 = ks * 32 + lq * 8 + 2 * e;
          const float wa = lr < 4 ? aux[j0 * 4 + lr] : 0.f, wb = lr < 4 ? aux[(j0 + 1) * 4 + lr] : 0.f;
          u[e] = pack2(wa, wb);
        }
        bfr[ks] = __builtin_bit_cast(bf16x8, u);
      }
      const int o = (lr >> 1) & 1, dir = lr & 1;
      c32* Xo = o ? X1 : X0;
#pragma unroll 1
      for (int mb0 = 0; mb0 < 32; mb0 += 8) {
        bf16x8 a0[8], a1[8];
#pragma unroll
        for (int i = 0; i < 8; ++i) {
          const bf16_t* src = hdnb + (size_t)((wv * 32 + mb0 + i) * 16 + lr) * 64 + lq * 8;
          a0[i] = *(const bf16x8*)src; a1[i] = *(const bf16x8*)(src + 32);
        }
#pragma unroll
        for (int i = 0; i < 8; ++i) {
          f32x4 cc = (f32x4){0.f, 0.f, 0.f, 0.f};
          cc = mfma16(a0[i], bfr[0], cc);
          cc = mfma16(a1[i], bfr[1], cc);
#pragma unroll
          for (int j = 0; j < 4; ++j) {
            const int t = (wv * 32 + mb0 + i) * 16 + 4 * lq + j;
            const float val = cc[j] * __expf(-((float)t / 4095.f) * delta);
            const float partner = __shfl_xor(val, 1, 64);
            if (lr < 4) {
              if (t == 0) { if (dir == 0) Xo[0] = (c32){val + partner, 0.f}; else Xo[phys(4096)] = (c32){0.f, 0.f}; }
              else Xo[phys(dir ? 8192 - t : t)] = (c32){val, 0.f};
            }
          }
        }
      }
      __syncthreads();
      fft_fwd<false>(X0, X1);
#pragma unroll 4
      for (int i = 0; i < 16; ++i) { Ksp[tid + NT * i] = X0[phys(tid + NT * i)]; Ksp[8192 + tid + NT * i] = X1[phys(tid + NT * i)]; }
      __syncthreads();
    }
    const bf16_t* uv = ut + (size_t)c * NTOK;
    const bf16_t* ug0 = ut + (size_t)(1024 + c) * NTOK;
    const bf16_t* ug1 = ut + (size_t)(2048 + c) * NTOK;
    bf16_t* usg = ut + (size_t)(3072 + c) * NTOK;
    {
      float z[4][8], g[4][8];
#pragma unroll
      for (int bb = 0; bb < 4; ++bb) sconv8(uv + bb * SEQ, t0, SEQ, w0[0], w1[0], w2[0], cb[0], z[bb]);
#pragma unroll
      for (int i = 0; i < 8; ++i) {
        X0[phys(t0 + i)] = (c32){z[0][i], z[1][i]};
        X1[phys(t0 + i)] = (c32){z[2][i], z[3][i]};
      }
      __syncthreads();
      fft_conv(X0, X1, Ksp);
      const int t0b = otid() * 8;
#pragma unroll
      for (int bb = 0; bb < 4; ++bb) sconv8(ug0 + bb * SEQ, t0b, SEQ, w0[1], w1[1], w2[1], cb[1], g[bb]);
#pragma unroll
      for (int i = 0; i < 8; ++i) {
        const c32 y0 = X0[phys(t0b + i)], y1 = X1[phys(t0b + i)];
        z[0][i] = g[0][i] * (y0.x * (1.f / 8192.f) + z[0][i] * bias0);
        z[1][i] = g[1][i] * (y0.y * (1.f / 8192.f) + z[1][i] * bias0);
        z[2][i] = g[2][i] * (y1.x * (1.f / 8192.f) + z[2][i] * bias0);
        z[3][i] = g[3][i] * (y1.y * (1.f / 8192.f) + z[3][i] * bias0);
      }
      __syncthreads();
#pragma unroll
      for (int i = 0; i < 8; ++i) {
        X0[phys(t0b + i)] = (c32){z[0][i], z[1][i]};
        X1[phys(t0b + i)] = (c32){z[2][i], z[3][i]};
      }
      __syncthreads();
      fft_conv(X0, X1, Ksp + 8192);
      const int t0c = otid() * 8;
#pragma unroll
      for (int bb = 0; bb < 4; ++bb) sconv8(ug1 + bb * SEQ, t0c, SEQ, w0[2], w1[2], w2[2], cb[2], g[bb]);
#pragma unroll
      for (int bb = 0; bb < 4; ++bb) {
        const u32x4 sgv = *(const u32x4*)(usg + bb * SEQ + t0c);
        float oo[8];
#pragma unroll
        for (int i = 0; i < 8; ++i) {
          const c32 y = (bb < 2) ? X0[phys(t0c + i)] : X1[phys(t0c + i)];
          const float yy = (bb & 1) ? y.y : y.x;
          const float zz = g[bb][i] * (yy * (1.f / 8192.f) + z[bb][i] * bias1);
          const unsigned ra = sgv[i >> 1];
          const float fa = (i & 1) ? __uint_as_float(ra & 0xffff0000u) : __uint_as_float(ra << 16);
          oo[i] = zz * fa;
        }
        u32x4 wv;
        wv.x = pack2(oo[0], oo[1]); wv.y = pack2(oo[2], oo[3]); wv.z = pack2(oo[4], oo[5]); wv.w = pack2(oo[6], oo[7]);
        if (!dry) *(u32x4*)(usg + bb * SEQ + t0c) = wv;
      }
      __syncthreads();
    }
  }
  for (int cb0 = blockIdx.x; cb0 < 1024; cb0 += 4 * gridDim.x) {
    float* aux4 = (float*)smem;
    float* klag = aux4 + 1024;
    f32x4* su = (f32x4*)(klag + 4096);
    f32x4* sz4 = su + 1024;
    f32x4* part = sz4 + 1024;
    int cch[4];
#pragma unroll
    for (int ch = 0; ch < 4; ++ch) { const int cc = cb0 + ch * gridDim.x; cch[ch] = cc < 1024 ? cc : cb0; }
    __syncthreads();
    {
      const int ta = otid();
      if (ta < 256) {
#pragma unroll
        for (int ch = 0; ch < 4; ++ch) aux4[ch * 256 + ta] = fwo[(size_t)(ta >> 2) * 4096 + (ta & 3) * 1024 + cch[ch]];
      }
    }
    __syncthreads();
    {
      const int tf = otid();
      const int t = tf & 255, o = tf >> 8;
      float a0[4] = {0.f, 0.f, 0.f, 0.f}, a1[4] = {0.f, 0.f, 0.f, 0.f};
#pragma unroll 16
      for (int j = 0; j < 64; ++j) {
        const float hv = hdnc[j * LCTX + t];
#pragma unroll
        for (int ch = 0; ch < 4; ++ch) { a0[ch] += hv * aux4[ch * 256 + j * 4 + 2 * o]; a1[ch] += hv * aux4[ch * 256 + j * 4 + 2 * o + 1]; }
      }
#pragma unroll
      for (int ch = 0; ch < 4; ++ch) {
        const float la0 = -15.350567286626973f, la1 = -3.0701134573253945f;
        const float delta = fabsf(la0 + (la1 - la0) * ((float)cch[ch] / 1023.f));
        const float dec = __expf(-((float)t / 255.f) * delta);
        float* kl = klag + ch * 1024 + o * 512;
        if (t == 0) kl[255] = (a0[ch] + a1[ch]) * dec;
        else { kl[255 + t] = a0[ch] * dec; kl[255 - t] = a1[ch] * dec; }
      }
    }
    const int tc = otid();
    const int t = tc & 255, half = tc >> 8;
    float vreg[4][2], g0r[4][2], g1r[4][2], z1[4][2];
#pragma unroll
    for (int ch = 0; ch < 4; ++ch) {
      const int c = cch[ch];
      const bf16_t* uv = ut + (size_t)c * NTOK;
      const bf16_t* ug0 = ut + (size_t)(1024 + c) * NTOK;
      const bf16_t* ug1 = ut + (size_t)(2048 + c) * NTOK;
#pragma unroll
      for (int i = 0; i < 2; ++i) {
        const int base = NLAT + (2 * half + i) * LCTX;
        vreg[ch][i] = sconv(uv + base, t, LCTX, cw[c], cw[3072 + c], cw[6144 + c], cbv[c]);
        g0r[ch][i] = sconv(ug0 + base, t, LCTX, cw[1024 + c], cw[3072 + 1024 + c], cw[6144 + 1024 + c], cbv[1024 + c]);
        g1r[ch][i] = sconv(ug1 + base, t, LCTX, cw[2048 + c], cw[3072 + 2048 + c], cw[6144 + 2048 + c], cbv[2048 + c]);
        ((float*)(su + ch * 256))[t * 4 + 2 * half + i] = vreg[ch][i];
      }
    }
    __syncthreads();
#pragma unroll
    for (int o = 0; o < 2; ++o) {
#pragma unroll
      for (int ch = 0; ch < 4; ++ch) {
        const f32x4* src = (o == 0 ? su : sz4) + ch * 256;
        const float* kl = klag + ch * 1024 + o * 512 + t + 255 - half * 128;
        f32x4 acc = (f32x4){0.f, 0.f, 0.f, 0.f};
#pragma unroll 8
        for (int s2 = 0; s2 < 128; ++s2) acc += kl[-s2] * src[half * 128 + s2];
        part[ch * 512 + half * 256 + t] = acc;
      }
      __syncthreads();
#pragma unroll
      for (int ch = 0; ch < 4; ++ch) {
        const int c = cch[ch];
        const f32x4 p0 = part[ch * 512 + t], p1 = part[ch * 512 + 256 + t];
        const float bias0 = hb[c], bias1 = hb[1024 + c];
        bf16_t* usg = ut + (size_t)(3072 + c) * NTOK;
#pragma unroll
        for (int i = 0; i < 2; ++i) {
          const int bsel = 2 * half + i;
          const float y = (bsel == 0 ? p0.x + p1.x : bsel == 1 ? p0.y + p1.y : bsel == 2 ? p0.z + p1.z : p0.w + p1.w);
          if (o == 0) {
            z1[ch][i] = g0r[ch][i] * (y + vreg[ch][i] * bias0);
            ((float*)(sz4 + ch * 256))[t * 4 + bsel] = z1[ch][i];
          } else {
            const float z2 = g1r[ch][i] * (y + z1[ch][i] * bias1);
            const int tok = NLAT + bsel * LCTX + t;
            if (!dry && (ch == 0 || cb0 + ch * (int)gridDim.x < 1024)) usg[tok] = f2bf(z2 * bf2f(usg[tok]));
          }
        }
      }
      __syncthreads();
    }
  }
}

DI void phase_hy_transpose(const P& p, char* smem) {
  const int tid = otid();
  const bf16_t* z = (const bf16_t*)(p.ws + O_UT) + (size_t)3072 * NTOK;
  bf16_t* og = (bf16_t*)(p.ws + O_ACT);
  bf16_t* tile = (bf16_t*)smem;
  for (int t = blockIdx.x; t < 272 * 16; t += gridDim.x) {
    const int tk0 = (t >> 4) * 64, c0 = (t & 15) * 64;
    __syncthreads();
    { const int ch = tid >> 3, kc = tid & 7;
      *(u32x4*)(tile + ch * 72 + kc * 8) = *(const u32x4*)(z + (size_t)(c0 + ch) * NTOK + tk0 + kc * 8); }
    __syncthreads();
    { const int tk = tid >> 3, cc = tid & 7;
      u32x4 v;
      v.x = (unsigned)tile[(cc * 8 + 0) * 72 + tk] | ((unsigned)tile[(cc * 8 + 1) * 72 + tk] << 16);
      v.y = (unsigned)tile[(cc * 8 + 2) * 72 + tk] | ((unsigned)tile[(cc * 8 + 3) * 72 + tk] << 16);
      v.z = (unsigned)tile[(cc * 8 + 4) * 72 + tk] | ((unsigned)tile[(cc * 8 + 5) * 72 + tk] << 16);
      v.w = (unsigned)tile[(cc * 8 + 6) * 72 + tk] | ((unsigned)tile[(cc * 8 + 7) * 72 + tk] << 16);
      *(u32x4*)(og + (size_t)(tk0 + tk) * 1024 + c0 + cc * 8) = v; }
  }
}

DI void phase_cfconv(const P& p, char* smem) {
  const int tid = otid(), lane = tid & 63, wave = tid >> 6;
  const bf16_t* u3 = (const bf16_t*)(p.ws + O_U3);
  const bf16_t* sg = (const bf16_t*)(p.ws + O_SG3);
  bf16_t* og = (bf16_t*)(p.ws + O_ACT);
  float* red = (float*)smem;
  float* red2 = red + 256;
  const int c0 = tid * 2;
  float w[31][2];
#pragma unroll
  for (int k = 0; k < 31; ++k) { const float2 t = *(const float2*)(p.in[28] + k * 1024 + c0); w[k][0] = t.x; w[k][1] = t.y; }
  const float2 bb = *(const float2*)(p.in[29] + c0), lg = *(const float2*)(p.in[30] + c0), lb = *(const float2*)(p.in[31] + c0);
  for (int tile = blockIdx.x; tile < 1024; tile += gridDim.x) {
    const int tok0 = tile * 16, b = tok0 >> 12, pos0 = tok0 & 4095;
    float acc[16][2];
#pragma unroll
    for (int o = 0; o < 16; ++o) { acc[o][0] = bb.x; acc[o][1] = bb.y; }
#pragma unroll
    for (int r = 0; r < 46; ++r) {
      const int pos = pos0 - 15 + r;
      const int pc = pos < 0 ? 0 : (pos > 4095 ? 4095 : pos);
      unsigned raw = *(const unsigned*)(u3 + (size_t)(b * SEQ + pc) * 1024 + c0);
      if (pos != pc) raw = 0u;
      const float x0 = __uint_as_float(raw << 16), x1 = __uint_as_float(raw & 0xffff0000u);
#pragma unroll
      for (int o = 0; o < 16; ++o) {
        const int j = r - o;
        if (j >= 0 && j <= 30) { acc[o][0] += w[j][0] * x0; acc[o][1] += w[j][1] * x1; }
      }
    }
    __syncthreads();
#pragma unroll
    for (int o = 0; o < 16; ++o) {
      float s1 = acc[o][0] + acc[o][1];
      float s2 = acc[o][0] * acc[o][0] + acc[o][1] * acc[o][1];
      s1 = wave_sum(s1); s2 = wave_sum(s2);
      if (lane == 0) { red[wave * 32 + o] = s1; red[wave * 32 + 16 + o] = s2; }
    }
    __syncthreads();
    if (tid < 32) {
      float s = 0.f;
#pragma unroll
      for (int w8 = 0; w8 < 8; ++w8) s += red[w8 * 32 + tid];
      red2[tid] = s;
    }
    __syncthreads();
#pragma unroll
    for (int o = 0; o < 16; ++o) {
      const float mean = red2[o] * (1.f / 1024.f);
      const float var = red2[16 + o] * (1.f / 1024.f) - mean * mean;
      const float rstd = rsqrtf(fmaxf(var, 0.f) + 1e-6f);
      const int tok = tok0 + o;
      const unsigned graw = *(const unsigned*)(sg + (size_t)tok * 1024 + c0);
      const float y0 = siluf((acc[o][0] - mean) * rstd * lg.x + lb.x) * __uint_as_float(graw << 16);
      const float y1 = siluf((acc[o][1] - mean) * rstd * lg.y + lb.y) * __uint_as_float(graw & 0xffff0000u);
      *(unsigned*)(og + (size_t)tok * 1024 + c0) = pack2(y0, y1);
    }
  }
}


#define XB_TMO      128
#define XB_XCNT(j)  (256  + 64 * (j))
#define XB_XSUB(j)  (1280 + 64 * (j))
#define XB_XGEN(j)  (2304 + 64 * (j))
#define XB_TOP      3328
#define XB_TOPGEN   3392
#define XCD_BAR_WORDS 3456
#define XB_SPIN_CAP (1u << 22)
#define LAS __attribute__((address_space(3)))
DI unsigned xb_ld(unsigned* p) { return __hip_atomic_load(p, __ATOMIC_RELAXED, __HIP_MEMORY_SCOPE_AGENT); }
DI unsigned xb_add(unsigned* p, unsigned v) { return __hip_atomic_fetch_add(p, v, __ATOMIC_RELAXED, __HIP_MEMORY_SCOPE_AGENT); }
DI unsigned xb_xcc_id() { return (unsigned)__builtin_amdgcn_s_getreg((3 << 11) | 20) & 0xFu; }
#define XB_SPIN(cond, bar) do { unsigned _sp = 0; while (cond) { __builtin_amdgcn_s_sleep(1); \
    if ((++_sp & 255u) == 0u) { if (xb_ld(&(bar)[XB_TMO])) break; if (_sp > XB_SPIN_CAP) { atomicAdd(&(bar)[XB_TMO], 1u); break; } } } } while (0)
struct XcdBarrier { unsigned* bar; unsigned x; volatile LAS unsigned* st; };
DI XcdBarrier xcd_barrier_post(unsigned* bar, volatile LAS unsigned* st) {
  XcdBarrier b; b.bar = bar; b.x = xb_xcc_id(); b.st = st;
  if (threadIdx.x == 0) (void)xb_add(&bar[XB_XCNT(b.x)], 1u);
  return b;
}
DI void xcd_barrier_complete(unsigned* bar, unsigned x, unsigned& nloc, unsigned& nx) {
  const unsigned G = gridDim.x * gridDim.y * gridDim.z;
  unsigned sum, cnt, mine, sp = 0u;
  for (;;) {
    sum = 0u; cnt = 0u; mine = 0u;
#pragma unroll
    for (unsigned j = 0; j < 16; ++j) { const unsigned c = xb_ld(&bar[XB_XCNT(j)]); sum += c; cnt += (c > 0u) ? 1u : 0u; mine = (j == x) ? c : mine; }
    if (sum == G) break;
    __builtin_amdgcn_s_sleep(1);
    if ((++sp & 255u) == 0u) { if (xb_ld(&bar[XB_TMO])) break; if (sp > XB_SPIN_CAP) { atomicAdd(&bar[XB_TMO], 1u); break; } }
  }
  nloc = mine > 0u ? mine : 1u; nx = cnt > 0u ? cnt : 1u;
}
__device__ __attribute__((noinline)) void xcd_barrier(unsigned* bbar, unsigned bx, volatile LAS unsigned* bst, bool leader) {
  XcdBarrier b; b.bar = bbar; b.x = bx; b.st = bst;
  asm volatile("s_waitcnt vmcnt(0)" ::: "memory");
  __syncthreads();
  if (leader) {
    unsigned* bar = b.bar;
    __builtin_amdgcn_s_waitcnt(0);
    unsigned nloc = b.st[0], nx = b.st[1];
    if (nloc == 0u) { xcd_barrier_complete(bar, b.x, nloc, nx); b.st[0] = nloc; b.st[1] = nx; }
    const unsigned old = xb_add(&bar[XB_XSUB(b.x)], 1u);
    const unsigned gen = old / nloc;
    if (old + 1u == (gen + 1u) * nloc) {
      __builtin_amdgcn_fence(__ATOMIC_RELEASE, "agent");
      asm volatile("s_waitcnt vmcnt(0)" ::: "memory");
      const unsigned og = xb_add(&bar[XB_TOP], 1u);
      const unsigned tg = og / nx;
      if (og + 1u == (tg + 1u) * nx) xb_add(&bar[XB_TOPGEN], 1u);
      else XB_SPIN(xb_ld(&bar[XB_TOPGEN]) == tg, bar);
      __builtin_amdgcn_fence(__ATOMIC_ACQUIRE, "agent");
      xb_add(&bar[XB_XGEN(b.x)], 1u);
      asm volatile("s_waitcnt vmcnt(0)" ::: "memory");
    } else {
      XB_SPIN(xb_ld(&bar[XB_XGEN(b.x)]) == gen, bar);
      __builtin_amdgcn_fence(__ATOMIC_ACQUIRE, "agent");
      asm volatile("s_waitcnt vmcnt(0)" ::: "memory");
    }
  }
  __syncthreads();
}

__global__ void __launch_bounds__(NT) mega(P p) {
  cg::grid_group grid = cg::this_grid();
  extern __shared__ __attribute__((aligned(16))) char smem[];
  __shared__ float aux[256];
  __shared__ uint4 xb_words;
  if (threadIdx.x == 0) xb_words = make_uint4(0u, 0u, 0u, 0u);
  __syncthreads();
  const XcdBarrier xb = xcd_barrier_post((unsigned*)(p.ws + O_BAR), (volatile LAS unsigned*)&xb_words);
  if (p.reps[7] == 0x7fffffff) grid.sync();

#define REP(g) for (int rep_ = 0; rep_ < p.reps[g]; ++rep_)
  REP(0) { phase0(p, smem); xcd_barrier(xb.bar, xb.x, xb.st, otid() == 0); }
  REP(1) { phase_norm(p, 0, NTOK); phase_shiftw(p, smem); xcd_barrier(xb.bar, xb.x, xb.st, otid() == 0); }
  REP(2) {
    unsigned char* ws = opq(p.ws); const bf16_t* act = (const bf16_t*)(ws + O_ACT); const float2* rope = (const float2*)(ws + O_ROPE); (void)act; (void)rope;
    EpiMlaIn e{(bf16_t*)(ws + O_CQ), (bf16_t*)(ws + O_CKV), (bf16_t*)(ws + O_KP), (bf16_t*)(ws + O_SG0), rope, (float*)(ws + O_RSS)};
    gemm_phase256((const bf16_t*)(ws + O_W_MLA_IN), act, 1024, 1792, NTOK, smem, e, rep_ + 1 < p.reps[2]);
    xcd_barrier(xb.bar, xb.x, xb.st, otid() == 0);
  }
  REP(2) {
    unsigned char* ws = opq(p.ws); const bf16_t* act = (const bf16_t*)(ws + O_ACT); const float2* rope = (const float2*)(ws + O_ROPE); (void)act; (void)rope;
    EpiUq e1{(bf16_t*)(ws + O_Q), rope, (const float*)(ws + O_RSS)};
    EpiUkv e2{(bf16_t*)(ws + O_KP), (bf16_t*)(ws + O_ACT), (const float*)(ws + O_RSS)};
    TileWalk tw(14, 68);
    int ft, tt;
    while (tw.next(ft, tt)) {
      if (ft < 6) gemm_tile8p((const bf16_t*)(ws + O_W_UQ), (const bf16_t*)(ws + O_CQ), 384, ft * 256, tt * 256, smem, e1, rep_ + 1 < p.reps[2]);
      else gemm_tile8p((const bf16_t*)(ws + O_W_UKV), (const bf16_t*)(ws + O_CKV), 256, (ft - 6) * 256, tt * 256, smem, e2, rep_ + 1 < p.reps[2]);
    }
    xcd_barrier(xb.bar, xb.x, xb.st, otid() == 0);
  }
  REP(4) { phase_mla_attn(p, smem, rep_ + 1 < p.reps[4]); xcd_barrier(xb.bar, xb.x, xb.st, otid() == 0); }
  REP(3) {
    unsigned char* ws = opq(p.ws); const bf16_t* act = (const bf16_t*)(ws + O_ACT); float* xc = (float*)(ws + O_XC); float* mod = (float*)(ws + O_MOD); (void)act;
    EpiRes e{p.in[0], p.in[2], p.out, xc, mod + 0 * 5 * 3072, rep_ + 1 < p.reps[3], (bf16_t*)(ws + O_ACT), p.in[4] + 1 * 1024, mod + 1 * 5 * 3072, (float*)(ws + O_RSSL) + 0 * NTOK};
    gemm_phase256((const bf16_t*)(ws + O_W_MLA_OUT), (const bf16_t*)(ws + O_SG0), 1024, 1024, NTOK, smem, e);
    xcd_barrier(xb.bar, xb.x, xb.st, otid() == 0);
  }
  REP(2) {
    unsigned char* ws = opq(p.ws); const bf16_t* act = (const bf16_t*)(ws + O_ACT); const float2* rope = (const float2*)(ws + O_ROPE); (void)act; (void)rope;
    EpiHyIn e{(bf16_t*)(ws + O_UT), PreNorm{(const float*)(ws + O_RSSL) + 0 * NTOK, (const float*)(ws + O_SW), 4096}};
    gemm_phase256((const bf16_t*)(ws + O_W_HY_IN), act, 1024, 4096, NTOK, smem, e, rep_ + 1 < p.reps[2]);
    xcd_barrier(xb.bar, xb.x, xb.st, otid() == 0);
  }
  REP(5) { phase_hyena(p, smem, aux, rep_ + 1 < p.reps[5]); xcd_barrier(xb.bar, xb.x, xb.st, otid() == 0); }
  phase_hy_transpose(p, smem);
  xcd_barrier(xb.bar, xb.x, xb.st, otid() == 0);
  REP(3) {
    unsigned char* ws = opq(p.ws); const bf16_t* act = (const bf16_t*)(ws + O_ACT); float* xc = (float*)(ws + O_XC); float* mod = (float*)(ws + O_MOD); (void)act;
    EpiRes e{p.out, xc, p.out, xc, mod + 1 * 5 * 3072, rep_ + 1 < p.reps[3], (bf16_t*)(ws + O_XG2), p.in[4] + 2 * 1024, mod + 2 * 5 * 3072, (float*)(ws + O_RSSL) + 1 * NTOK};
    gemm_phase256((const bf16_t*)(ws + O_W_HY_OUT), act, 1024, 1024, NTOK, smem, e);
    xcd_barrier(xb.bar, xb.x, xb.st, otid() == 0);
  }
  REP(2) {
    unsigned char* ws = opq(p.ws); const bf16_t* act = (const bf16_t*)(ws + O_ACT); const float2* rope = (const float2*)(ws + O_ROPE); (void)act; (void)rope;
    EpiSwaIn e{(bf16_t*)(ws + O_QS), (bf16_t*)(ws + O_KS), (bf16_t*)(ws + O_VT2), (bf16_t*)(ws + O_SG2), rope, PreNorm{(const float*)(ws + O_RSSL) + 1 * NTOK, (const float*)(ws + O_SW) + 5 * 4096, 2560}};
    gemm_phase256((const bf16_t*)(ws + O_W_SWA_IN), (const bf16_t*)(ws + O_XG2), 1024, 2560, NTOK, smem, e, rep_ + 1 < p.reps[2]);
    xcd_barrier(xb.bar, xb.x, xb.st, otid() == 0);
  }
  REP(6) { phase_swa_attn(p, smem, rep_ + 1 < p.reps[6]); xcd_barrier(xb.bar, xb.x, xb.st, otid() == 0); }
  REP(3) {
    unsigned char* ws = opq(p.ws); const bf16_t* act = (const bf16_t*)(ws + O_ACT); float* xc = (float*)(ws + O_XC); float* mod = (float*)(ws + O_MOD); (void)act;
    EpiRes e{p.out, xc, p.out, xc, mod + 2 * 5 * 3072, rep_ + 1 < p.reps[3], (bf16_t*)(ws + O_ACT), p.in[4] + 3 * 1024, mod + 3 * 5 * 3072, (float*)(ws + O_RSSL) + 2 * NTOK};
    gemm_phase256((const bf16_t*)(ws + O_W_SWA_OUT), (const bf16_t*)(ws + O_SG2), 1024, 1024, NLAT, smem, e);
    xcd_barrier(xb.bar, xb.x, xb.st, otid() == 0);
  }
  REP(2) {
    unsigned char* ws = opq(p.ws); const bf16_t* act = (const bf16_t*)(ws + O_ACT); const float2* rope = (const float2*)(ws + O_ROPE); (void)act; (void)rope;
    EpiCfIn e{(bf16_t*)(ws + O_U3), (bf16_t*)(ws + O_SG3), PreNorm{(const float*)(ws + O_RSSL) + 2 * NTOK, (const float*)(ws + O_SW) + 5 * (4096 + 2560), 3072}};
    gemm_phase256((const bf16_t*)(ws + O_W_CF_IN), act, 1024, 3072, NLAT, smem, e, rep_ + 1 < p.reps[2]);
    xcd_barrier(xb.bar, xb.x, xb.st, otid() == 0);
  }
  REP(7) { phase_cfconv(p, smem); xcd_barrier(xb.bar, xb.x, xb.st, otid() == 0); }
  REP(3) {
    unsigned char* ws = opq(p.ws); const bf16_t* act = (const bf16_t*)(ws + O_ACT); float* xc = (float*)(ws + O_XC); float* mod = (float*)(ws + O_MOD); (void)act;
    EpiRes e{p.out, xc, p.out, xc, mod + 3 * 5 * 3072, rep_ + 1 < p.reps[3], nullptr, nullptr, nullptr, nullptr};
    gemm_phase256((const bf16_t*)(ws + O_W_CF_OUT), act, 1024, 1024, NLAT, smem, e);
    xcd_barrier(xb.bar, xb.x, xb.st, otid() == 0);
  }
  phase_final(p);
}

extern "C" void kernel_launch(void* const* d_in, const int* in_sizes, int n_in, void* d_out, int out_size, void* d_ws, size_t ws_size,
                              hipStream_t stream) {
  static int grid = 0;
  if (grid == 0) {
    if (n_in != 33 || ws_size < WS_NEED) {
      fprintf(stderr, "kernel_launch: need 33 inputs and >= %zu bytes of workspace; got n_in %d, ws %zu\n", (size_t)WS_NEED, n_in, ws_size);
      grid = -1;
      return;
    }
    int dev = 0, cus = 0, per_cu = 0;
    hipGetDevice(&dev);
    hipDeviceGetAttribute(&cus, hipDeviceAttributeMultiprocessorCount, dev);
    if (hipFuncSetAttribute((const void*)mega, hipFuncAttributeMaxDynamicSharedMemorySize, DYN_LDS) != hipSuccess) { fprintf(stderr, "hipFuncSetAttribute failed\n"); grid = -1; return; }
    hipOccupancyMaxActiveBlocksPerMultiprocessor(&per_cu, mega, NT, DYN_LDS);
    int g = cus * per_cu;
    if (g > 256) g = 256;
    if (g < 1) g = 256;
    grid = g;
  }
  if (grid < 0) return;
  P p{};
  for (int i = 0; i < 33; ++i) p.in[i] = (const float*)d_in[i];
  p.out = (float*)d_out;
  p.ws = (unsigned char*)d_ws;
  { const int r[8] = {PROBE_REPS}; for (int i = 0; i < 8; ++i) p.reps[i] = r[i]; }
  if (hipMemsetAsync((char*)d_ws + O_BAR, 0, XCD_BAR_BYTES, stream) != hipSuccess) { fprintf(stderr, "memset of barrier words failed\n"); return; }
  void* args[] = {&p};
  hipError_t e = hipLaunchCooperativeKernel((void*)mega, dim3(grid), dim3(NT), args, DYN_LDS, stream);
  if (e != hipSuccess) fprintf(stderr, "cooperative launch failed: %s (grid %d)\n", hipGetErrorString(e), grid);
}
```

```cpp
#include <hip/hip_runtime.h>
#include <hip/hip_cooperative_groups.h>
#include <cstdio>
#include <cstdint>
namespace cg = cooperative_groups;

typedef unsigned short bf16_t;
typedef __attribute__((ext_vector_type(8))) short bf16x8;
typedef __attribute__((ext_vector_type(4))) float f32x4;
typedef __attribute__((ext_vector_type(2))) float f32x2;
typedef __attribute__((ext_vector_type(4))) unsigned u32x4;
typedef __attribute__((ext_vector_type(2))) unsigned u32x2;

#define NT 512
#define DYN_LDS 139264
#ifndef PROBE_REPS
#define PROBE_REPS 1, 1, 1, 1, 1, 1, 1, 1
#endif
#define DI __device__ __forceinline__

constexpr int NLAT = 16384, NCTX = 1024, NTOK = 17408, SEQ = 4096, LCTX = 256, KEYS = 4352;
constexpr float LOG2E = 1.4426950408889634f;
constexpr size_t XCD_BAR_BYTES = 3456 * 4;

constexpr size_t al(size_t x) { return (x + 255) & ~(size_t)255; }
constexpr size_t O_W_MLA_IN = 0;
constexpr size_t O_W_UQ = O_W_MLA_IN + al((size_t)1792 * 1024 * 2);
constexpr size_t O_W_UKV = O_W_UQ + al((size_t)1536 * 384 * 2);
constexpr size_t O_W_MLA_OUT = O_W_UKV + al((size_t)2048 * 256 * 2);
constexpr size_t O_W_HY_IN = O_W_MLA_OUT + al((size_t)1024 * 1024 * 2);
constexpr size_t O_W_HY_OUT = O_W_HY_IN + al((size_t)4096 * 1024 * 2);
constexpr size_t O_W_SWA_IN = O_W_HY_OUT + al((size_t)1024 * 1024 * 2);
constexpr size_t O_W_SWA_OUT = O_W_SWA_IN + al((size_t)2560 * 1024 * 2);
constexpr size_t O_W_CF_IN = O_W_SWA_OUT + al((size_t)1024 * 1024 * 2);
constexpr size_t O_W_CF_OUT = O_W_CF_IN + al((size_t)3072 * 1024 * 2);
constexpr size_t O_MOD = O_W_CF_OUT + al((size_t)1024 * 1024 * 2);
constexpr size_t O_HDN = O_MOD + al((size_t)4 * 5 * 3072 * 4);
constexpr size_t O_HDNC = O_HDN + al((size_t)64 * 4096 * 4);
constexpr size_t O_HDNB = O_HDNC + al((size_t)64 * 256 * 4);
constexpr size_t O_ROPE = O_HDNB + al((size_t)4096 * 64 * 2);
constexpr size_t O_RSS = O_ROPE + al((size_t)4096 * 32 * 8);
constexpr size_t O_RSSL = O_RSS + al((size_t)2 * NTOK * 4);
constexpr size_t O_SW = O_RSSL + al((size_t)3 * NTOK * 4);
constexpr size_t O_XC = O_SW + al((size_t)5 * 9728 * 4);
constexpr size_t O_ACT = O_XC + al((size_t)NCTX * 1024 * 4);
constexpr size_t O_T = O_ACT + al((size_t)NTOK * 1024 * 2);
constexpr size_t O_CQ = O_T;
constexpr size_t O_CKV = O_CQ + al((size_t)NTOK * 384 * 2);
constexpr size_t O_SG0 = O_CKV + al((size_t)NTOK * 256 * 2);
constexpr size_t O_Q = O_SG0 + al((size_t)NTOK * 1024 * 2);
constexpr size_t O_KP = O_Q + al((size_t)NTOK * 1536 * 2);
constexpr size_t O_END0 = O_KP + al((size_t)NTOK * 1536 * 2);
constexpr size_t O_UT = O_T;
constexpr size_t O_FFT = O_UT + al((size_t)4096 * NTOK * 2);
constexpr size_t O_END1 = O_FFT + (size_t)256 * 131072;
constexpr size_t O_QS = O_T;
constexpr size_t O_KS = O_QS + al((size_t)NTOK * 1024 * 2);
constexpr size_t O_VT2 = O_KS + al((size_t)NTOK * 256 * 2);
constexpr size_t O_SG2 = O_VT2 + al((size_t)16 * 64 * KEYS * 2);
constexpr size_t O_U3 = O_T;
constexpr size_t O_SG3 = O_U3 + al((size_t)NLAT * 1024 * 2);
constexpr size_t O_BAR = (O_END0 > O_END1 ? O_END0 : O_END1);
constexpr size_t O_XG2 = O_T + (size_t)96 * 1024 * 1024;
constexpr size_t WS_NEED = O_BAR + XCD_BAR_BYTES;

struct P {
  const float* in[33];
  float* out;
  unsigned char* ws;
  int reps[8];
};

DI int otid() { int t = threadIdx.x; asm volatile("" : "+v"(t)); return t; }
template <class T> DI T* opq(T* p) { asm volatile("" : "+s"(p)); return p; }
DI bf16_t f2bf(float x) { unsigned r; asm("v_cvt_pk_bf16_f32 %0, %1, %1" : "=v"(r) : "v"(x)); return (bf16_t)r; }
DI float bf2f(bf16_t v) { return __uint_as_float(((unsigned)v) << 16); }
DI unsigned pack2(float a, float b) { unsigned r; asm("v_cvt_pk_bf16_f32 %0, %1, %2" : "=v"(r) : "v"(a), "v"(b)); return r; }
DI float siluf(float x) { return x * __builtin_amdgcn_rcpf(1.f + __expf(-x)); }
DI float sigmf(float x) { return __builtin_amdgcn_rcpf(1.f + __expf(-x)); }
DI float rowpair_sum(float x) { const auto r = __builtin_amdgcn_permlane16_swap(__float_as_uint(x), __float_as_uint(x), false, false); return __uint_as_float(r[0]) + __uint_as_float(r[1]); }
DI float half_sum(float x) { const auto r = __builtin_amdgcn_permlane32_swap(__float_as_uint(x), __float_as_uint(x), false, false); return __uint_as_float(r[0]) + __uint_as_float(r[1]); }
DI float rowpair_max(float x) { const auto r = __builtin_amdgcn_permlane16_swap(__float_as_uint(x), __float_as_uint(x), false, false); return fmaxf(__uint_as_float(r[0]), __uint_as_float(r[1])); }
DI float half_max(float x) { const auto r = __builtin_amdgcn_permlane32_swap(__float_as_uint(x), __float_as_uint(x), false, false); return fmaxf(__uint_as_float(r[0]), __uint_as_float(r[1])); }
DI float wave_sum(float v) {
#pragma unroll
  for (int o = 32; o >= 1; o >>= 1) v += __shfl_xor(v, o, 64);
  return v;
}
DI void store4bf(bf16_t* p, float a, float b, float c, float d) {
  uint2 v; v.x = pack2(a, b); v.y = pack2(c, d);
  *(uint2*)p = v;
}
struct PairW {
  unsigned ax, ay;
  DI void put(int fi, bf16_t* row64, int lq, float a, float b, float c, float d) {
    const unsigned px = pack2(a, b), py = pack2(c, d);
    if ((fi & 1) == 0) { ax = px; ay = py; }
    else {
      const auto rx = __builtin_amdgcn_permlane16_swap(ax, px, false, false);
      const auto ry = __builtin_amdgcn_permlane16_swap(ay, py, false, false);
      u32x4 v; v.x = rx[0]; v.y = ry[0]; v.z = rx[1]; v.w = ry[1];
      const int col = (lq & 1) ? fi * 16 + 4 * (lq - 1) : (fi - 1) * 16 + 4 * lq;
      *(u32x4*)(row64 + col) = v;
    }
  }
};
template <bool PERM>
DI void tstore2(bf16_t* row32, int lr, float v0, float v1) {
  const float snd = (lr & 1) ? v0 : v1;
  const float rcv = __int_as_float(__builtin_amdgcn_mov_dpp(__float_as_int(snd), 0xB1, 0xF, 0xF, true));
  const unsigned w = (lr & 1) ? pack2(rcv, v1) : pack2(v0, rcv);
  const int pos = PERM ? ((lr >> 2) * 8 + ((lr & 1) ? 4 : 0) + (lr & 2)) : ((lr & 1) ? 16 + lr - 1 : lr);
  *(unsigned*)(row32 + pos) = w;
}
DI f32x4 mfma16(bf16x8 a, bf16x8 b, f32x4 c) { return __builtin_amdgcn_mfma_f32_16x16x32_bf16(a, b, c, 0, 0, 0); }

DI int tok_modrow(int tok) { return tok < NLAT ? (tok >> 12) : 4; }
DI int tok_batch(int tok) { return tok < NLAT ? (tok >> 12) : ((tok - NLAT) >> 8); }
DI int tok_key(int tok) { return tok < NLAT ? (tok & 4095) : (SEQ + ((tok - NLAT) & 255)); }
DI int key_perm(int key) { const int x = key & 31; return (key & ~31) | (((x >> 2) & 3) * 8 + (x >> 4) * 4 + (x & 3)); }

constexpr int GLD = 72;
template <class Epi>
DI void gemm_tile(const bf16_t* __restrict__ W, const bf16_t* __restrict__ X, int K, int f0, int t0, char* smem, const Epi& epi) {
  bf16_t* sW = (bf16_t*)smem;
  bf16_t* sX = sW + 128 * GLD;
  const int tid = otid(), lane = tid & 63, wave = tid >> 6;
  const int wf = wave >> 2, wt = wave & 3;
  const int lr = lane & 15, lq = lane >> 4;
  f32x4 acc[4][4];
#pragma unroll
  for (int i = 0; i < 4; ++i)
#pragma unroll
    for (int j = 0; j < 4; ++j) acc[i][j] = (f32x4){0.f, 0.f, 0.f, 0.f};
  u32x4 rwA[2], rxA[4], rwB[2], rxB[4];
  const int crow = tid >> 3, ccol = (tid & 7) * 8;
  const bf16_t* Wp = W + (size_t)(f0 + crow) * K + ccol;
  const bf16_t* Xp = X + (size_t)(t0 + crow) * K + ccol;
#define G_LOAD(RW, RX, KOFF)                                                            \
  {                                                                                     \
    _Pragma("unroll") for (int i = 0; i < 2; ++i) RW[i] = *(const u32x4*)(Wp + (size_t)(64 * i) * K + (KOFF)); \
    _Pragma("unroll") for (int i = 0; i < 4; ++i) RX[i] = *(const u32x4*)(Xp + (size_t)(64 * i) * K + (KOFF)); \
  }
#define G_STORE(RW, RX)                                                                 \
  {                                                                                     \
    _Pragma("unroll") for (int i = 0; i < 2; ++i) *(u32x4*)(sW + (crow + 64 * i) * GLD + ccol) = RW[i]; \
    _Pragma("unroll") for (int i = 0; i < 4; ++i) *(u32x4*)(sX + (crow + 64 * i) * GLD + ccol) = RX[i]; \
  }
#define G_COMPUTE()                                                                     \
  {                                                                                     \
    _Pragma("unroll") for (int ks = 0; ks < 2; ++ks) {                                  \
      bf16x8 a[4], b[4];                                                                \
      _Pragma("unroll") for (int i = 0; i < 4; ++i) a[i] = *(const bf16x8*)(sW + (wf * 64 + i * 16 + lr) * GLD + ks * 32 + lq * 8); \
      _Pragma("unroll") for (int i = 0; i < 4; ++i) b[i] = *(const bf16x8*)(sX + (wt * 64 + i * 16 + lr) * GLD + ks * 32 + lq * 8); \
      _Pragma("unroll") for (int i = 0; i < 4; ++i)                                     \
        _Pragma("unroll") for (int j = 0; j < 4; ++j) acc[i][j] = mfma16(a[i], b[j], acc[i][j]); \
    }                                                                                   \
  }
  G_LOAD(rwA, rxA, 0);
  G_LOAD(rwB, rxB, 64);
  for (int k0 = 0; k0 < K; k0 += 128) {
    __syncthreads();
    G_STORE(rwA, rxA);
    __syncthreads();
    { const int kn = k0 + 128 < K ? k0 + 128 : K - 128; G_LOAD(rwA, rxA, kn); }
    G_COMPUTE();
    __syncthreads();
    G_STORE(rwB, rxB);
    __syncthreads();
    { const int kn = k0 + 192 < K ? k0 + 192 : K - 64; G_LOAD(rwB, rxB, kn); }
    G_COMPUTE();
  }
#undef G_LOAD
#undef G_STORE
#undef G_COMPUTE
  epi(f0 + wf * 64, t0 + wt * 64, acc);
}

struct TileWalk {
  int nft, start, ntl, u, nlb;
  DI TileWalk(int nft_, int ntt) {
    const int x = blockIdx.x & 7;
    nft = nft_;
    start = (x * ntt) >> 3;
    ntl = (((x + 1) * ntt) >> 3) - start;
    u = blockIdx.x >> 3;
    nlb = (gridDim.x - x + 7) >> 3;
  }
  DI bool next(int& ft, int& tt) {
    if (u >= ntl * nft) return false;
    const int grp = u / (4 * nft), rem = u - grp * 4 * nft;
    const int left = ntl - grp * 4, gsz = left < 4 ? left : 4;
    ft = rem / gsz;
    tt = start + grp * 4 + rem % gsz;
    u += nlb;
    return true;
  }
};

template <class Epi>
DI void gemm_phase(const bf16_t* W, const bf16_t* X, int K, int NF, int NTK, char* smem, const Epi& epi) {
  TileWalk tw(NF / 128, NTK / 256);
  int ft, tt;
  while (tw.next(ft, tt)) gemm_tile(W, X, K, ft * 128, tt * 256, smem, epi);
}


constexpr int G_BK = 64, G_HALF = 128, G_HT = G_HALF * G_BK;
DI int g_lds_byte(int r, int c) {
  int st = (r >> 4) * 2 + (c >> 5), rr = r & 15, cc = c & 31, ob = rr * 64 + cc * 2;
  return st * 1024 + (ob ^ (((ob >> 9) & 1) << 5));
}
DI void g_stage_rc(int b, int& R, int& C) {
  int st = b / 1024, sb = b % 1024, swz = sb ^ (((sb >> 9) & 1) << 5);
  R = (st >> 1) * 16 + swz / 64; C = (st & 1) * 32 + (swz % 64) / 2;
}
template <class Epi>
DI void gemm_tile256(const bf16_t* __restrict__ W, const bf16_t* __restrict__ X, int K, int f0, int t0, char* smem, const Epi& epi, bool dry = false) {
  const int tidx = otid();
  const int wid = tidx >> 6, lane = tidx & 63, wr = wid >> 2, wc = wid & 3, fr = lane & 15, fq = lane >> 4;
  f32x4 acc[8][4];
#pragma unroll
  for (int i = 0; i < 8; ++i)
#pragma unroll
    for (int j = 0; j < 4; ++j) acc[i][j] = (f32x4){0.f, 0.f, 0.f, 0.f};
  int r0, c0, r1, c1;
  g_stage_rc(tidx * 16, r0, c0);
  g_stage_rc(tidx * 16 + 8192, r1, c1);
  const bf16_t* Wg0 = W + (size_t)(f0 + r0) * K + c0;
  const bf16_t* Wg1 = W + (size_t)(f0 + r1) * K + c1;
  const bf16_t* Xg0 = X + (size_t)(t0 + r0) * K + c0;
  const bf16_t* Xg1 = X + (size_t)(t0 + r1) * K + c1;
  const size_t hk = (size_t)128 * K;
#define GLL(src, dst) __builtin_amdgcn_global_load_lds((const unsigned*)(src), (__attribute__((address_space(3))) unsigned*)(dst), 16, 0, 0)
#define STAGE_ALL(buf, kt)                                                     \
  {                                                                            \
    char* sb_ = smem + (buf) * 65536 + tidx * 16;                              \
    const size_t ko_ = (size_t)(kt) * 64;                                      \
    GLL(Wg0 + ko_, sb_);               GLL(Wg1 + ko_, sb_ + 8192);             \
    GLL(Wg0 + hk + ko_, sb_ + 16384);  GLL(Wg1 + hk + ko_, sb_ + 24576);       \
    GLL(Xg0 + ko_, sb_ + 32768);       GLL(Xg1 + ko_, sb_ + 40960);            \
    GLL(Xg0 + hk + ko_, sb_ + 49152);  GLL(Xg1 + hk + ko_, sb_ + 57344);       \
  }
  const int ob = fr * 64 + fq * 16;
  const int lane_off = ob ^ (((ob >> 9) & 1) << 5);
  const char* aBase = smem + wr * 16384 + lane_off;
  const char* bBase = smem + 32768 + (wc >> 1) * 16384 + (wc & 1) * 8192 + lane_off;
  const int nt = K / 64;
  STAGE_ALL(0, 0);
  for (int kt = 0; kt < nt; ++kt) {
    asm volatile("s_waitcnt vmcnt(0)" ::: "memory");
    __builtin_amdgcn_s_barrier();
    if (kt + 1 < nt) STAGE_ALL((kt + 1) & 1, kt + 1);
    const char* ab = aBase + (kt & 1) * 65536;
    const char* bb = bBase + (kt & 1) * 65536;
#pragma unroll
    for (int ks = 0; ks < 2; ++ks) {
      bf16x8 a[8], b[4];
#pragma unroll
      for (int m = 0; m < 8; ++m) a[m] = *(const bf16x8*)(ab + (m * 2 + ks) * 1024);
#pragma unroll
      for (int n = 0; n < 4; ++n) b[n] = *(const bf16x8*)(bb + (n * 2 + ks) * 1024);
#pragma unroll
      for (int m = 0; m < 8; ++m)
#pragma unroll
        for (int n = 0; n < 4; ++n) acc[m][n] = mfma16(a[m], b[n], acc[m][n]);
    }
  }
#undef GLL
#undef STAGE_ALL
  if (!dry) {
    f32x4 (&lo)[4][4] = *reinterpret_cast<f32x4 (*)[4][4]>(&acc[0]);
    f32x4 (&hi)[4][4] = *reinterpret_cast<f32x4 (*)[4][4]>(&acc[4]);
    epi(f0 + wr * 128, t0 + wc * 64, lo);
    epi(f0 + wr * 128 + 64, t0 + wc * 64, hi);
  }
}


template <class Epi>
DI void gemm_tile8p(const bf16_t* __restrict__ A, const bf16_t* __restrict__ Bt, int K, int brow, int bcol, char* smem, const Epi& epi, bool dry = false) {
  bf16_t* shm = (bf16_t*)smem;
  #define SA(b,h) (shm+((b)*2+(h))*G_HT)
  #define SB(b,h) (shm+(4+(b)*2+(h))*G_HT)
  #define STAGE(P,BASE,br,kt) do{long _g=(long)(br)*K+(long)(kt)*G_BK; \
    for(int _i=0;_i<2;++_i){int _b=tidx*16+_i*8192;int _r,_c;g_stage_rc(_b,_r,_c); \
      __builtin_amdgcn_global_load_lds((const unsigned*)(BASE+_g+(long)_r*K+_c), \
        (__attribute__((address_space(3))) unsigned*)((char*)(P)+_b),16,0,0);}}while(0)
  #define LDA(dst,b,h) for(int m=0;m<4;++m)for(int k=0;k<2;++k) \
    dst[m][k]=*reinterpret_cast<const bf16x8*>((char*)SA(b,h)+g_lds_byte(wr*64+m*16+fr,k*32+fq*8))
  #define LDB(dst,b,h) for(int n=0;n<2;++n)for(int k=0;k<2;++k) \
    dst[n][k]=*reinterpret_cast<const bf16x8*>((char*)SB(b,h)+g_lds_byte(wc*32+n*16+fr,k*32+fq*8))
  #define MMA(ai,bj,At,Bt_) do{__builtin_amdgcn_s_setprio(1); \
    for(int m=0;m<4;++m)for(int n=0;n<2;++n)for(int k=0;k<2;++k) \
      acc[ai][bj][m][n]=__builtin_amdgcn_mfma_f32_16x16x32_bf16(At[m][k],Bt_[n][k],acc[ai][bj][m][n],0,0,0); \
    __builtin_amdgcn_s_setprio(0);}while(0)
  #define WAIT_V(n) asm volatile("s_waitcnt vmcnt(" #n ")":::"memory")
  #define WAIT_L(n) asm volatile("s_waitcnt lgkmcnt(" #n ")":::"memory")
  #define BAR __builtin_amdgcn_s_barrier()
  #define SCHED __builtin_amdgcn_sched_barrier(0)
  const int tidx = otid();
  const int wid=tidx>>6,lane=tidx&63,wr=wid>>2,wc=wid&3,fr=lane&15,fq=lane>>4;
  f32x4 acc[2][2][4][2]={};
  bf16x8 At[4][2],B0[2][2],B1[2][2];
  const int nt=K/G_BK;
  asm volatile("s_waitcnt vmcnt(0) lgkmcnt(0)" ::: "memory");
  __syncthreads();
  STAGE(SB(0,0),Bt,bcol,0); STAGE(SA(0,0),A,brow,0);
  STAGE(SB(0,1),Bt,bcol+G_HALF,0); STAGE(SA(0,1),A,brow+G_HALF,0);
  if(wr==1)BAR;
  WAIT_V(4); BAR;
  STAGE(SB(1,0),Bt,bcol,1); STAGE(SA(1,0),A,brow,1); STAGE(SB(1,1),Bt,bcol+G_HALF,1);
  WAIT_V(6); BAR;
  for(int t=0;t<nt-2;t+=2){
    LDB(B0,0,0); SCHED; LDA(At,0,0); STAGE(SA(1,1),A,brow+G_HALF,t+1);
    WAIT_L(8); BAR; WAIT_L(0); MMA(0,0,At,B0); BAR; SCHED;
    LDB(B1,0,1); STAGE(SB(0,0),Bt,bcol,t+2);
    BAR; WAIT_L(0); MMA(0,1,At,B1); BAR;
    LDA(At,0,1); STAGE(SA(0,0),A,brow,t+2);
    BAR; WAIT_L(0); MMA(1,0,At,B0); BAR; SCHED;
    STAGE(SB(0,1),Bt,bcol+G_HALF,t+2);
    WAIT_V(6); BAR; MMA(1,1,At,B1); BAR;
    LDB(B0,1,0); SCHED; LDA(At,1,0); STAGE(SA(0,1),A,brow+G_HALF,t+2);
    WAIT_L(8); BAR; WAIT_L(0); MMA(0,0,At,B0); BAR; SCHED;
    LDB(B1,1,1); STAGE(SB(1,0),Bt,bcol,t+3);
    BAR; WAIT_L(0); MMA(0,1,At,B1); BAR;
    LDA(At,1,1); STAGE(SA(1,0),A,brow,t+3);
    BAR; WAIT_L(0); MMA(1,0,At,B0); BAR; SCHED;
    STAGE(SB(1,1),Bt,bcol+G_HALF,t+3);
    WAIT_V(6); BAR; MMA(1,1,At,B1); BAR;
  }
  { LDB(B0,0,0); LDA(At,0,0); STAGE(SA(1,1),A,brow+G_HALF,nt-1);
    BAR; WAIT_L(0); MMA(0,0,At,B0); BAR;
    LDB(B1,0,1); BAR; WAIT_L(0); MMA(0,1,At,B1); BAR;
    LDA(At,0,1); WAIT_V(4); BAR; WAIT_L(0); MMA(1,0,At,B0); MMA(1,1,At,B1); BAR; }
  { LDB(B0,1,0); LDA(At,1,0); WAIT_V(2); BAR; WAIT_L(0); MMA(0,0,At,B0); BAR;
    LDB(B1,1,1); WAIT_V(0); BAR; WAIT_L(0); MMA(0,1,At,B1); BAR;
    LDA(At,1,1); BAR; WAIT_L(0); MMA(1,0,At,B0); MMA(1,1,At,B1); BAR; }
  if(wr==0)BAR;
  if (!dry) {
#pragma unroll
    for(int ai=0;ai<2;++ai)
#pragma unroll
      for(int bj=0;bj<2;++bj) epi(brow+ai*G_HALF+wr*64, bcol+bj*G_HALF+wc*32, acc[ai][bj]);
  }
  #undef SA
  #undef SB
  #undef STAGE
  #undef LDA
  #undef LDB
  #undef MMA
  #undef WAIT_V
  #undef WAIT_L
  #undef BAR
  #undef SCHED
}

template <class Epi>
DI void gemm_phase256(const bf16_t* W, const bf16_t* X, int K, int NF, int NTK, char* smem, const Epi& epi, bool dry = false) {
  TileWalk tw(NF / 256, NTK / 256);
  int ft, tt;
  while (tw.next(ft, tt)) gemm_tile8p(W, X, K, ft * 256, tt * 256, smem, epi, dry);
}

struct EpiMlaIn {
  bf16_t *cq, *ckv, *kp, *sg; const float2* rope; float* rss;
  template <int NTI> DI void operator()(int f0, int t0, f32x4 (&acc)[4][NTI]) const {
    const int lane = otid() & 63, lr = lane & 15, lq = lane >> 4;
    if (f0 >= 1728) return;
    if (f0 == 640) {
#pragma unroll
      for (int ti = 0; ti < NTI; ++ti) {
        const int tok = t0 + ti * 16 + lr;
        const bool lat = tok < NLAT;
        const int pos = tok & 4095;
#pragma unroll
        for (int fi = 0; fi < 2; ++fi) {
          float o1[4], o2[4];
#pragma unroll
          for (int j = 0; j < 4; ++j) {
            const int d = fi * 16 + 4 * lq + j;
            float x1 = acc[fi][ti][j], x2 = acc[fi + 2][ti][j];
            if (lat) { float2 cs = rope[pos * 32 + d]; o1[j] = x1 * cs.x - x2 * cs.y; o2[j] = x1 * cs.y + x2 * cs.x; }
            else { o1[j] = x1; o2[j] = x2; }
          }
          const int d0 = fi * 16 + 4 * lq;
#pragma unroll
          for (int h = 0; h < 8; ++h) {
            bf16_t* base = kp + ((size_t)tok * 8 + h) * 192 + 128;
            store4bf(base + d0, o1[0], o1[1], o1[2], o1[3]);
            store4bf(base + 32 + d0, o2[0], o2[1], o2[2], o2[3]);
          }
        }
      }
      return;
    }
    if (f0 < 640) {
#pragma unroll
      for (int ti = 0; ti < NTI; ++ti) {
        const int tok = t0 + ti * 16 + lr;
        float ss = 0.f;
        PairW pw;
        bf16_t* row64 = f0 < 384 ? cq + (size_t)tok * 384 + f0 : ckv + (size_t)tok * 256 + (f0 - 384);
#pragma unroll
        for (int fi = 0; fi < 4; ++fi) {
          f32x4 v = acc[fi][ti];
          ss += v[0] * v[0] + v[1] * v[1] + v[2] * v[2] + v[3] * v[3];
          pw.put(fi, row64, lq, v[0], v[1], v[2], v[3]);
        }
        ss = half_sum(rowpair_sum(ss));
        if (lq == 0) atomicAdd(rss + (f0 < 384 ? 0 : NTOK) + tok, ss);
      }
      return;
    }
#pragma unroll
    for (int ti = 0; ti < NTI; ++ti) {
      const int tok = t0 + ti * 16 + lr;
      PairW pw;
      bf16_t* row64 = sg + (size_t)tok * 1024 + (f0 - 704);
#pragma unroll
      for (int fi = 0; fi < 4; ++fi) {
        f32x4 v = acc[fi][ti];
        pw.put(fi, row64, lq, siluf(v[0]), siluf(v[1]), siluf(v[2]), siluf(v[3]));
      }
    }
  }
};

struct EpiUq {
  bf16_t* q; const float2* rope; const float* rss;
  template <int NTI> DI void operator()(int f0, int t0, f32x4 (&acc)[4][NTI]) const {
    const int lane = otid() & 63, lr = lane & 15, lq = lane >> 4;
    const bool isrope = (f0 % 192) == 128;
#pragma unroll
    for (int ti = 0; ti < NTI; ++ti) {
      const int tok = t0 + ti * 16 + lr;
      const int pos = tok & 4095;
      const float sc = 0.07216878364870322f * LOG2E * rsqrtf(rss[tok] * (1.f / 384.f) + 1e-6f);
      bf16_t* row64 = q + (size_t)tok * 1536 + f0;
      if (isrope && tok < NLAT) {
        PairW p1, p2;
#pragma unroll
        for (int fi = 0; fi < 2; ++fi) {
          float o1[4], o2[4];
#pragma unroll
          for (int j = 0; j < 4; ++j) {
            const int d = fi * 16 + 4 * lq + j;
            float2 cs = rope[pos * 32 + d];
            float x1 = acc[fi][ti][j], x2 = acc[fi + 2][ti][j];
            o1[j] = (x1 * cs.x - x2 * cs.y) * sc; o2[j] = (x1 * cs.y + x2 * cs.x) * sc;
          }
          p1.put(fi, row64, lq, o1[0], o1[1], o1[2], o1[3]);
          p2.put(fi, row64 + 32, lq, o2[0], o2[1], o2[2], o2[3]);
        }
      } else {
        PairW pw;
#pragma unroll
        for (int fi = 0; fi < 4; ++fi) {
          f32x4 v = acc[fi][ti];
          pw.put(fi, row64, lq, v[0] * sc, v[1] * sc, v[2] * sc, v[3] * sc);
        }
      }
    }
  }
};

struct EpiUkv {
  bf16_t *kp, *vt; const float* rss;
  template <int NTI> DI void operator()(int f0, int t0, f32x4 (&acc)[4][NTI]) const {
    const int lane = otid() & 63, lr = lane & 15, lq = lane >> 4;
    const int h = f0 >> 8, r = f0 & 255;
#pragma unroll
    for (int ti = 0; ti < NTI; ++ti) {
      const int tok = t0 + ti * 16 + lr;
      const float rs = rsqrtf(rss[NTOK + tok] * (1.f / 256.f) + 1e-6f);
      if (r < 128) {
        PairW pw;
        bf16_t* row64 = kp + ((size_t)tok * 8 + h) * 192 + r;
#pragma unroll
        for (int fi = 0; fi < 4; ++fi) {
          f32x4 v = acc[fi][ti] * rs;
          pw.put(fi, row64, lq, v[0], v[1], v[2], v[3]);
        }
      }
    }
    if (r >= 128) {
      static_assert(NTI == 2, "transposed pair store expects the 32-token sub-tile of the 8-phase GEMM body");
      const int b = tok_batch(t0), key0 = tok_key(t0);
      const float rs0 = rsqrtf(rss[NTOK + t0 + lr] * (1.f / 256.f) + 1e-6f), rs1 = rsqrtf(rss[NTOK + t0 + 16 + lr] * (1.f / 256.f) + 1e-6f);
#pragma unroll
      for (int fi = 0; fi < 4; ++fi)
#pragma unroll
        for (int j = 0; j < 4; ++j) {
          const int dv = r - 128 + fi * 16 + 4 * lq + j;
          tstore2<true>(vt + ((size_t)(b * 8 + h) * 128 + dv) * KEYS + key0, lr, acc[fi][0][j] * rs0, acc[fi][1][j] * rs1);
        }
    }
  }
};

struct EpiRes {
  const float *sl, *sc; float *xl, *xc; const float* mod; bool dry;
  bf16_t* xg; const float* gn; const float* modn; float* rssn;
  template <int NTI> DI void operator()(int f0, int t0, f32x4 (&acc)[4][NTI]) const {
    if (dry) return;
    const int lane = otid() & 63, lr = lane & 15, lq = lane >> 4;
#pragma unroll
    for (int ti = 0; ti < NTI; ++ti) {
      const int tok = t0 + ti * 16 + lr;
      const size_t ro = tok < NLAT ? (size_t)tok * 1024 : (size_t)(tok - NLAT) * 1024;
      const float* xs = (tok < NLAT ? sl : sc) + ro;
      float* xr = (tok < NLAT ? xl : xc) + ro;
      const int mr = tok_modrow(tok);
      const float* g = mod + mr * 3072 + 2048;
      float ss = 0.f;
      PairW pw;
#pragma unroll
      for (int fi = 0; fi < 4; ++fi) {
        const int f = f0 + fi * 16 + 4 * lq;
        float4 xv = *(const float4*)(xs + f);
        float4 gv = *(const float4*)(g + f);
        f32x4 v = acc[fi][ti];
        xv.x += gv.x * v[0]; xv.y += gv.y * v[1]; xv.z += gv.z * v[2]; xv.w += gv.w * v[3];
        *(float4*)(xr + f) = xv;
        if (xg) {
          ss += xv.x * xv.x + xv.y * xv.y + xv.z * xv.z + xv.w * xv.w;
          const float4 gg = *(const float4*)(gn + f), sn = *(const float4*)(modn + mr * 3072 + 1024 + f);
          pw.put(fi, xg + (size_t)tok * 1024 + f0, lq, xv.x * gg.x * (1.f + sn.x), xv.y * gg.y * (1.f + sn.y), xv.z * gg.z * (1.f + sn.z), xv.w * gg.w * (1.f + sn.w));
        }
      }
      if (xg) {
        ss = half_sum(rowpair_sum(ss));
        if (lq == 0) atomicAdd(rssn + tok, ss);
      }
    }
  }
};
struct PreNorm {
  const float* rss; const float* sw; int nf;
  template <int NTI> DI void apply(int f0, int t0, f32x4 (&acc)[4][NTI]) const {
    const int lane = otid() & 63, lr = lane & 15, lq = lane >> 4;
#pragma unroll
    for (int ti = 0; ti < NTI; ++ti) {
      const int tok = t0 + ti * 16 + lr;
      const float rstd = rsqrtf(rss[tok] * (1.f / 1024.f) + 1e-6f);
      const float* sr = sw + (size_t)tok_modrow(tok) * nf + f0 + 4 * lq;
#pragma unroll
      for (int fi = 0; fi < 4; ++fi) {
        const float4 sv = *(const float4*)(sr + fi * 16);
        acc[fi][ti][0] = acc[fi][ti][0] * rstd + sv.x; acc[fi][ti][1] = acc[fi][ti][1] * rstd + sv.y;
        acc[fi][ti][2] = acc[fi][ti][2] * rstd + sv.z; acc[fi][ti][3] = acc[fi][ti][3] * rstd + sv.w;
      }
    }
  }
};

struct EpiHyIn {
  bf16_t* ut;
  PreNorm pn;
  template <int NTI> DI void operator()(int f0, int t0, f32x4 (&acc)[4][NTI]) const {
    pn.apply(f0, t0, acc);
    const int lane = otid() & 63, lr = lane & 15, lq = lane >> 4;
    const bool gate = f0 >= 3072;
    static_assert(NTI == 2, "transposed pair store expects the 32-token sub-tile of the 8-phase GEMM body");
#pragma unroll
    for (int fi = 0; fi < 4; ++fi)
#pragma unroll
      for (int j = 0; j < 4; ++j) {
        const int f = f0 + fi * 16 + 4 * lq + j;
        float v0 = acc[fi][0][j], v1 = acc[fi][1][j];
        if (gate) { v0 = siluf(v0); v1 = siluf(v1); }
        tstore2<false>(ut + (size_t)f * NTOK + t0, lr, v0, v1);
      }
  }
};

struct EpiSwaIn {
  bf16_t *qs, *ks, *vt, *sg; const float2* rope;
  PreNorm pn;
  template <int NTI> DI void operator()(int f0, int t0, f32x4 (&acc)[4][NTI]) const {
    pn.apply(f0, t0, acc);
    const int lane = otid() & 63, lr = lane & 15, lq = lane >> 4;
    const float sc = 0.125f * LOG2E;
#pragma unroll
    for (int ti = 0; ti < NTI; ++ti) {
      const int tok = t0 + ti * 16 + lr;
      const int pos = tok & 4095;
      if (f0 < 1280) {
        const bool isq = f0 < 1024;
        const float s = isq ? sc : 1.f;
        bf16_t* dst = isq ? qs + (size_t)tok * 1024 + f0 : ks + (size_t)tok * 256 + (f0 - 1024);
        PairW p1, p2;
#pragma unroll
        for (int fi = 0; fi < 2; ++fi) {
          float o1[4], o2[4];
#pragma unroll
          for (int j = 0; j < 4; ++j) {
            const int d = fi * 16 + 4 * lq + j;
            float x1 = acc[fi][ti][j], x2 = acc[fi + 2][ti][j];
            if (tok < NLAT) { float2 cs = rope[pos * 32 + d]; o1[j] = (x1 * cs.x - x2 * cs.y) * s; o2[j] = (x1 * cs.y + x2 * cs.x) * s; }
            else { o1[j] = x1 * s; o2[j] = x2 * s; }
          }
          p1.put(fi, dst, lq, o1[0], o1[1], o1[2], o1[3]);
          p2.put(fi, dst + 32, lq, o2[0], o2[1], o2[2], o2[3]);
        }
      } else if (f0 < 1536) {
        if (ti == 0) {
          static_assert(NTI == 2, "transposed pair store expects the 32-token sub-tile of the 8-phase GEMM body");
          const int g = (f0 - 1280) >> 6;
          const int b = tok_batch(t0), key0 = tok_key(t0);
#pragma unroll
          for (int fi = 0; fi < 4; ++fi)
#pragma unroll
            for (int j = 0; j < 4; ++j) {
              const int dv = fi * 16 + 4 * lq + j;
              tstore2<true>(vt + ((size_t)(b * 4 + g) * 64 + dv) * KEYS + key0, lr, acc[fi][0][j], acc[fi][1][j]);
            }
        }
      } else {
        PairW pw;
        bf16_t* row64 = sg + (size_t)tok * 1024 + (f0 - 1536);
#pragma unroll
        for (int fi = 0; fi < 4; ++fi) {
          f32x4 v = acc[fi][ti];
          pw.put(fi, row64, lq, siluf(v[0]), siluf(v[1]), siluf(v[2]), siluf(v[3]));
        }
      }
    }
  }
};

struct EpiCfIn {
  bf16_t *u3, *sg;
  PreNorm pn;
  template <int NTI> DI void operator()(int f0, int t0, f32x4 (&acc)[4][NTI]) const {
    pn.apply(f0, t0, acc);
    const int lane = otid() & 63, lr = lane & 15, lq = lane >> 4;
#pragma unroll
    for (int ti = 0; ti < NTI; ++ti) {
      const int tok = t0 + ti * 16 + lr;
      if (f0 < 2048) {
        const int c0 = (f0 >> 6) * 32;
        PairW pw;
#pragma unroll
        for (int fi = 0; fi < 2; ++fi) {
          f32x4 a = acc[fi][ti], b = acc[fi + 2][ti];
          pw.put(fi, u3 + (size_t)tok * 1024 + c0, lq, a[0] * sigmf(b[0]), a[1] * sigmf(b[1]), a[2] * sigmf(b[2]), a[3] * sigmf(b[3]));
        }
      } else {
        PairW pw;
        bf16_t* row64 = sg + (size_t)tok * 1024 + (f0 - 2048);
#pragma unroll
        for (int fi = 0; fi < 4; ++fi) {
          f32x4 v = acc[fi][ti];
          pw.put(fi, row64, lq, siluf(v[0]), siluf(v[1]), siluf(v[2]), siluf(v[3]));
        }
      }
    }
  }
};

template <int MODE>
DI void transpose_w(const float* __restrict__ src, int K, int N, bf16_t* __restrict__ dst, char* smem, const float* __restrict__ kscale = nullptr) {
  float* tile = (float*)smem;
  const int tid = otid();
  const int nkt = K / 64, nnt = N / 64;
  for (int t = blockIdx.x; t < nkt * nnt; t += gridDim.x) {
    const int k0 = (t % nkt) * 64, n0 = (t / nkt) * 64;
    __syncthreads();
#pragma unroll
    for (int i = 0; i < 8; ++i) {
      const int e = tid + NT * i, kk = e >> 6, nn = e & 63;
      tile[kk * 65 + nn] = src[(size_t)(k0 + kk) * N + n0 + nn] * (kscale ? kscale[k0 + kk] : 1.f);
    }
    __syncthreads();
    const int nn = tid >> 3, kc = tid & 7;
    int n = n0 + nn;
    if (MODE == 1) {
      if (n < 1024) n = (n >> 5) * 64 + (n & 31);
      else if (n < 2048) { const int c = n - 1024; n = (c >> 5) * 64 + 32 + (c & 31); }
    }
    uint4 v;
    v.x = pack2(tile[(kc * 8 + 0) * 65 + nn], tile[(kc * 8 + 1) * 65 + nn]);
    v.y = pack2(tile[(kc * 8 + 2) * 65 + nn], tile[(kc * 8 + 3) * 65 + nn]);
    v.z = pack2(tile[(kc * 8 + 4) * 65 + nn], tile[(kc * 8 + 5) * 65 + nn]);
    v.w = pack2(tile[(kc * 8 + 6) * 65 + nn], tile[(kc * 8 + 7) * 65 + nn]);
    *(uint4*)(dst + (size_t)n * K + k0 + kc * 8) = v;
  }
  __syncthreads();
}

DI void phase0(const P& p, char* smem) {
  const int tid = otid(), lane = tid & 63, wave = tid >> 6;
  unsigned char* ws = p.ws;
  transpose_w<0>(p.in[8], 1024, 1728, (bf16_t*)(ws + O_W_MLA_IN), smem);
  for (size_t i = (size_t)blockIdx.x * NT + tid; i < (size_t)64 * 1024 / 2; i += (size_t)gridDim.x * NT)
    ((unsigned*)(ws + O_W_MLA_IN + (size_t)1728 * 1024 * 2))[i] = 0u;
  transpose_w<0>(p.in[11], 384, 1536, (bf16_t*)(ws + O_W_UQ), smem, p.in[9]);
  transpose_w<0>(p.in[12], 256, 2048, (bf16_t*)(ws + O_W_UKV), smem, p.in[10]);
  for (int i = blockIdx.x * NT + tid; i < 5 * NTOK; i += gridDim.x * NT) ((float*)(ws + O_RSS))[i] = 0.f;
  transpose_w<0>(p.in[13], 1024, 1024, (bf16_t*)(ws + O_W_MLA_OUT), smem);
  transpose_w<0>(p.in[14], 1024, 4096, (bf16_t*)(ws + O_W_HY_IN), smem);
  transpose_w<0>(p.in[23], 1024, 1024, (bf16_t*)(ws + O_W_HY_OUT), smem);
  transpose_w<0>(p.in[24], 1024, 2560, (bf16_t*)(ws + O_W_SWA_IN), smem);
  transpose_w<0>(p.in[26], 1024, 1024, (bf16_t*)(ws + O_W_SWA_OUT), smem);
  transpose_w<1>(p.in[27], 1024, 3072, (bf16_t*)(ws + O_W_CF_IN), smem);
  transpose_w<0>(p.in[32], 1024, 1024, (bf16_t*)(ws + O_W_CF_OUT), smem);
  {
    float* sS = (float*)smem;
    float* red = sS + 5 * 1024;
    __syncthreads();
    for (int i = tid; i < 5 * 1024; i += NT) {
      const int r = i >> 10, k = i & 1023;
      const float v = r < 4 ? p.in[1][r * 1024 + k] : p.in[3][k];
      sS[i] = siluf(v);
    }
    __syncthreads();
    float* mod = (float*)(ws + O_MOD);
    for (int it = blockIdx.x; it < 4 * 48; it += gridDim.x) {
      const int layer = it / 48, col = (it % 48) * 64 + lane;
      const float* w = p.in[5] + ((size_t)layer * 1024 + wave * 128) * 3072 + col;
      float a0 = 0, a1 = 0, a2 = 0, a3 = 0, a4 = 0;
#pragma unroll 8
      for (int k = 0; k < 128; ++k) {
        const float wv = w[(size_t)k * 3072];
        const int kk = wave * 128 + k;
        a0 += sS[kk] * wv; a1 += sS[1024 + kk] * wv; a2 += sS[2048 + kk] * wv; a3 += sS[3072 + kk] * wv; a4 += sS[4096 + kk] * wv;
      }
      red[(wave * 5 + 0) * 64 + lane] = a0; red[(wave * 5 + 1) * 64 + lane] = a1; red[(wave * 5 + 2) * 64 + lane] = a2;
      red[(wave * 5 + 3) * 64 + lane] = a3; red[(wave * 5 + 4) * 64 + lane] = a4;
      __syncthreads();
      if (tid < 320) {
        const int r = tid >> 6, c = tid & 63;
        float s = 0;
#pragma unroll
        for (int w8 = 0; w8 < 8; ++w8) s += red[(w8 * 5 + r) * 64 + c];
        const int cc = (it % 48) * 64 + c;
        mod[(layer * 5 + r) * 3072 + cc] = s + p.in[6][layer * 3072 + cc];
      }
      __syncthreads();
    }
  }
  {
    float2* rope = (float2*)(ws + O_ROPE);
    for (int i = blockIdx.x * NT + tid; i < 4096 * 32; i += gridDim.x * NT) {
      const int pos = i >> 5, d = i & 31;
      const float inv = exp2f(-(float)(d & 15) * (13.287712379549449f / 16.f));
      const float ang = (float)(d < 16 ? (pos >> 6) : (pos & 63)) * inv;
      float s, c; sincosf(ang, &s, &c);
      rope[i] = make_float2(c, s);
    }
  }
  {
    float* swin = (float*)smem;
    float* swh = swin + 33 * 64;
    float* shall = swh + 2 * 64 * 64;
    float* sh = shall + wave * 64;
    const float* fb = p.in[19];
    const float* ff = p.in[20];
    __syncthreads();
    for (int i = tid; i < 33 * 64; i += NT) swin[i] = p.in[17][i];
    for (int i = tid; i < 2 * 64 * 64; i += NT) swh[i] = p.in[18][i];
    __syncthreads();
    const float f0 = ff[lane], f1 = ff[64 + lane], f2 = ff[128 + lane], b0 = fb[lane], b1 = fb[64 + lane], b2 = fb[128 + lane];
    for (int item = blockIdx.x * 8 + wave; item < SEQ + LCTX; item += gridDim.x * 8) {
      const bool isc = item >= SEQ;
      const int t = isc ? item - SEQ : item;
      const int Lf = isc ? LCTX : SEQ;
      const float tl = (float)t / (float)(Lf - 1);
      const float wpos = (6.283185307179586f / (float)Lf) * (float)t;
      float e = 0.f;
      if (lane == 0) e = tl;
      else if (lane < 33) {
        const int kb = (lane - 1) & 15;
        const float band = 1e-4f + (float)kb * ((15.f - 1e-4f) / 15.f);
        const float a = band * wpos;
        e = lane < 17 ? cosf(a) : -sinf(a);
      }
      sh[lane] = e;
      __builtin_amdgcn_wave_barrier();
      float acc = 0.f;
#pragma unroll 11
      for (int i = 0; i < 33; ++i) acc += sh[i] * swin[i * 64 + lane];
      float hv = sinf(f0 * (acc + b0));
      __builtin_amdgcn_wave_barrier();
      sh[lane] = hv;
      __builtin_amdgcn_wave_barrier();
      acc = 0.f;
#pragma unroll 16
      for (int i = 0; i < 64; ++i) acc += sh[i] * swh[i * 64 + lane];
      hv = sinf(f1 * (acc + b1));
      __builtin_amdgcn_wave_barrier();
      sh[lane] = hv;
      __builtin_amdgcn_wave_barrier();
      acc = 0.f;
#pragma unroll 16
      for (int i = 0; i < 64; ++i) acc += sh[i] * swh[4096 + i * 64 + lane];
      hv = sinf(f2 * (acc + b2));
      __builtin_amdgcn_wave_barrier();
      if (isc) ((float*)(ws + O_HDNC))[lane * LCTX + t] = hv;
      else { ((float*)(ws + O_HDN))[lane * SEQ + t] = hv; ((bf16_t*)(ws + O_HDNB))[t * 64 + lane] = f2bf(hv); }
    }
    __syncthreads();
  }
}

DI void phase_shiftw(const P& p, char* smem) {
  const int tid = otid(), lane = tid & 63, wave = tid >> 6;
  float* sS = (float*)smem;
  float* red = sS + 5 * 1024;
  const float* mod = (const float*)(p.ws + O_MOD);
  float* sw = (float*)(p.ws + O_SW);
  int cur = -1;
  for (int it = blockIdx.x; it < 64 + 40 + 48; it += gridDim.x) {
    const int L = it < 64 ? 1 : (it < 104 ? 2 : 3);
    const int chunk = it < 64 ? it : (it < 104 ? it - 64 : it - 104);
    const int N = L == 1 ? 4096 : (L == 2 ? 2560 : 3072);
    const float* W = L == 1 ? p.in[14] : (L == 2 ? p.in[24] : p.in[27]);
    float* out = sw + (L == 1 ? 0 : (L == 2 ? 5 * 4096 : 5 * (4096 + 2560)));
    __syncthreads();
    if (cur != L) {
      for (int i = tid; i < 5 * 1024; i += NT) sS[i] = mod[(L * 5 + (i >> 10)) * 3072 + (i & 1023)];
      cur = L;
    }
    __syncthreads();
    const int col = chunk * 64 + lane;
    const float* w = W + (size_t)(wave * 128) * N + col;
    float a0 = 0, a1 = 0, a2 = 0, a3 = 0, a4 = 0;
#pragma unroll 8
    for (int k = 0; k < 128; ++k) {
      const float wv = w[(size_t)k * N];
      const int kk = wave * 128 + k;
      a0 += sS[kk] * wv; a1 += sS[1024 + kk] * wv; a2 += sS[2048 + kk] * wv; a3 += sS[3072 + kk] * wv; a4 += sS[4096 + kk] * wv;
    }
    red[(wave * 5 + 0) * 64 + lane] = a0; red[(wave * 5 + 1) * 64 + lane] = a1; red[(wave * 5 + 2) * 64 + lane] = a2;
    red[(wave * 5 + 3) * 64 + lane] = a3; red[(wave * 5 + 4) * 64 + lane] = a4;
    __syncthreads();
    if (tid < 320) {
      const int r = tid >> 6, c = tid & 63;
      float sum = 0;
#pragma unroll
      for (int w8 = 0; w8 < 8; ++w8) sum += red[(w8 * 5 + r) * 64 + c];
      int n = chunk * 64 + c;
      if (L == 3) {
        if (n < 1024) n = (n >> 5) * 64 + (n & 31);
        else if (n < 2048) { const int cc = n - 1024; n = (cc >> 5) * 64 + 32 + (cc & 31); }
      }
      out[r * N + n] = sum;
    }
  }
  __syncthreads();
}

DI void phase_norm(const P& p, int layer, int ntok) {
  const int lane = otid() & 63, wave = otid() >> 6;
  const float* xc = layer == 0 ? p.in[2] : (const float*)(p.ws + O_XC);
  const float* xlat = layer == 0 ? p.in[0] : p.out;
  const float* mod = (const float*)(p.ws + O_MOD) + layer * 5 * 3072;
  const float* g = p.in[4] + layer * 1024;
  bf16_t* act = (bf16_t*)(p.ws + O_ACT);
  for (int row0 = (blockIdx.x * 8 + wave) * 4; row0 < ntok; row0 += gridDim.x * 32) {
    f32x4 v[4][4];
#pragma unroll
    for (int r = 0; r < 4; ++r) {
      const int row = row0 + r;
      const float* x = row < NLAT ? xlat + (size_t)row * 1024 : xc + (size_t)(row - NLAT) * 1024;
#pragma unroll
      for (int i = 0; i < 4; ++i) v[r][i] = ((const f32x4*)x)[lane + 64 * i];
    }
    const float* m = mod + tok_modrow(row0) * 3072;
#pragma unroll
    for (int r = 0; r < 4; ++r) {
      float ss = 0.f;
#pragma unroll
      for (int i = 0; i < 4; ++i) ss += v[r][i].x * v[r][i].x + v[r][i].y * v[r][i].y + v[r][i].z * v[r][i].z + v[r][i].w * v[r][i].w;
      ss = wave_sum(ss);
      const float rstd = rsqrtf(ss * (1.f / 1024.f) + 1e-6f);
#pragma unroll
      for (int i = 0; i < 4; ++i) {
        const int c = (lane + 64 * i) * 4;
        const f32x4 gv = *(const f32x4*)(g + c), sh = *(const f32x4*)(m + c), sc = *(const f32x4*)(m + 1024 + c);
        store4bf(act + (size_t)(row0 + r) * 1024 + c, v[r][i].x * rstd * gv.x * (1.f + sc.x) + sh.x, v[r][i].y * rstd * gv.y * (1.f + sc.y) + sh.y,
                 v[r][i].z * rstd * gv.z * (1.f + sc.z) + sh.z, v[r][i].w * rstd * gv.w * (1.f + sc.w) + sh.w);
      }
    }
  }
}

template <int PER>
DI void small_norm(bf16_t* buf, const float* g) {
  const int lane = otid() & 63, wave = otid() >> 6;
  for (int row = blockIdx.x * 8 + wave; row < NTOK; row += gridDim.x * 8) {
    bf16_t* r = buf + (size_t)row * (64 * PER);
    float v[PER]; float ss = 0.f;
#pragma unroll
    for (int i = 0; i < PER; ++i) { v[i] = bf2f(r[lane + 64 * i]); ss += v[i] * v[i]; }
    ss = wave_sum(ss);
    const float rstd = rsqrtf(ss / (float)(64 * PER) + 1e-6f);
#pragma unroll
    for (int i = 0; i < PER; ++i) r[lane + 64 * i] = f2bf(v[i] * rstd * g[lane + 64 * i]);
  }
}

DI void phase_final(const P& p) {
  const int lane = otid() & 63, wave = otid() >> 6;
  const float* g = p.in[7];
  for (int row = blockIdx.x * 8 + wave; row < NLAT; row += gridDim.x * 8) {
    float* x = p.out + (size_t)row * 1024;
    f32x4 v[4]; float ss = 0.f;
#pragma unroll
    for (int i = 0; i < 4; ++i) { v[i] = ((const f32x4*)x)[lane + 64 * i]; ss += v[i].x * v[i].x + v[i].y * v[i].y + v[i].z * v[i].z + v[i].w * v[i].w; }
    ss = wave_sum(ss);
    const float rstd = rsqrtf(ss * (1.f / 1024.f) + 1e-6f);
#pragma unroll
    for (int i = 0; i < 4; ++i) {
      const int c = (lane + 64 * i) * 4;
      const float4 gv = *(const float4*)(g + c);
      float4 o; o.x = v[i].x * rstd * gv.x; o.y = v[i].y * rstd * gv.y; o.z = v[i].z * rstd * gv.z; o.w = v[i].w * rstd * gv.w;
      ((float4*)x)[lane + 64 * i] = o;
    }
  }
}

struct AttnItem {
  const bf16_t* Kbase; int kld;
  const bf16_t* Vt;
  int b; int a0, n1, n2;
  const bf16_t* Q; int qld;
  int qtok0; int qpos0;
  float minit, linit;
  bf16_t* og; int ocol;
  bool dry;
};

template <int DQK, int DV, bool MASK>
DI void attn_item(const AttnItem& a, char* smem) {
  constexpr int NKS = DQK / 32, NDB = DV / 16;
  constexpr int KBYTES = 64 * DQK * 2, VBYTES = DV * 64 * 2, STG = KBYTES + VBYTES;
  constexpr int KCH = KBYTES / 8192, VCH = VBYTES / 8192;
  const int tid = otid(), lane = tid & 63, lr = lane & 15, lq = lane >> 4;
  bf16x8 qf[2][NKS];
#pragma unroll
  for (int nb = 0; nb < 2; ++nb)
#pragma unroll
    for (int ks = 0; ks < NKS; ++ks) qf[nb][ks] = *(const bf16x8*)(a.Q + (size_t)(nb * 16 + lr) * a.qld + ks * 32 + lq * 8);
  f32x4 o[NDB][2];
#pragma unroll
  for (int i = 0; i < NDB; ++i) { o[i][0] = (f32x4){0.f, 0.f, 0.f, 0.f}; o[i][1] = (f32x4){0.f, 0.f, 0.f, 0.f}; }
  float m[2] = {a.minit, a.minit};
  float l[2] = {lq == 0 ? a.linit : 0.f, lq == 0 ? a.linit : 0.f};
  int kR[KCH], kC[KCH], vOff[VCH];
#pragma unroll
  for (int c = 0; c < KCH; ++c) {
    const int bb = tid * 16 + c * 8192, st = bb >> 10, sb = bb & 1023, swz = sb ^ (((sb >> 9) & 1) << 5);
    kR[c] = (st / NKS) * 16 + (swz >> 6); kC[c] = (st % NKS) * 32 + ((swz & 63) >> 1);
  }
#pragma unroll
  for (int c = 0; c < VCH; ++c) {
    const int bb = tid * 16 + c * 8192, st = bb >> 10, sb = bb & 1023, swz = sb ^ (((sb >> 9) & 1) << 5);
    vOff[c] = ((st >> 1) * 16 + (swz >> 6)) * KEYS + (st & 1) * 32 + ((swz & 63) >> 1);
  }
  const int ntile = a.n1 + a.n2;
#define ATT_STAGE(buf, i)                                                                                     \
  {                                                                                                           \
    const int kt_ = (i) < a.n1 ? a.a0 + (i) : 64 + ((i) - a.n1);                                              \
    const int key0_ = kt_ * 64;                                                                               \
    const int tokb_ = key0_ < SEQ ? a.b * SEQ + key0_ : NLAT + a.b * LCTX + (key0_ - SEQ);                    \
    char* sb_ = smem + (buf) * STG + tid * 16;                                                                \
    _Pragma("unroll") for (int c = 0; c < KCH; ++c)                                                           \
      __builtin_amdgcn_global_load_lds((const unsigned*)(a.Kbase + (size_t)(tokb_ + kR[c]) * a.kld + kC[c]),  \
                                       (__attribute__((address_space(3))) unsigned*)(sb_ + c * 8192), 16, 0, 0); \
    _Pragma("unroll") for (int c = 0; c < VCH; ++c)                                                           \
      __builtin_amdgcn_global_load_lds((const unsigned*)(a.Vt + vOff[c] + key0_),                             \
                                       (__attribute__((address_space(3))) unsigned*)(sb_ + KBYTES + c * 8192), 16, 0, 0); \
  }
  const int ob = lr * 64 + lq * 16;
  const int lane_off = ob ^ (((ob >> 9) & 1) << 5);
  __syncthreads();
  ATT_STAGE(0, 0);
  for (int it = 0; it < ntile; ++it) {
    asm volatile("s_waitcnt vmcnt(0)" ::: "memory");
    __builtin_amdgcn_s_barrier();
    if (it + 1 < ntile) ATT_STAGE((it + 1) & 1, it + 1);
    const char* sK = smem + (it & 1) * STG + lane_off;
    const char* sV = sK + KBYTES;
    f32x4 s[4][2];
#pragma unroll
    for (int kb = 0; kb < 4; ++kb) { s[kb][0] = (f32x4){0.f, 0.f, 0.f, 0.f}; s[kb][1] = (f32x4){0.f, 0.f, 0.f, 0.f}; }
#pragma unroll
    for (int ks = 0; ks < NKS; ++ks)
#pragma unroll
      for (int kb = 0; kb < 4; ++kb) {
        const bf16x8 kf = *(const bf16x8*)(sK + (kb * NKS + ks) * 1024);
        s[kb][0] = mfma16(kf, qf[0][ks], s[kb][0]);
        s[kb][1] = mfma16(kf, qf[1][ks], s[kb][1]);
      }
    if (MASK) {
      const int kt = it < a.n1 ? a.a0 + it : 64;
      const int dq = kt - (a.qpos0 >> 6);
      if (kt < 64 && (dq <= -2 || dq >= 2)) {
#pragma unroll
        for (int nb = 0; nb < 2; ++nb) {
          const int qp = a.qpos0 + nb * 16 + lr;
#pragma unroll
          for (int kb = 0; kb < 4; ++kb)
#pragma unroll
            for (int j = 0; j < 4; ++j) {
              const int kp = kt * 64 + kb * 16 + 4 * lq + j;
              const int dlt = kp - qp;
              if (dlt > 128 || dlt < -128) s[kb][nb][j] = -INFINITY;
            }
        }
      }
    }
    bf16x8 pf[2][2];
#pragma unroll
    for (int nb = 0; nb < 2; ++nb) {
      float mx = -INFINITY;
#pragma unroll
      for (int kb = 0; kb < 4; ++kb)
#pragma unroll
        for (int j = 0; j < 4; ++j) mx = fmaxf(mx, s[kb][nb][j]);
      mx = half_max(rowpair_max(mx));
      const float mn = fmaxf(m[nb], mx);
      const float alpha = __builtin_amdgcn_exp2f(m[nb] - mn);
      m[nb] = mn;
      float rs = 0.f;
      float pv[4][4];
#pragma unroll
      for (int kb = 0; kb < 4; ++kb)
#pragma unroll
        for (int j = 0; j < 4; ++j) { pv[kb][j] = __builtin_amdgcn_exp2f(s[kb][nb][j] - mn); rs += pv[kb][j]; }
      l[nb] = l[nb] * alpha + rs;
#pragma unroll
      for (int st = 0; st < 2; ++st) {
        u32x4 u;
        u.x = pack2(pv[2 * st][0], pv[2 * st][1]); u.y = pack2(pv[2 * st][2], pv[2 * st][3]);
        u.z = pack2(pv[2 * st + 1][0], pv[2 * st + 1][1]); u.w = pack2(pv[2 * st + 1][2], pv[2 * st + 1][3]);
        pf[nb][st] = __builtin_bit_cast(bf16x8, u);
      }
      if (__builtin_amdgcn_ballot_w64(alpha != 1.f) != 0ull) {
#pragma unroll
        for (int db = 0; db < NDB; ++db) { o[db][nb][0] *= alpha; o[db][nb][1] *= alpha; o[db][nb][2] *= alpha; o[db][nb][3] *= alpha; }
      }
    }
#pragma unroll
    for (int st = 0; st < 2; ++st)
#pragma unroll
      for (int db = 0; db < NDB; ++db) {
        const bf16x8 vf = *(const bf16x8*)(sV + (db * 2 + st) * 1024);
        o[db][0] = mfma16(vf, pf[0][st], o[db][0]);
        o[db][1] = mfma16(vf, pf[1][st], o[db][1]);
      }
  }
#undef ATT_STAGE
  if (a.dry) return;
#pragma unroll
  for (int nb = 0; nb < 2; ++nb) {
    float lt = l[nb];
    lt = half_sum(rowpair_sum(lt));
    const float inv = 1.f / lt;
    const int tok = a.qtok0 + nb * 16 + lr;
    uint2 gg[NDB];
#pragma unroll
    for (int db = 0; db < NDB; ++db) gg[db] = *(const uint2*)(a.og + (size_t)tok * 1024 + a.ocol + db * 16 + 4 * lq);
    PairW pw;
#pragma unroll
    for (int db = 0; db < NDB; ++db) {
      const uint2 g = gg[db];
      const float g0 = __uint_as_float(g.x << 16), g1 = __uint_as_float(g.x & 0xffff0000u);
      const float g2 = __uint_as_float(g.y << 16), g3 = __uint_as_float(g.y & 0xffff0000u);
      pw.put(db & 1, a.og + (size_t)tok * 1024 + a.ocol + (db & ~1) * 16, lq, o[db][nb][0] * inv * g0, o[db][nb][1] * inv * g1, o[db][nb][2] * inv * g2, o[db][nb][3] * inv * g3);
    }
  }
}

DI void phase_mla_attn(const P& p, char* smem, bool dry) {
  const int wave = otid() >> 6;
  const bf16_t* q = (const bf16_t*)(p.ws + O_Q);
  const bf16_t* kp = (const bf16_t*)(p.ws + O_KP);
  const bf16_t* vt = (const bf16_t*)(p.ws + O_ACT);
  bf16_t* og = (bf16_t*)(p.ws + O_SG0);
  const int xcd = blockIdx.x & 7, lb = blockIdx.x >> 3, nlb = (gridDim.x - xcd + 7) >> 3;
  for (int li = lb; li < 68; li += nlb) {
    AttnItem a;
    int b, h, qtok;
    if (li < 64) { const int pair = (li >> 4) * 8 + xcd; b = pair >> 3; h = pair & 7; qtok = b * SEQ + (li & 15) * 256; a.a0 = 0; a.n1 = 64; }
    else { const int pair = (li - 64) * 8 + xcd; b = pair >> 3; h = pair & 7; qtok = NLAT + b * LCTX; a.a0 = 0; a.n1 = 0; }
    a.n2 = 4; a.b = b;
    a.Kbase = kp + h * 192; a.kld = 1536;
    a.Vt = vt + (size_t)(b * 8 + h) * 128 * KEYS;
    a.qtok0 = qtok + wave * 32; a.qpos0 = 0;
    a.Q = q + (size_t)a.qtok0 * 1536 + h * 192; a.qld = 1536;
    a.minit = -INFINITY; a.linit = 0.f;
    a.og = og; a.ocol = h * 128; a.dry = dry;
    attn_item<192, 128, false>(a, smem);
  }
}

DI void phase_swa_attn(const P& p, char* smem, bool dry) {
  const int wave = otid() >> 6;
  const bf16_t* qs = (const bf16_t*)(p.ws + O_QS);
  const bf16_t* ks = (const bf16_t*)(p.ws + O_KS);
  const bf16_t* vt = (const bf16_t*)(p.ws + O_VT2);
  bf16_t* og = (bf16_t*)(p.ws + O_SG2);
  const float* sink = p.in[25];
  for (int it = blockIdx.x; it < 1024; it += gridDim.x) {
    AttnItem a;
    int b, g, qtok, pos0;
    if (it < 1024) {
      b = it >> 8; g = (it >> 6) & 3; const int qb = it & 63;
      pos0 = qb * 64; qtok = b * SEQ + pos0;
      a.a0 = qb - 2 < 0 ? 0 : qb - 2; const int a1 = qb + 3 > 64 ? 64 : qb + 3; a.n1 = a1 - a.a0;
    } else {
      const int j = it - 1024; b = j >> 4; g = (j >> 2) & 3; pos0 = (j & 3) * 64; qtok = NLAT + b * LCTX + pos0;
      a.a0 = 0; a.n1 = 0;
    }
    const int head = g * 4 + (wave >> 1);
    a.n2 = 4; a.b = b;
    a.Kbase = ks + g * 64; a.kld = 256;
    a.Vt = vt + (size_t)(b * 4 + g) * 64 * KEYS;
    a.qtok0 = qtok + (wave & 1) * 32; a.qpos0 = pos0 + (wave & 1) * 32;
    a.Q = qs + (size_t)a.qtok0 * 1024 + head * 64; a.qld = 1024;
    a.minit = sink[head] * LOG2E; a.linit = 1.f;
    a.og = og; a.ocol = head * 64; a.dry = dry;
    attn_item<64, 64, true>(a, smem);
  }
}

typedef f32x2 c32;
DI c32 cmul(c32 a, c32 b) { return (c32){a.x * b.x - a.y * b.y, a.x * b.y + a.y * b.x}; }
DI c32 cmulc(c32 a, c32 b) { return (c32){a.x * b.x + a.y * b.y, a.y * b.x - a.x * b.y}; }
DI int phys(int i) { return i + (i >> 5); }
DI c32 w16(int k) {
  const float c1 = 0.9238795325112867f, s1 = 0.3826834323650898f, r = 0.7071067811865476f;
  switch (k & 7) {
    case 0: return (c32){1.f, 0.f};
    case 1: return (c32){c1, -s1};
    case 2: return (c32){r, -r};
    case 3: return (c32){s1, -c1};
    case 4: return (c32){0.f, -1.f};
    case 5: return (c32){-s1, -c1};
    case 6: return (c32){-r, -r};
    default: return (c32){-c1, -s1};
  }
}
DI c32 w16g(int m) {
  const c32 w = w16(m & 7);
  return (m & 8) ? (c32){-w.x, -w.y} : w;
}
template <bool ZHI>
DI void r4_fwd(c32& x0, c32& x1, c32& x2, c32& x3, c32 t1, c32 t2, c32 t3) {
  const c32 s02 = ZHI ? x0 : x0 + x2, s13 = ZHI ? x1 : x1 + x3, d02 = ZHI ? x0 : x0 - x2, d13 = ZHI ? x1 : x1 - x3;
  const c32 e = (c32){d13.y, -d13.x};
  x0 = s02 + s13; x1 = cmul(s02 - s13, t1); x2 = cmul(d02 + e, t2); x3 = cmul(d02 - e, t3);
}
template <bool LOONLY>
DI void r4_inv(c32& x0, c32& x1, c32& x2, c32& x3, c32 t1, c32 t2, c32 t3) {
  const c32 p1 = cmulc(x1, t1), p2 = cmulc(x2, t2), p3 = cmulc(x3, t3);
  const c32 a = x0 + p1, b = x0 - p1, c = p2 + p3, dd = p2 - p3;
  const c32 d = (c32){-dd.y, dd.x};
  x0 = a + c; x1 = b + d;
  if (!LOONLY) { x2 = a - c; x3 = b - d; }
}
template <bool ZHI>
DI void fft16_fwd2(c32 (&v0)[16], c32 (&v1)[16], c32 w1) {
  const c32 w2 = cmul(w1, w1), w3 = cmul(w1, w2), w4 = cmul(w2, w2), w8 = cmul(w4, w4), w48 = cmul(w4, w8);
#pragma unroll
  for (int k = 0; k < 4; ++k) {
    const c32 tB = k ? cmul(w2, w16g(2 * k)) : w2, tA = k ? cmul(w1, w16g(k)) : w1, tAB = k ? cmul(w3, w16g(3 * k)) : w3;
    r4_fwd<ZHI>(v0[k], v0[k + 4], v0[k + 8], v0[k + 12], tB, tA, tAB);
    r4_fwd<ZHI>(v1[k], v1[k + 4], v1[k + 8], v1[k + 12], tB, tA, tAB);
  }
#pragma unroll
  for (int q = 0; q < 16; q += 4) {
    r4_fwd<false>(v0[q], v0[q + 1], v0[q + 2], v0[q + 3], w8, w4, w48);
    r4_fwd<false>(v1[q], v1[q + 1], v1[q + 2], v1[q + 3], w8, w4, w48);
  }
}
template <bool LOONLY>
DI void fft16_inv2(c32 (&v0)[16], c32 (&v1)[16], c32 w1) {
  const c32 w2 = cmul(w1, w1), w3 = cmul(w1, w2), w4 = cmul(w2, w2), w8 = cmul(w4, w4), w48 = cmul(w4, w8);
#pragma unroll
  for (int q = 0; q < 16; q += 4) {
    r4_inv<false>(v0[q], v0[q + 1], v0[q + 2], v0[q + 3], w8, w4, w48);
    r4_inv<false>(v1[q], v1[q + 1], v1[q + 2], v1[q + 3], w8, w4, w48);
  }
#pragma unroll
  for (int k = 0; k < 4; ++k) {
    const c32 tB = k ? cmul(w2, w16g(2 * k)) : w2, tA = k ? cmul(w1, w16g(k)) : w1, tAB = k ? cmul(w3, w16g(3 * k)) : w3;
    r4_inv<LOONLY>(v0[k], v0[k + 4], v0[k + 8], v0[k + 12], tB, tA, tAB);
    r4_inv<LOONLY>(v1[k], v1[k + 4], v1[k + 8], v1[k + 12], tB, tA, tAB);
  }
}
template <int H, bool INV, bool PRUNE>
DI void fft_pass16(c32* X0, c32* X1) {
  constexpr int ST = H / 16;
  const int tid = otid();
  const int jb = tid & (ST - 1), base = (tid / ST) * H + jb;
  c32 v0[16], v1[16];
  constexpr int NLD = (PRUNE && !INV) ? 8 : 16, NSTR = (PRUNE && INV) ? 8 : 16;
#pragma unroll
  for (int k = 0; k < NLD; ++k) { v0[k] = X0[phys(base + k * ST)]; v1[k] = X1[phys(base + k * ST)]; }
#pragma unroll
  for (int k = NLD; k < 16; ++k) { v0[k] = (c32){0.f, 0.f}; v1[k] = (c32){0.f, 0.f}; }
  const float fr = (float)jb * (1.f / (float)H);
  const c32 w1 = (c32){__builtin_amdgcn_cosf(fr), -__builtin_amdgcn_sinf(fr)};
  if (INV) fft16_inv2<PRUNE>(v0, v1, w1); else fft16_fwd2<PRUNE>(v0, v1, w1);
#pragma unroll
  for (int k = 0; k < NSTR; ++k) { X0[phys(base + k * ST)] = v0[k]; X1[phys(base + k * ST)] = v1[k]; }
  __syncthreads();
}
DI void fft_pass2(c32* X0, c32* X1) {
  const int tid = otid();
#pragma unroll
  for (int i = 0; i < 8; ++i) {
    const int i0 = phys(2 * (tid + NT * i));
    const c32 a = X0[i0], b = X0[i0 + 1], c = X1[i0], d = X1[i0 + 1];
    X0[i0] = a + b; X0[i0 + 1] = a - b; X1[i0] = c + d; X1[i0 + 1] = c - d;
  }
  __syncthreads();
}
template <bool PRUNE>
DI void fft_fwd(c32* X0, c32* X1) { fft_pass16<8192, false, PRUNE>(X0, X1); fft_pass16<512, false, false>(X0, X1); fft_pass16<32, false, false>(X0, X1); fft_pass2(X0, X1); }
DI void fft_conv(c32* X0, c32* X1, const c32* __restrict__ Ks) {
  fft_pass16<8192, false, true>(X0, X1); fft_pass16<512, false, false>(X0, X1); fft_pass16<32, false, false>(X0, X1);
  {
    const int tid = otid();
#pragma unroll
    for (int i = 0; i < 8; ++i) {
      const int mm = tid + NT * i, i0 = phys(2 * mm);
      const f32x4 kk = *(const f32x4*)(Ks + 2 * mm);
      const c32 k0 = (c32){kk.x, kk.y}, k1 = (c32){kk.z, kk.w};
      const c32 a = X0[i0], b = X0[i0 + 1], c = X1[i0], d = X1[i0 + 1];
      const c32 pa = cmul(a + b, k0), pb = cmul(a - b, k1), pc = cmul(c + d, k0), pd = cmul(c - d, k1);
      X0[i0] = pa + pb; X0[i0 + 1] = pa - pb; X1[i0] = pc + pd; X1[i0 + 1] = pc - pd;
    }
    __syncthreads();
  }
  fft_pass16<32, true, false>(X0, X1); fft_pass16<512, true, false>(X0, X1); fft_pass16<8192, true, true>(X0, X1);
}
DI void spec_mul(c32* X0, c32* X1, const c32* __restrict__ Ks) {
  const int tid = otid();
#pragma unroll 8
  for (int i = 0; i < 16; ++i) {
    const c32 k = Ks[tid + NT * i];
    const int n = phys(tid + NT * i);
    X0[n] = cmul(X0[n], k); X1[n] = cmul(X1[n], k);
  }
  __syncthreads();
}
DI float sconv(const bf16_t* u, int t, int len, float w0, float w1, float w2, float cb) {
  float r = cb + w1 * bf2f(u[t]);
  if (t > 0) r += w0 * bf2f(u[t - 1]);
  if (t + 1 < len) r += w2 * bf2f(u[t + 1]);
  return r;
}

DI void sconv8(const bf16_t* u, int t0, int len, float w0, float w1, float w2, float cb, float (&out)[8]) {
  const u32x4 raw = *(const u32x4*)(u + t0);
  float x[10];
  x[0] = t0 > 0 ? bf2f(u[t0 - 1]) : 0.f;
  x[9] = t0 + 8 < len ? bf2f(u[t0 + 8]) : 0.f;
#pragma unroll
  for (int i = 0; i < 4; ++i) { x[1 + 2 * i] = __uint_as_float(raw[i] << 16); x[2 + 2 * i] = __uint_as_float(raw[i] & 0xffff0000u); }
#pragma unroll
  for (int i = 0; i < 8; ++i) out[i] = cb + w0 * x[i] + w1 * x[i + 1] + w2 * x[i + 2];
}

DI void phase_hyena(const P& p, char* smem, float* aux, bool dry) {
  const int tid = otid();
  c32* X0 = (c32*)smem; c32* X1 = (c32*)(smem + 67584);
  bf16_t* ut = (bf16_t*)(p.ws + O_UT);
  const float* hdn = (const float*)(p.ws + O_HDN);
  const float* hdnc = (const float*)(p.ws + O_HDNC);
  c32* Ksp = (c32*)(p.ws + O_FFT + (size_t)blockIdx.x * 131072);
  const float* cw = p.in[15];
  const float* cbv = p.in[16];
  const float* fwo = p.in[21];
  const float* hb = p.in[22];
  for (int c = blockIdx.x; c < 1024; c += gridDim.x) {
    __syncthreads();
    { const int ta = otid(); if (ta < 256) aux[ta] = fwo[(size_t)(ta >> 2) * 4096 + (ta & 3) * 1024 + c]; }
    __syncthreads();
    const float la0 = -15.350567286626973f, la1 = -3.0701134573253945f;
    const float delta = fabsf(la0 + (la1 - la0) * ((float)c / 1023.f));
    const float bias0 = hb[c], bias1 = hb[1024 + c];
    float w0[3], w1[3], w2[3], cb[3];
#pragma unroll
    for (int r = 0; r < 3; ++r) { const int f = r * 1024 + c; w0[r] = cw[f]; w1[r] = cw[3072 + f]; w2[r] = cw[6144 + f]; cb[r] = cbv[f]; }
    const int t0 = tid * 8;
    {
      const int lane = tid & 63, wv = tid >> 6, lr = lane & 15, lq = lane >> 4;
      const bf16_t* hdnb = (const bf16_t*)(p.ws + O_HDNB);
      bf16x8 bfr[2];
#pragma unroll
      for (int ks = 0; ks < 2; ++ks) {
        u32x4 u;
#pragma unroll
        for (int e = 0; e < 4; ++e) {
          const int j0 = ks * 32 + lq * 8 + 2 * e;
          const float wa = lr < 4 ? aux[j0 * 4 + lr] : 0.f, wb = lr < 4 ? aux[(j0 + 1) * 4 + lr] : 0.f;
          u[e] = pack2(wa, wb);
        }
        bfr[ks] = __builtin_bit_cast(bf16x8, u);
      }
      const int o = (lr >> 1) & 1, dir = lr & 1;
      c32* Xo = o ? X1 : X0;
#pragma unroll 1
      for (int mb0 = 0; mb0 < 32; mb0 += 8) {
        bf16x8 a0[8], a1[8];
#pragma unroll
        for (int i = 0; i < 8; ++i) {
          const bf16_t* src = hdnb + (size_t)((wv * 32 + mb0 + i) * 16 + lr) * 64 + lq * 8;
          a0[i] = *(const bf16x8*)src; a1[i] = *(const bf16x8*)(src + 32);
        }
#pragma unroll
        for (int i = 0; i < 8; ++i) {
          f32x4 cc = (f32x4){0.f, 0.f, 0.f, 0.f};
          cc = mfma16(a0[i], bfr[0], cc);
          cc = mfma16(a1[i], bfr[1], cc);
#pragma unroll
          for (int j = 0; j < 4; ++j) {
            const int t = (wv * 32 + mb0 + i) * 16 + 4 * lq + j;
            const float val = cc[j] * __expf(-((float)t / 4095.f) * delta);
            const float partner = __shfl_xor(val, 1, 64);
            if (lr < 4) {
              if (t == 0) { if (dir == 0) Xo[0] = (c32){val + partner, 0.f}; else Xo[phys(4096)] = (c32){0.f, 0.f}; }
              else Xo[phys(dir ? 8192 - t : t)] = (c32){val, 0.f};
            }
          }
        }
      }
      __syncthreads();
      fft_fwd<false>(X0, X1);
#pragma unroll 4
      for (int i = 0; i < 16; ++i) { Ksp[tid + NT * i] = X0[phys(tid + NT * i)]; Ksp[8192 + tid + NT * i] = X1[phys(tid + NT * i)]; }
      __syncthreads();
    }
    const bf16_t* uv = ut + (size_t)c * NTOK;
    const bf16_t* ug0 = ut + (size_t)(1024 + c) * NTOK;
    const bf16_t* ug1 = ut + (size_t)(2048 + c) * NTOK;
    bf16_t* usg = ut + (size_t)(3072 + c) * NTOK;
    {
      float z[4][8], g[4][8];
#pragma unroll
      for (int bb = 0; bb < 4; ++bb) sconv8(uv + bb * SEQ, t0, SEQ, w0[0], w1[0], w2[0], cb[0], z[bb]);
#pragma unroll
      for (int i = 0; i < 8; ++i) {
        X0[phys(t0 + i)] = (c32){z[0][i], z[1][i]};
        X1[phys(t0 + i)] = (c32){z[2][i], z[3][i]};
      }
      __syncthreads();
      fft_conv(X0, X1, Ksp);
      const int t0b = otid() * 8;
#pragma unroll
      for (int bb = 0; bb < 4; ++bb) sconv8(ug0 + bb * SEQ, t0b, SEQ, w0[1], w1[1], w2[1], cb[1], g[bb]);
#pragma unroll
      for (int i = 0; i < 8; ++i) {
        const c32 y0 = X0[phys(t0b + i)], y1 = X1[phys(t0b + i)];
        z[0][i] = g[0][i] * (y0.x * (1.f / 8192.f) + z[0][i] * bias0);
        z[1][i] = g[1][i] * (y0.y * (1.f / 8192.f) + z[1][i] * bias0);
        z[2][i] = g[2][i] * (y1.x * (1.f / 8192.f) + z[2][i] * bias0);
        z[3][i] = g[3][i] * (y1.y * (1.f / 8192.f) + z[3][i] * bias0);
      }
      __syncthreads();
#pragma unroll
      for (int i = 0; i < 8; ++i) {
        X0[phys(t0b + i)] = (c32){z[0][i], z[1][i]};
        X1[phys(t0b + i)] = (c32){z[2][i], z[3][i]};
      }
      __syncthreads();
      fft_conv(X0, X1, Ksp + 8192);
      const int t0c = otid() * 8;
#pragma unroll
      for (int bb = 0; bb < 4; ++bb) sconv8(ug1 + bb * SEQ, t0c, SEQ, w0[2], w1[2], w2[2], cb[2], g[bb]);
#pragma unroll
      for (int bb = 0; bb < 4; ++bb) {
        const u32x4 sgv = *(const u32x4*)(usg + bb * SEQ + t0c);
        float oo[8];
#pragma unroll
        for (int i = 0; i < 8; ++i) {
          const c32 y = (bb < 2) ? X0[phys(t0c + i)] : X1[phys(t0c + i)];
          const float yy = (bb & 1) ? y.y : y.x;
          const float zz = g[bb][i] * (yy * (1.f / 8192.f) + z[bb][i] * bias1);
          const unsigned ra = sgv[i >> 1];
          const float fa = (i & 1) ? __uint_as_float(ra & 0xffff0000u) : __uint_as_float(ra << 16);
          oo[i] = zz * fa;
        }
        u32x4 wv;
        wv.x = pack2(oo[0], oo[1]); wv.y = pack2(oo[2], oo[3]); wv.z = pack2(oo[4], oo[5]); wv.w = pack2(oo[6], oo[7]);
        if (!dry) *(u32x4*)(usg + bb * SEQ + t0c) = wv;
      }
      __syncthreads();
    }
  }
  for (int cb0 = blockIdx.x; cb0 < 1024; cb0 += 4 * gridDim.x) {
    float* aux4 = (float*)smem;
    float* klag = aux4 + 1024;
    f32x4* su = (f32x4*)(klag + 4096);
    f32x4* sz4 = su + 1024;
    f32x4* part = sz4 + 1024;
    int cch[4];
#pragma unroll
    for (int ch = 0; ch < 4; ++ch) { const int cc = cb0 + ch * gridDim.x; cch[ch] = cc < 1024 ? cc : cb0; }
    __syncthreads();
    {
      const int ta = otid();
      if (ta < 256) {
#pragma unroll
        for (int ch = 0; ch < 4; ++ch) aux4[ch * 256 + ta] = fwo[(size_t)(ta >> 2) * 4096 + (ta & 3) * 1024 + cch[ch]];
      }
    }
    __syncthreads();
    {
      const int tf = otid();
      const int t = tf & 255, o = tf >> 8;
      float a0[4] = {0.f, 0.f, 0.f, 0.f}, a1[4] = {0.f, 0.f, 0.f, 0.f};
#pragma unroll 16
      for (int j = 0; j < 64; ++j) {
        const float hv = hdnc[j * LCTX + t];
#pragma unroll
        for (int ch = 0; ch < 4; ++ch) { a0[ch] += hv * aux4[ch * 256 + j * 4 + 2 * o]; a1[ch] += hv * aux4[ch * 256 + j * 4 + 2 * o + 1]; }
      }
#pragma unroll
      for (int ch = 0; ch < 4; ++ch) {
        const float la0 = -15.350567286626973f, la1 = -3.0701134573253945f;
        const float delta = fabsf(la0 + (la1 - la0) * ((float)cch[ch] / 1023.f));
        const float dec = __expf(-((float)t / 255.f) * delta);
        float* kl = klag + ch * 1024 + o * 512;
        if (t == 0) kl[255] = (a0[ch] + a1[ch]) * dec;
        else { kl[255 + t] = a0[ch] * dec; kl[255 - t] = a1[ch] * dec; }
      }
    }
    const int tc = otid();
    const int t = tc & 255, half = tc >> 8;
    float vreg[4][2], g0r[4][2], g1r[4][2], z1[4][2];
#pragma unroll
    for (int ch = 0; ch < 4; ++ch) {
      const int c = cch[ch];
      const bf16_t* uv = ut + (size_t)c * NTOK;
      const bf16_t* ug0 = ut + (size_t)(1024 + c) * NTOK;
      const bf16_t* ug1 = ut + (size_t)(2048 + c) * NTOK;
#pragma unroll
      for (int i = 0; i < 2; ++i) {
        const int base = NLAT + (2 * half + i) * LCTX;
        vreg[ch][i] = sconv(uv + base, t, LCTX, cw[c], cw[3072 + c], cw[6144 + c], cbv[c]);
        g0r[ch][i] = sconv(ug0 + base, t, LCTX, cw[1024 + c], cw[3072 + 1024 + c], cw[6144 + 1024 + c], cbv[1024 + c]);
        g1r[ch][i] = sconv(ug1 + base, t, LCTX, cw[2048 + c], cw[3072 + 2048 + c], cw[6144 + 2048 + c], cbv[2048 + c]);
        ((float*)(su + ch * 256))[t * 4 + 2 * half + i] = vreg[ch][i];
      }
    }
    __syncthreads();
#pragma unroll
    for (int o = 0; o < 2; ++o) {
#pragma unroll
      for (int ch = 0; ch < 4; ++ch) {
        const f32x4* src = (o == 0 ? su : sz4) + ch * 256;
        const float* kl = klag + ch * 1024 + o * 512 + t + 255 - half * 128;
        f32x4 acc = (f32x4){0.f, 0.f, 0.f, 0.f};
#pragma unroll 8
        for (int s2 = 0; s2 < 128; ++s2) acc += kl[-s2] * src[half * 128 + s2];
        part[ch * 512 + half * 256 + t] = acc;
      }
      __syncthreads();
#pragma unroll
      for (int ch = 0; ch < 4; ++ch) {
        const int c = cch[ch];
        const f32x4 p0 = part[ch * 512 + t], p1 = part[ch * 512 + 256 + t];
        const float bias0 = hb[c], bias1 = hb[1024 + c];
        bf16_t* usg = ut + (size_t)(3072 + c) * NTOK;
#pragma unroll
        for (int i = 0; i < 2; ++i) {
          const int bsel = 2 * half + i;
          const float y = (bsel == 0 ? p0.x + p1.x : bsel == 1 ? p0.y + p1.y : bsel == 2 ? p0.z + p1.z : p0.w + p1.w);
          if (o == 0) {
            z1[ch][i] = g0r[ch][i] * (y + vreg[ch][i] * bias0);
            ((float*)(sz4 + ch * 256))[t * 4 + bsel] = z1[ch][i];
          } else {
            const float z2 = g1r[ch][i] * (y + z1[ch][i] * bias1);
            const int tok = NLAT + bsel * LCTX + t;
            if (!dry && (ch == 0 || cb0 + ch * (int)gridDim.x < 1024)) usg[tok] = f2bf(z2 * bf2f(usg[tok]));
          }
        }
      }
      __syncthreads();
    }
  }
}

DI void phase_hy_transpose(const P& p, char* smem) {
  const int tid = otid();
  const bf16_t* z = (const bf16_t*)(p.ws + O_UT) + (size_t)3072 * NTOK;
  bf16_t* og = (bf16_t*)(p.ws + O_ACT);
  bf16_t* tile = (bf16_t*)smem;
  for (int t = blockIdx.x; t < 272 * 16; t += gridDim.x) {
    const int tk0 = (t >> 4) * 64, c0 = (t & 15) * 64;
    __syncthreads();
    { const int ch = tid >> 3, kc = tid & 7;
      *(u32x4*)(tile + ch * 72 + kc * 8) = *(const u32x4*)(z + (size_t)(c0 + ch) * NTOK + tk0 + kc * 8); }
    __syncthreads();
    { const int tk = tid >> 3, cc = tid & 7;
      u32x4 v;
      v.x = (unsigned)tile[(cc * 8 + 0) * 72 + tk] | ((unsigned)tile[(cc * 8 + 1) * 72 + tk] << 16);
      v.y = (unsigned)tile[(cc * 8 + 2) * 72 + tk] | ((unsigned)tile[(cc * 8 + 3) * 72 + tk] << 16);
      v.z = (unsigned)tile[(cc * 8 + 4) * 72 + tk] | ((unsigned)tile[(cc * 8 + 5) * 72 + tk] << 16);
      v.w = (unsigned)tile[(cc * 8 + 6) * 72 + tk] | ((unsigned)tile[(cc * 8 + 7) * 72 + tk] << 16);
      *(u32x4*)(og + (size_t)(tk0 + tk) * 1024 + c0 + cc * 8) = v; }
  }
}

DI void phase_cfconv(const P& p, char* smem) {
  const int tid = otid(), lane = tid & 63, wave = tid >> 6;
  const bf16_t* u3 = (const bf16_t*)(p.ws + O_U3);
  const bf16_t* sg = (const bf16_t*)(p.ws + O_SG3);
  bf16_t* og = (bf16_t*)(p.ws + O_ACT);
  float* red = (float*)smem;
  float* red2 = red + 256;
  const int c0 = tid * 2;
  float w[31][2];
#pragma unroll
  for (int k = 0; k < 31; ++k) { const float2 t = *(const float2*)(p.in[28] + k * 1024 + c0); w[k][0] = t.x; w[k][1] = t.y; }
  const float2 bb = *(const float2*)(p.in[29] + c0), lg = *(const float2*)(p.in[30] + c0), lb = *(const float2*)(p.in[31] + c0);
  for (int tile = blockIdx.x; tile < 1024; tile += gridDim.x) {
    const int tok0 = tile * 16, b = tok0 >> 12, pos0 = tok0 & 4095;
    float acc[16][2];
#pragma unroll
    for (int o = 0; o < 16; ++o) { acc[o][0] = bb.x; acc[o][1] = bb.y; }
#pragma unroll
    for (int r = 0; r < 46; ++r) {
      const int pos = pos0 - 15 + r;
      const int pc = pos < 0 ? 0 : (pos > 4095 ? 4095 : pos);
      unsigned raw = *(const unsigned*)(u3 + (size_t)(b * SEQ + pc) * 1024 + c0);
      if (pos != pc) raw = 0u;
      const float x0 = __uint_as_float(raw << 16), x1 = __uint_as_float(raw & 0xffff0000u);
#pragma unroll
      for (int o = 0; o < 16; ++o) {
        const int j = r - o;
        if (j >= 0 && j <= 30) { acc[o][0] += w[j][0] * x0; acc[o][1] += w[j][1] * x1; }
      }
    }
    __syncthreads();
#pragma unroll
    for (int o = 0; o < 16; ++o) {
      float s1 = acc[o][0] + acc[o][1];
      float s2 = acc[o][0] * acc[o][0] + acc[o][1] * acc[o][1];
      s1 = wave_sum(s1); s2 = wave_sum(s2);
      if (lane == 0) { red[wave * 32 + o] = s1; red[wave * 32 + 16 + o] = s2; }
    }
    __syncthreads();
    if (tid < 32) {
      float s = 0.f;
#pragma unroll
      for (int w8 = 0; w8 < 8; ++w8) s += red[w8 * 32 + tid];
      red2[tid] = s;
    }
    __syncthreads();
#pragma unroll
    for (int o = 0; o < 16; ++o) {
      const float mean = red2[o] * (1.f / 1024.f);
      const float var = red2[16 + o] * (1.f / 1024.f) - mean * mean;
      const float rstd = rsqrtf(fmaxf(var, 0.f) + 1e-6f);
      const int tok = tok0 + o;
      const unsigned graw = *(const unsigned*)(sg + (size_t)tok * 1024 + c0);
      const float y0 = siluf((acc[o][0] - mean) * rstd * lg.x + lb.x) * __uint_as_float(graw << 16);
      const float y1 = siluf((acc[o][1] - mean) * rstd * lg.y + lb.y) * __uint_as_float(graw & 0xffff0000u);
      *(unsigned*)(og + (size_t)tok * 1024 + c0) = pack2(y0, y1);
    }
  }
}


#define XB_TMO      128
#define XB_XCNT(j)  (256  + 64 * (j))
#define XB_XSUB(j)  (1280 + 64 * (j))
#define XB_XGEN(j)  (2304 + 64 * (j))
#define XB_TOP      3328
#define XB_TOPGEN   3392
#define XCD_BAR_WORDS 3456
#define XB_SPIN_CAP (1u << 22)
#define LAS __attribute__((address_space(3)))
DI unsigned xb_ld(unsigned* p) { return __hip_atomic_load(p, __ATOMIC_RELAXED, __HIP_MEMORY_SCOPE_AGENT); }
DI unsigned xb_add(unsigned* p, unsigned v) { return __hip_atomic_fetch_add(p, v, __ATOMIC_RELAXED, __HIP_MEMORY_SCOPE_AGENT); }
DI unsigned xb_xcc_id() { return (unsigned)__builtin_amdgcn_s_getreg((3 << 11) | 20) & 0xFu; }
#define XB_SPIN(cond, bar) do { unsigned _sp = 0; while (cond) { __builtin_amdgcn_s_sleep(1); \
    if ((++_sp & 255u) == 0u) { if (xb_ld(&(bar)[XB_TMO])) break; if (_sp > XB_SPIN_CAP) { atomicAdd(&(bar)[XB_TMO], 1u); break; } } } } while (0)
struct XcdBarrier { unsigned* bar; unsigned x; volatile LAS unsigned* st; };
DI XcdBarrier xcd_barrier_post(unsigned* bar, volatile LAS unsigned* st) {
  XcdBarrier b; b.bar = bar; b.x = xb_xcc_id(); b.st = st;
  if (threadIdx.x == 0) (void)xb_add(&bar[XB_XCNT(b.x)], 1u);
  return b;
}
DI void xcd_barrier_complete(unsigned* bar, unsigned x, unsigned& nloc, unsigned& nx) {
  const unsigned G = gridDim.x * gridDim.y * gridDim.z;
  unsigned sum, cnt, mine, sp = 0u;
  for (;;) {
    sum = 0u; cnt = 0u; mine = 0u;
#pragma unroll
    for (unsigned j = 0; j < 16; ++j) { const unsigned c = xb_ld(&bar[XB_XCNT(j)]); sum += c; cnt += (c > 0u) ? 1u : 0u; mine = (j == x) ? c : mine; }
    if (sum == G) break;
    __builtin_amdgcn_s_sleep(1);
    if ((++sp & 255u) == 0u) { if (xb_ld(&bar[XB_TMO])) break; if (sp > XB_SPIN_CAP) { atomicAdd(&bar[XB_TMO], 1u); break; } }
  }
  nloc = mine > 0u ? mine : 1u; nx = cnt > 0u ? cnt : 1u;
}
__device__ __attribute__((noinline)) void xcd_barrier(unsigned* bbar, unsigned bx, volatile LAS unsigned* bst, bool leader) {
  XcdBarrier b; b.bar = bbar; b.x = bx; b.st = bst;
  asm volatile("s_waitcnt vmcnt(0)" ::: "memory");
  __syncthreads();
  if (leader) {
    unsigned* bar = b.bar;
    __builtin_amdgcn_s_waitcnt(0);
    unsigned nloc = b.st[0], nx = b.st[1];
    if (nloc == 0u) { xcd_barrier_complete(bar, b.x, nloc, nx); b.st[0] = nloc; b.st[1] = nx; }
    const unsigned old = xb_add(&bar[XB_XSUB(b.x)], 1u);
    const unsigned gen = old / nloc;
    if (old + 1u == (gen + 1u) * nloc) {
      __builtin_amdgcn_fence(__ATOMIC_RELEASE, "agent");
      asm volatile("s_waitcnt vmcnt(0)" ::: "memory");
      const unsigned og = xb_add(&bar[XB_TOP], 1u);
      const unsigned tg = og / nx;
      if (og + 1u == (tg + 1u) * nx) xb_add(&bar[XB_TOPGEN], 1u);
      else XB_SPIN(xb_ld(&bar[XB_TOPGEN]) == tg, bar);
      __builtin_amdgcn_fence(__ATOMIC_ACQUIRE, "agent");
      xb_add(&bar[XB_XGEN(b.x)], 1u);
      asm volatile("s_waitcnt vmcnt(0)" ::: "memory");
    } else {
      XB_SPIN(xb_ld(&bar[XB_XGEN(b.x)]) == gen, bar);
      __builtin_amdgcn_fence(__ATOMIC_ACQUIRE, "agent");
      asm volatile("s_waitcnt vmcnt(0)" ::: "memory");
    }
  }
  __syncthreads();
}

__global__ void __launch_bounds__(NT) mega(P p) {
  cg::grid_group grid = cg::this_grid();
  extern __shared__ __attribute__((aligned(16))) char smem[];
  __shared__ float aux[256];
  __shared__ uint4 xb_words;
  if (threadIdx.x == 0) xb_words = make_uint4(0u, 0u, 0u, 0u);
  __syncthreads();
  const XcdBarrier xb = xcd_barrier_post((unsigned*)(p.ws + O_BAR), (volatile LAS unsigned*)&xb_words);
  if (p.reps[7] == 0x7fffffff) grid.sync();

#define REP(g) for (int rep_ = 0; rep_ < p.reps[g]; ++rep_)
  REP(0) { phase0(p, smem); xcd_barrier(xb.bar, xb.x, xb.st, otid() == 0); }
  REP(1) { phase_norm(p, 0, NTOK); phase_shiftw(p, smem); xcd_barrier(xb.bar, xb.x, xb.st, otid() == 0); }
  REP(2) {
    unsigned char* ws = opq(p.ws); const bf16_t* act = (const bf16_t*)(ws + O_ACT); const float2* rope = (const float2*)(ws + O_ROPE); (void)act; (void)rope;
    EpiMlaIn e{(bf16_t*)(ws + O_CQ), (bf16_t*)(ws + O_CKV), (bf16_t*)(ws + O_KP), (bf16_t*)(ws + O_SG0), rope, (float*)(ws + O_RSS)};
    gemm_phase256((const bf16_t*)(ws + O_W_MLA_IN), act, 1024, 1792, NTOK, smem, e, rep_ + 1 < p.reps[2]);
    xcd_barrier(xb.bar, xb.x, xb.st, otid() == 0);
  }
  REP(2) {
    unsigned char* ws = opq(p.ws); const bf16_t* act = (const bf16_t*)(ws + O_ACT); const float2* rope = (const float2*)(ws + O_ROPE); (void)act; (void)rope;
    EpiUq e1{(bf16_t*)(ws + O_Q), rope, (const float*)(ws + O_RSS)};
    EpiUkv e2{(bf16_t*)(ws + O_KP), (bf16_t*)(ws + O_ACT), (const float*)(ws + O_RSS)};
    TileWalk tw(14, 68);
    int ft, tt;
    while (tw.next(ft, tt)) {
      if (ft < 6) gemm_tile8p((const bf16_t*)(ws + O_W_UQ), (const bf16_t*)(ws + O_CQ), 384, ft * 256, tt * 256, smem, e1, rep_ + 1 < p.reps[2]);
      else gemm_tile8p((const bf16_t*)(ws + O_W_UKV), (const bf16_t*)(ws + O_CKV), 256, (ft - 6) * 256, tt * 256, smem, e2, rep_ + 1 < p.reps[2]);
    }
    xcd_barrier(xb.bar, xb.x, xb.st, otid() == 0);
  }
  REP(4) { phase_mla_attn(p, smem, rep_ + 1 < p.reps[4]); xcd_barrier(xb.bar, xb.x, xb.st, otid() == 0); }
  REP(3) {
    unsigned char* ws = opq(p.ws); const bf16_t* act = (const bf16_t*)(ws + O_ACT); float* xc = (float*)(ws + O_XC); float* mod = (float*)(ws + O_MOD); (void)act;
    EpiRes e{p.in[0], p.in[2], p.out, xc, mod + 0 * 5 * 3072, rep_ + 1 < p.reps[3], (bf16_t*)(ws + O_ACT), p.in[4] + 1 * 1024, mod + 1 * 5 * 3072, (float*)(ws + O_RSSL) + 0 * NTOK};
    gemm_phase256((const bf16_t*)(ws + O_W_MLA_OUT), (const bf16_t*)(ws + O_SG0), 1024, 1024, NTOK, smem, e);
    xcd_barrier(xb.bar, xb.x, xb.st, otid() == 0);
  }
  REP(2) {
    unsigned char* ws = opq(p.ws); const bf16_t* act = (const bf16_t*)(ws + O_ACT); const float2* rope = (const float2*)(ws + O_ROPE); (void)act; (void)rope;
    EpiHyIn e{(bf16_t*)(ws + O_UT), PreNorm{(const float*)(ws + O_RSSL) + 0 * NTOK, (const float*)(ws + O_SW), 4096}};
    gemm_phase256((const bf16_t*)(ws + O_W_HY_IN), act, 1024, 4096, NTOK, smem, e, rep_ + 1 < p.reps[2]);
    xcd_barrier(xb.bar, xb.x, xb.st, otid() == 0);
  }
  REP(5) { phase_hyena(p, smem, aux, rep_ + 1 < p.reps[5]); xcd_barrier(xb.bar, xb.x, xb.st, otid() == 0); }
  phase_hy_transpose(p, smem);
  xcd_barrier(xb.bar, xb.x, xb.st, otid() == 0);
  REP(3) {
    unsigned char* ws = opq(p.ws); const bf16_t* act = (const bf16_t*)(ws + O_ACT); float* xc = (float*)(ws + O_XC); float* mod = (float*)(ws + O_MOD); (void)act;
    EpiRes e{p.out, xc, p.out, xc, mod + 1 * 5 * 3072, rep_ + 1 < p.reps[3], (bf16_t*)(ws + O_XG2), p.in[4] + 2 * 1024, mod + 2 * 5 * 3072, (float*)(ws + O_RSSL) + 1 * NTOK};
    gemm_phase256((const bf16_t*)(ws + O_W_HY_OUT), act, 1024, 1024, NTOK, smem, e);
    xcd_barrier(xb.bar, xb.x, xb.st, otid() == 0);
  }
  REP(2) {
    unsigned char* ws = opq(p.ws); const bf16_t* act = (const bf16_t*)(ws + O_ACT); const float2* rope = (const float2*)(ws + O_ROPE); (void)act; (void)rope;
    EpiSwaIn e{(bf16_t*)(ws + O_QS), (bf16_t*)(ws + O_KS), (bf16_t*)(ws + O_VT2), (bf16_t*)(ws + O_SG2), rope, PreNorm{(const float*)(ws + O_RSSL) + 1 * NTOK, (const float*)(ws + O_SW) + 5 * 4096, 2560}};
    gemm_phase256((const bf16_t*)(ws + O_W_SWA_IN), (const bf16_t*)(ws + O_XG2), 1024, 2560, NTOK, smem, e, rep_ + 1 < p.reps[2]);
    xcd_barrier(xb.bar, xb.x, xb.st, otid() == 0);
  }
  REP(6) { phase_swa_attn(p, smem, rep_ + 1 < p.reps[6]); xcd_barrier(xb.bar, xb.x, xb.st, otid() == 0); }
  REP(3) {
    unsigned char* ws = opq(p.ws); const bf16_t* act = (const bf16_t*)(ws + O_ACT); float* xc = (float*)(ws + O_XC); float* mod = (float*)(ws + O_MOD); (void)act;
    EpiRes e{p.out, xc, p.out, xc, mod + 2 * 5 * 3072, rep_ + 1 < p.reps[3], (bf16_t*)(ws + O_ACT), p.in[4] + 3 * 1024, mod + 3 * 5 * 3072, (float*)(ws + O_RSSL) + 2 * NTOK};
    gemm_phase256((const bf16_t*)(ws + O_W_SWA_OUT), (const bf16_t*)(ws + O_SG2), 1024, 1024, NLAT, smem, e);
    xcd_barrier(xb.bar, xb.x, xb.st, otid() == 0);
  }
  REP(2) {
    unsigned char* ws = opq(p.ws); const bf16_t* act = (const bf16_t*)(ws + O_ACT); const float2* rope = (const float2*)(ws + O_ROPE); (void)act; (void)rope;
    EpiCfIn e{(bf16_t*)(ws + O_U3), (bf16_t*)(ws + O_SG3), PreNorm{(const float*)(ws + O_RSSL) + 2 * NTOK, (const float*)(ws + O_SW) + 5 * (4096 + 2560), 3072}};
    gemm_phase256((const bf16_t*)(ws + O_W_CF_IN), act, 1024, 3072, NLAT, smem, e, rep_ + 1 < p.reps[2]);
    xcd_barrier(xb.bar, xb.x, xb.st, otid() == 0);
  }
  REP(7) { phase_cfconv(p, smem); xcd_barrier(xb.bar, xb.x, xb.st, otid() == 0); }
  REP(3) {
    unsigned char* ws = opq(p.ws); const bf16_t* act = (const bf16_t*)(ws + O_ACT); float* xc = (float*)(ws + O_XC); float* mod = (float*)(ws + O_MOD); (void)act;
    EpiRes e{p.out, xc, p.out, xc, mod + 3 * 5 * 3072, rep_ + 1 < p.reps[3], nullptr, nullptr, nullptr, nullptr};
    gemm_phase256((const bf16_t*)(ws + O_W_CF_OUT), act, 1024, 1024, NLAT, smem, e);
    xcd_barrier(xb.bar, xb.x, xb.st, otid() == 0);
  }
  phase_final(p);
}

extern "C" void kernel_launch(void* const* d_in, const int* in_sizes, int n_in, void* d_out, int out_size, void* d_ws, size_t ws_size,
                              hipStream_t stream) {
  static int grid = 0;
  if (grid == 0) {
    if (n_in != 33 || ws_size < WS_NEED) {
      fprintf(stderr, "kernel_launch: need 33 inputs and >= %zu bytes of workspace; got n_in %d, ws %zu\n", (size_t)WS_NEED, n_in, ws_size);
      grid = -1;
      return;
    }
    int dev = 0, cus = 0, per_cu = 0;
    hipGetDevice(&dev);
    hipDeviceGetAttribute(&cus, hipDeviceAttributeMultiprocessorCount, dev);
    if (hipFuncSetAttribute((const void*)mega, hipFuncAttributeMaxDynamicSharedMemorySize, DYN_LDS) != hipSuccess) { fprintf(stderr, "hipFuncSetAttribute failed\n"); grid = -1; return; }
    hipOccupancyMaxActiveBlocksPerMultiprocessor(&per_cu, mega, NT, DYN_LDS);
    int g = cus * per_cu;
    if (g > 256) g = 256;
    if (g < 1) g = 256;
    grid = g;
  }
  if (grid < 0) return;
  P p{};
  for (int i = 0; i < 33; ++i) p.in[i] = (const float*)d_in[i];
  p.out = (float*)d_out;
  p.ws = (unsigned char*)d_ws;
  { const int r[8] = {PROBE_REPS}; for (int i = 0; i < 8; ++i) p.reps[i] = r[i]; }
  if (hipMemsetAsync((char*)d_ws + O_BAR, 0, XCD_BAR_BYTES, stream) != hipSuccess) { fprintf(stderr, "memset of barrier words failed\n"); return; }
  void* args[] = {&p};
  hipError_t e = hipLaunchCooperativeKernel((void*)mega, dim3(grid), dim3(NT), args, DYN_LDS, stream);
  if (e != hipSuccess) fprintf(stderr, "cooperative launch failed: %s (grid %d)\n", hipGetErrorString(e), grid);
}
```

```cpp
#include <hip/hip_runtime.h>
#include <hip/hip_cooperative_groups.h>
#include <cstdio>
#include <cstdint>
namespace cg = cooperative_groups;

typedef unsigned short bf16_t;
typedef __attribute__((ext_vector_type(8))) short bf16x8;
typedef __attribute__((ext_vector_type(4))) float f32x4;
typedef __attribute__((ext_vector_type(2))) float f32x2;
typedef __attribute__((ext_vector_type(4))) unsigned u32x4;
typedef __attribute__((ext_vector_type(2))) unsigned u32x2;

#define NT 512
#define DYN_LDS 139264
#ifndef PROBE_REPS
#define PROBE_REPS 1, 1, 1, 1, 1, 1, 1, 1
#endif
#define DI __device__ __forceinline__

constexpr int NLAT = 16384, NCTX = 1024, NTOK = 17408, SEQ = 4096, LCTX = 256, KEYS = 4352;
constexpr float LOG2E = 1.4426950408889634f;
constexpr size_t XCD_BAR_BYTES = 3456 * 4;

constexpr size_t al(size_t x) { return (x + 255) & ~(size_t)255; }
constexpr size_t O_W_MLA_IN = 0;
constexpr size_t O_W_UQ = O_W_MLA_IN + al((size_t)1792 * 1024 * 2);
constexpr size_t O_W_UKV = O_W_UQ + al((size_t)1536 * 384 * 2);
constexpr size_t O_W_MLA_OUT = O_W_UKV + al((size_t)2048 * 256 * 2);
constexpr size_t O_W_HY_IN = O_W_MLA_OUT + al((size_t)1024 * 1024 * 2);
constexpr size_t O_W_HY_OUT = O_W_HY_IN + al((size_t)4096 * 1024 * 2);
constexpr size_t O_W_SWA_IN = O_W_HY_OUT + al((size_t)1024 * 1024 * 2);
constexpr size_t O_W_SWA_OUT = O_W_SWA_IN + al((size_t)2560 * 1024 * 2);
constexpr size_t O_W_CF_IN = O_W_SWA_OUT + al((size_t)1024 * 1024 * 2);
constexpr size_t O_W_CF_OUT = O_W_CF_IN + al((size_t)3072 * 1024 * 2);
constexpr size_t O_MOD = O_W_CF_OUT + al((size_t)1024 * 1024 * 2);
constexpr size_t O_HDN = O_MOD + al((size_t)4 * 5 * 3072 * 4);
constexpr size_t O_HDNC = O_HDN + al((size_t)64 * 4096 * 4);
constexpr size_t O_HDNB = O_HDNC + al((size_t)64 * 256 * 4);
constexpr size_t O_ROPE = O_HDNB + al((size_t)4096 * 64 * 2);
constexpr size_t O_RSS = O_ROPE + al((size_t)4096 * 32 * 8);
constexpr size_t O_RSSL = O_RSS + al((size_t)2 * NTOK * 4);
constexpr size_t O_SW = O_RSSL + al((size_t)3 * NTOK * 4);
constexpr size_t O_XC = O_SW + al((size_t)5 * 9728 * 4);
constexpr size_t O_ACT = O_XC + al((size_t)NCTX * 1024 * 4);
constexpr size_t O_T = O_ACT + al((size_t)NTOK * 1024 * 2);
constexpr size_t O_CQ = O_T;
constexpr size_t O_CKV = O_CQ + al((size_t)NTOK * 384 * 2);
constexpr size_t O_SG0 = O_CKV + al((size_t)NTOK * 256 * 2);
constexpr size_t O_Q = O_SG0 + al((size_t)NTOK * 1024 * 2);
constexpr size_t O_KP = O_Q + al((size_t)NTOK * 1536 * 2);
constexpr size_t O_END0 = O_KP + al((size_t)NTOK * 1536 * 2);
constexpr size_t O_UT = O_T;
constexpr size_t O_FFT = O_UT + al((size_t)4096 * NTOK * 2);
constexpr size_t O_END1 = O_FFT + (size_t)256 * 131072;
constexpr size_t O_QS = O_T;
constexpr size_t O_KS = O_QS + al((size_t)NTOK * 1024 * 2);
constexpr size_t O_VT2 = O_KS + al((size_t)NTOK * 256 * 2);
constexpr size_t O_SG2 = O_VT2 + al((size_t)16 * 64 * KEYS * 2);
constexpr size_t O_U3 = O_T;
constexpr size_t O_SG3 = O_U3 + al((size_t)NLAT * 1024 * 2);
constexpr size_t O_BAR = (O_END0 > O_END1 ? O_END0 : O_END1);
constexpr size_t O_XG2 = O_T + (size_t)96 * 1024 * 1024;
constexpr size_t WS_NEED = O_BAR + XCD_BAR_BYTES;

struct P {
  const float* in[33];
  float* out;
  unsigned char* ws;
  int reps[8];
};

DI int otid() { int t = threadIdx.x; asm volatile("" : "+v"(t)); return t; }
template <class T> DI T* opq(T* p) { asm volatile("" : "+s"(p)); return p; }
DI bf16_t f2bf(float x) { unsigned r; asm("v_cvt_pk_bf16_f32 %0, %1, %1" : "=v"(r) : "v"(x)); return (bf16_t)r; }
DI float bf2f(bf16_t v) { return __uint_as_float(((unsigned)v) << 16); }
DI unsigned pack2(float a, float b) { unsigned r; asm("v_cvt_pk_bf16_f32 %0, %1, %2" : "=v"(r) : "v"(a), "v"(b)); return r; }
DI float siluf(float x) { return x * __builtin_amdgcn_rcpf(1.f + __expf(-x)); }
DI float sigmf(float x) { return __builtin_amdgcn_rcpf(1.f + __expf(-x)); }
DI float rowpair_sum(float x) { const auto r = __builtin_amdgcn_permlane16_swap(__float_as_uint(x), __float_as_uint(x), false, false); return __uint_as_float(r[0]) + __uint_as_float(r[1]); }
DI float half_sum(float x) { const auto r = __builtin_amdgcn_permlane32_swap(__float_as_uint(x), __float_as_uint(x), false, false); return __uint_as_float(r[0]) + __uint_as_float(r[1]); }
DI float rowpair_max(float x) { const auto r = __builtin_amdgcn_permlane16_swap(__float_as_uint(x), __float_as_uint(x), false, false); return fmaxf(__uint_as_float(r[0]), __uint_as_float(r[1])); }
DI float half_max(float x) { const auto r = __builtin_amdgcn_permlane32_swap(__float_as_uint(x), __float_as_uint(x), false, false); return fmaxf(__uint_as_float(r[0]), __uint_as_float(r[1])); }
DI float wave_sum(float v) {
#pragma unroll
  for (int o = 32; o >= 1; o >>= 1) v += __shfl_xor(v, o, 64);
  return v;
}
DI void store4bf(bf16_t* p, float a, float b, float c, float d) {
  uint2 v; v.x = pack2(a, b); v.y = pack2(c, d);
  *(uint2*)p = v;
}
struct PairW {
  unsigned ax, ay;
  DI void put(int fi, bf16_t* row64, int lq, float a, float b, float c, float d) {
    const unsigned px = pack2(a, b), py = pack2(c, d);
    if ((fi & 1) == 0) { ax = px; ay = py; }
    else {
      const auto rx = __builtin_amdgcn_permlane16_swap(ax, px, false, false);
      const auto ry = __builtin_amdgcn_permlane16_swap(ay, py, false, false);
      u32x4 v; v.x = rx[0]; v.y = ry[0]; v.z = rx[1]; v.w = ry[1];
      const int col = (lq & 1) ? fi * 16 + 4 * (lq - 1) : (fi - 1) * 16 + 4 * lq;
      *(u32x4*)(row64 + col) = v;
    }
  }
};
template <bool PERM>
DI void tstore2(bf16_t* row32, int lr, float v0, float v1) {
  const float snd = (lr & 1) ? v0 : v1;
  const float rcv = __int_as_float(__builtin_amdgcn_mov_dpp(__float_as_int(snd), 0xB1, 0xF, 0xF, true));
  const unsigned w = (lr & 1) ? pack2(rcv, v1) : pack2(v0, rcv);
  const int pos = PERM ? ((lr >> 2) * 8 + ((lr & 1) ? 4 : 0) + (lr & 2)) : ((lr & 1) ? 16 + lr - 1 : lr);
  *(unsigned*)(row32 + pos) = w;
}
DI f32x4 mfma16(bf16x8 a, bf16x8 b, f32x4 c) { return __builtin_amdgcn_mfma_f32_16x16x32_bf16(a, b, c, 0, 0, 0); }

DI int tok_modrow(int tok) { return tok < NLAT ? (tok >> 12) : 4; }
DI int tok_batch(int tok) { return tok < NLAT ? (tok >> 12) : ((tok - NLAT) >> 8); }
DI int tok_key(int tok) { return tok < NLAT ? (tok & 4095) : (SEQ + ((tok - NLAT) & 255)); }
DI int key_perm(int key) { const int x = key & 31; return (key & ~31) | (((x >> 2) & 3) * 8 + (x >> 4) * 4 + (x & 3)); }

constexpr int GLD = 72;
template <class Epi>
DI void gemm_tile(const bf16_t* __restrict__ W, const bf16_t* __restrict__ X, int K, int f0, int t0, char* smem, const Epi& epi) {
  bf16_t* sW = (bf16_t*)smem;
  bf16_t* sX = sW + 128 * GLD;
  const int tid = otid(), lane = tid & 63, wave = tid >> 6;
  const int wf = wave >> 2, wt = wave & 3;
  const int lr = lane & 15, lq = lane >> 4;
  f32x4 acc[4][4];
#pragma unroll
  for (int i = 0; i < 4; ++i)
#pragma unroll
    for (int j = 0; j < 4; ++j) acc[i][j] = (f32x4){0.f, 0.f, 0.f, 0.f};
  u32x4 rwA[2], rxA[4], rwB[2], rxB[4];
  const int crow = tid >> 3, ccol = (tid & 7) * 8;
  const bf16_t* Wp = W + (size_t)(f0 + crow) * K + ccol;
  const bf16_t* Xp = X + (size_t)(t0 + crow) * K + ccol;
#define G_LOAD(RW, RX, KOFF)                                                            \
  {                                                                                     \
    _Pragma("unroll") for (int i = 0; i < 2; ++i) RW[i] = *(const u32x4*)(Wp + (size_t)(64 * i) * K + (KOFF)); \
    _Pragma("unroll") for (int i = 0; i < 4; ++i) RX[i] = *(const u32x4*)(Xp + (size_t)(64 * i) * K + (KOFF)); \
  }
#define G_STORE(RW, RX)                                                                 \
  {                                                                                     \
    _Pragma("unroll") for (int i = 0; i < 2; ++i) *(u32x4*)(sW + (crow + 64 * i) * GLD + ccol) = RW[i]; \
    _Pragma("unroll") for (int i = 0; i < 4; ++i) *(u32x4*)(sX + (crow + 64 * i) * GLD + ccol) = RX[i]; \
  }
#define G_COMPUTE()                                                                     \
  {                                                                                     \
    _Pragma("unroll") for (int ks = 0; ks < 2; ++ks) {                                  \
      bf16x8 a[4], b[4];                                                                \
      _Pragma("unroll") for (int i = 0; i < 4; ++i) a[i] = *(const bf16x8*)(sW + (wf * 64 + i * 16 + lr) * GLD + ks * 32 + lq * 8); \
      _Pragma("unroll") for (int i = 0; i < 4; ++i) b[i] = *(const bf16x8*)(sX + (wt * 64 + i * 16 + lr) * GLD + ks * 32 + lq * 8); \
      _Pragma("unroll") for (int i = 0; i < 4; ++i)                                     \
        _Pragma("unroll") for (int j = 0; j < 4; ++j) acc[i][j] = mfma16(a[i], b[j], acc[i][j]); \
    }                                                                                   \
  }
  G_LOAD(rwA, rxA, 0);
  G_LOAD(rwB, rxB, 64);
  for (int k0 = 0; k0 < K; k0 += 128) {
    __syncthreads();
    G_STORE(rwA, rxA);
    __syncthreads();
    { const int kn = k0 + 128 < K ? k0 + 128 : K - 128; G_LOAD(rwA, rxA, kn); }
    G_COMPUTE();
    __syncthreads();
    G_STORE(rwB, rxB);
    __syncthreads();
    { const int kn = k0 + 192 < K ? k0 + 192 : K - 64; G_LOAD(rwB, rxB, kn); }
    G_COMPUTE();
  }
#undef G_LOAD
#undef G_STORE
#undef G_COMPUTE
  epi(f0 + wf * 64, t0 + wt * 64, acc);
}

struct TileWalk {
  int nft, start, ntl, u, nlb;
  DI TileWalk(int nft_, int ntt) {
    const int x = blockIdx.x & 7;
    nft = nft_;
    start = (x * ntt) >> 3;
    ntl = (((x + 1) * ntt) >> 3) - start;
    u = blockIdx.x >> 3;
    nlb = (gridDim.x - x + 7) >> 3;
  }
  DI bool next(int& ft, int& tt) {
    if (u >= ntl * nft) return false;
    const int grp = u / (4 * nft), rem = u - grp * 4 * nft;
    const int left = ntl - grp * 4, gsz = left < 4 ? left : 4;
    ft = rem / gsz;
    tt = start + grp * 4 + rem % gsz;
    u += nlb;
    return true;
  }
};

template <class Epi>
DI void gemm_phase(const bf16_t* W, const bf16_t* X, int K, int NF, int NTK, char* smem, const Epi& epi) {
  TileWalk tw(NF / 128, NTK / 256);
  int ft, tt;
  while (tw.next(ft, tt)) gemm_tile(W, X, K, ft * 128, tt * 256, smem, epi);
}


constexpr int G_BK = 64, G_HALF = 128, G_HT = G_HALF * G_BK;
DI int g_lds_byte(int r, int c) {
  int st = (r >> 4) * 2 + (c >> 5), rr = r & 15, cc = c & 31, ob = rr * 64 + cc * 2;
  return st * 1024 + (ob ^ (((ob >> 9) & 1) << 5));
}
DI void g_stage_rc(int b, int& R, int& C) {
  int st = b / 1024, sb = b % 1024, swz = sb ^ (((sb >> 9) & 1) << 5);
  R = (st >> 1) * 16 + swz / 64; C = (st & 1) * 32 + (swz % 64) / 2;
}
template <class Epi>
DI void gemm_tile256(const bf16_t* __restrict__ W, const bf16_t* __restrict__ X, int K, int f0, int t0, char* smem, const Epi& epi, bool dry = false) {
  const int tidx = otid();
  const int wid = tidx >> 6, lane = tidx & 63, wr = wid >> 2, wc = wid & 3, fr = lane & 15, fq = lane >> 4;
  f32x4 acc[8][4];
#pragma unroll
  for (int i = 0; i < 8; ++i)
#pragma unroll
    for (int j = 0; j < 4; ++j) acc[i][j] = (f32x4){0.f, 0.f, 0.f, 0.f};
  int r0, c0, r1, c1;
  g_stage_rc(tidx * 16, r0, c0);
  g_stage_rc(tidx * 16 + 8192, r1, c1);
  const bf16_t* Wg0 = W + (size_t)(f0 + r0) * K + c0;
  const bf16_t* Wg1 = W + (size_t)(f0 + r1) * K + c1;
  const bf16_t* Xg0 = X + (size_t)(t0 + r0) * K + c0;
  const bf16_t* Xg1 = X + (size_t)(t0 + r1) * K + c1;
  const size_t hk = (size_t)128 * K;
#define GLL(src, dst) __builtin_amdgcn_global_load_lds((const unsigned*)(src), (__attribute__((address_space(3))) unsigned*)(dst), 16, 0, 0)
#define STAGE_ALL(buf, kt)                                                     \
  {                                                                            \
    char* sb_ = smem + (buf) * 65536 + tidx * 16;                              \
    const size_t ko_ = (size_t)(kt) * 64;                                      \
    GLL(Wg0 + ko_, sb_);               GLL(Wg1 + ko_, sb_ + 8192);             \
    GLL(Wg0 + hk + ko_, sb_ + 16384);  GLL(Wg1 + hk + ko_, sb_ + 24576);       \
    GLL(Xg0 + ko_, sb_ + 32768);       GLL(Xg1 + ko_, sb_ + 40960);            \
    GLL(Xg0 + hk + ko_, sb_ + 49152);  GLL(Xg1 + hk + ko_, sb_ + 57344);       \
  }
  const int ob = fr * 64 + fq * 16;
  const int lane_off = ob ^ (((ob >> 9) & 1) << 5);
  const char* aBase = smem + wr * 16384 + lane_off;
  const char* bBase = smem + 32768 + (wc >> 1) * 16384 + (wc & 1) * 8192 + lane_off;
  const int nt = K / 64;
  STAGE_ALL(0, 0);
  for (int kt = 0; kt < nt; ++kt) {
    asm volatile("s_waitcnt vmcnt(0)" ::: "memory");
    __builtin_amdgcn_s_barrier();
    if (kt + 1 < nt) STAGE_ALL((kt + 1) & 1, kt + 1);
    const char* ab = aBase + (kt & 1) * 65536;
    const char* bb = bBase + (kt & 1) * 65536;
#pragma unroll
    for (int ks = 0; ks < 2; ++ks) {
      bf16x8 a[8], b[4];
#pragma unroll
      for (int m = 0; m < 8; ++m) a[m] = *(const bf16x8*)(ab + (m * 2 + ks) * 1024);
#pragma unroll
      for (int n = 0; n < 4; ++n) b[n] = *(const bf16x8*)(bb + (n * 2 + ks) * 1024);
#pragma unroll
      for (int m = 0; m < 8; ++m)
#pragma unroll
        for (int n = 0; n < 4; ++n) acc[m][n] = mfma16(a[m], b[n], acc[m][n]);
    }
  }
#undef GLL
#undef STAGE_ALL
  if (!dry) {
    f32x4 (&lo)[4][4] = *reinterpret_cast<f32x4 (*)[4][4]>(&acc[0]);
    f32x4 (&hi)[4][4] = *reinterpret_cast<f32x4 (*)[4][4]>(&acc[4]);
    epi(f0 + wr * 128, t0 + wc * 64, lo);
    epi(f0 + wr * 128 + 64, t0 + wc * 64, hi);
  }
}


template <class Epi>
DI void gemm_tile8p(const bf16_t* __restrict__ A, const bf16_t* __restrict__ Bt, int K, int brow, int bcol, char* smem, const Epi& epi, bool dry = false) {
  bf16_t* shm = (bf16_t*)smem;
  #define SA(b,h) (shm+((b)*2+(h))*G_HT)
  #define SB(b,h) (shm+(4+(b)*2+(h))*G_HT)
  #define STAGE(P,BASE,br,kt) do{long _g=(long)(br)*K+(long)(kt)*G_BK; \
    for(int _i=0;_i<2;++_i){int _b=tidx*16+_i*8192;int _r,_c;g_stage_rc(_b,_r,_c); \
      __builtin_amdgcn_global_load_lds((const unsigned*)(BASE+_g+(long)_r*K+_c), \
        (__attribute__((address_space(3))) unsigned*)((char*)(P)+_b),16,0,0);}}while(0)
  #define LDA(dst,b,h) for(int m=0;m<4;++m)for(int k=0;k<2;++k) \
    dst[m][k]=*reinterpret_cast<const bf16x8*>((char*)SA(b,h)+g_lds_byte(wr*64+m*16+fr,k*32+fq*8))
  #define LDB(dst,b,h) for(int n=0;n<2;++n)for(int k=0;k<2;++k) \
    dst[n][k]=*reinterpret_cast<const bf16x8*>((char*)SB(b,h)+g_lds_byte(wc*32+n*16+fr,k*32+fq*8))
  #define MMA(ai,bj,At,Bt_) do{__builtin_amdgcn_s_setprio(1); \
    for(int m=0;m<4;++m)for(int n=0;n<2;++n)for(int k=0;k<2;++k) \
      acc[ai][bj][m][n]=__builtin_amdgcn_mfma_f32_16x16x32_bf16(At[m][k],Bt_[n][k],acc[ai][bj][m][n],0,0,0); \
    __builtin_amdgcn_s_setprio(0);}while(0)
  #define WAIT_V(n) asm volatile("s_waitcnt vmcnt(" #n ")":::"memory")
  #define WAIT_L(n) asm volatile("s_waitcnt lgkmcnt(" #n ")":::"memory")
  #define BAR __builtin_amdgcn_s_barrier()
  #define SCHED __builtin_amdgcn_sched_barrier(0)
  const int tidx = otid();
  const int wid=tidx>>6,lane=tidx&63,wr=wid>>2,wc=wid&3,fr=lane&15,fq=lane>>4;
  f32x4 acc[2][2][4][2]={};
  bf16x8 At[4][2],B0[2][2],B1[2][2];
  const int nt=K/G_BK;
  asm volatile("s_waitcnt vmcnt(0) lgkmcnt(0)" ::: "memory");
  __syncthreads();
  STAGE(SB(0,0),Bt,bcol,0); STAGE(SA(0,0),A,brow,0);
  STAGE(SB(0,1),Bt,bcol+G_HALF,0); STAGE(SA(0,1),A,brow+G_HALF,0);
  if(wr==1)BAR;
  WAIT_V(4); BAR;
  STAGE(SB(1,0),Bt,bcol,1); STAGE(SA(1,0),A,brow,1); STAGE(SB(1,1),Bt,bcol+G_HALF,1);
  WAIT_V(6); BAR;
  for(int t=0;t<nt-2;t+=2){
    LDB(B0,0,0); SCHED; LDA(At,0,0); STAGE(SA(1,1),A,brow+G_HALF,t+1);
    WAIT_L(8); BAR; WAIT_L(0); MMA(0,0,At,B0); BAR; SCHED;
    LDB(B1,0,1); STAGE(SB(0,0),Bt,bcol,t+2);
    BAR; WAIT_L(0); MMA(0,1,At,B1); BAR;
    LDA(At,0,1); STAGE(SA(0,0),A,brow,t+2);
    BAR; WAIT_L(0); MMA(1,0,At,B0); BAR; SCHED;
    STAGE(SB(0,1),Bt,bcol+G_HALF,t+2);
    WAIT_V(6); BAR; MMA(1,1,At,B1); BAR;
    LDB(B0,1,0); SCHED; LDA(At,1,0); STAGE(SA(0,1),A,brow+G_HALF,t+2);
    WAIT_L(8); BAR; WAIT_L(0); MMA(0,0,At,B0); BAR; SCHED;
    LDB(B1,1,1); STAGE(SB(1,0),Bt,bcol,t+3);
    BAR; WAIT_L(0); MMA(0,1,At,B1); BAR;
    LDA(At,1,1); STAGE(SA(1,0),A,brow,t+3);
    BAR; WAIT_L(0); MMA(1,0,At,B0); BAR; SCHED;
    STAGE(SB(1,1),Bt,bcol+G_HALF,t+3);
    WAIT_V(6); BAR; MMA(1,1,At,B1); BAR;
  }
  { LDB(B0,0,0); LDA(At,0,0); STAGE(SA(1,1),A,brow+G_HALF,nt-1);
    BAR; WAIT_L(0); MMA(0,0,At,B0); BAR;
    LDB(B1,0,1); BAR; WAIT_L(0); MMA(0,1,At,B1); BAR;
    LDA(At,0,1); WAIT_V(4); BAR; WAIT_L(0); MMA(1,0,At,B0); MMA(1,1,At,B1); BAR; }
  { LDB(B0,1,0); LDA(At,1,0); WAIT_V(2); BAR; WAIT_L(0); MMA(0,0,At,B0); BAR;
    LDB(B1,1,1); WAIT_V(0); BAR; WAIT_L(0); MMA(0,1,At,B1); BAR;
    LDA(At,1,1); BAR; WAIT_L(0); MMA(1,0,At,B0); MMA(1,1,At,B1); BAR; }
  if(wr==0)BAR;
  if (!dry) {
#pragma unroll
    for(int ai=0;ai<2;++ai)
#pragma unroll
      for(int bj=0;bj<2;++bj) epi(brow+ai*G_HALF+wr*64, bcol+bj*G_HALF+wc*32, acc[ai][bj]);
  }
  #undef SA
  #undef SB
  #undef STAGE
  #undef LDA
  #undef LDB
  #undef MMA
  #undef WAIT_V
  #undef WAIT_L
  #undef BAR
  #undef SCHED
}

template <class Epi>
DI void gemm_phase256(const bf16_t* W, const bf16_t* X, int K, int NF, int NTK, char* smem, const Epi& epi, bool dry = false) {
  TileWalk tw(NF / 256, NTK / 256);
  int ft, tt;
  while (tw.next(ft, tt)) gemm_tile8p(W, X, K, ft * 256, tt * 256, smem, epi, dry);
}

struct EpiMlaIn {
  bf16_t *cq, *ckv, *kp, *sg; const float2* rope; float* rss;
  template <int NTI> DI void operator()(int f0, int t0, f32x4 (&acc)[4][NTI]) const {
    const int lane = otid() & 63, lr = lane & 15, lq = lane >> 4;
    if (f0 >= 1728) return;
    if (f0 == 640) {
#pragma unroll
      for (int ti = 0; ti < NTI; ++ti) {
        const int tok = t0 + ti * 16 + lr;
        const bool lat = tok < NLAT;
        const int pos = tok & 4095;
#pragma unroll
        for (int fi = 0; fi < 2; ++fi) {
          float o1[4], o2[4];
          const f32x4 rc01 = *(const f32x4*)(rope + pos * 32 + fi * 16 + 4 * lq), rc23 = *(const f32x4*)(rope + pos * 32 + fi * 16 + 4 * lq + 2);
#pragma unroll
          for (int j = 0; j < 4; ++j) {
            float x1 = acc[fi][ti][j], x2 = acc[fi + 2][ti][j];
            const float2 cs = make_float2(j == 0 ? rc01.x : j == 1 ? rc01.z : j == 2 ? rc23.x : rc23.z, j == 0 ? rc01.y : j == 1 ? rc01.w : j == 2 ? rc23.y : rc23.w);
            if (lat) { o1[j] = x1 * cs.x - x2 * cs.y; o2[j] = x1 * cs.y + x2 * cs.x; }
            else { o1[j] = x1; o2[j] = x2; }
          }
          const int d0 = fi * 16 + 4 * lq;
#pragma unroll
          for (int h = 0; h < 8; ++h) {
            bf16_t* base = kp + ((size_t)tok * 8 + h) * 192 + 128;
            store4bf(base + d0, o1[0], o1[1], o1[2], o1[3]);
            store4bf(base + 32 + d0, o2[0], o2[1], o2[2], o2[3]);
          }
        }
      }
      return;
    }
    if (f0 < 640) {
#pragma unroll
      for (int ti = 0; ti < NTI; ++ti) {
        const int tok = t0 + ti * 16 + lr;
        float ss = 0.f;
        PairW pw;
        bf16_t* row64 = f0 < 384 ? cq + (size_t)tok * 384 + f0 : ckv + (size_t)tok * 256 + (f0 - 384);
#pragma unroll
        for (int fi = 0; fi < 4; ++fi) {
          f32x4 v = acc[fi][ti];
          ss += v[0] * v[0] + v[1] * v[1] + v[2] * v[2] + v[3] * v[3];
          pw.put(fi, row64, lq, v[0], v[1], v[2], v[3]);
        }
        ss = half_sum(rowpair_sum(ss));
        if (lq == 0) atomicAdd(rss + (f0 < 384 ? 0 : NTOK) + tok, ss);
      }
      return;
    }
#pragma unroll
    for (int ti = 0; ti < NTI; ++ti) {
      const int tok = t0 + ti * 16 + lr;
      PairW pw;
      bf16_t* row64 = sg + (size_t)tok * 1024 + (f0 - 704);
#pragma unroll
      for (int fi = 0; fi < 4; ++fi) {
        f32x4 v = acc[fi][ti];
        pw.put(fi, row64, lq, siluf(v[0]), siluf(v[1]), siluf(v[2]), siluf(v[3]));
      }
    }
  }
};

struct EpiUq {
  bf16_t* q; const float2* rope; const float* rss;
  template <int NTI> DI void operator()(int f0, int t0, f32x4 (&acc)[4][NTI]) const {
    const int lane = otid() & 63, lr = lane & 15, lq = lane >> 4;
    const bool isrope = (f0 % 192) == 128;
#pragma unroll
    for (int ti = 0; ti < NTI; ++ti) {
      const int tok = t0 + ti * 16 + lr;
      const int pos = tok & 4095;
      const float sc = 0.07216878364870322f * LOG2E * rsqrtf(rss[tok] * (1.f / 384.f) + 1e-6f);
      bf16_t* row64 = q + (size_t)tok * 1536 + f0;
      if (isrope && tok < NLAT) {
        PairW p1, p2;
#pragma unroll
        for (int fi = 0; fi < 2; ++fi) {
          float o1[4], o2[4];
          const f32x4 rc01 = *(const f32x4*)(rope + pos * 32 + fi * 16 + 4 * lq), rc23 = *(const f32x4*)(rope + pos * 32 + fi * 16 + 4 * lq + 2);
#pragma unroll
          for (int j = 0; j < 4; ++j) {
            const float2 cs = make_float2(j == 0 ? rc01.x : j == 1 ? rc01.z : j == 2 ? rc23.x : rc23.z, j == 0 ? rc01.y : j == 1 ? rc01.w : j == 2 ? rc23.y : rc23.w);
            float x1 = acc[fi][ti][j], x2 = acc[fi + 2][ti][j];
            o1[j] = (x1 * cs.x - x2 * cs.y) * sc; o2[j] = (x1 * cs.y + x2 * cs.x) * sc;
          }
          p1.put(fi, row64, lq, o1[0], o1[1], o1[2], o1[3]);
          p2.put(fi, row64 + 32, lq, o2[0], o2[1], o2[2], o2[3]);
        }
      } else {
        PairW pw;
#pragma unroll
        for (int fi = 0; fi < 4; ++fi) {
          f32x4 v = acc[fi][ti];
          pw.put(fi, row64, lq, v[0] * sc, v[1] * sc, v[2] * sc, v[3] * sc);
        }
      }
    }
  }
};

struct EpiUkv {
  bf16_t *kp, *vt; const float* rss;
  template <int NTI> DI void operator()(int f0, int t0, f32x4 (&acc)[4][NTI]) const {
    const int lane = otid() & 63, lr = lane & 15, lq = lane >> 4;
    const int h = f0 >> 8, r = f0 & 255;
#pragma unroll
    for (int ti = 0; ti < NTI; ++ti) {
      const int tok = t0 + ti * 16 + lr;
      const float rs = rsqrtf(rss[NTOK + tok] * (1.f / 256.f) + 1e-6f);
      if (r < 128) {
        PairW pw;
        bf16_t* row64 = kp + ((size_t)tok * 8 + h) * 192 + r;
#pragma unroll
        for (int fi = 0; fi < 4; ++fi) {
          f32x4 v = acc[fi][ti] * rs;
          pw.put(fi, row64, lq, v[0], v[1], v[2], v[3]);
        }
      }
    }
    if (r >= 128) {
      static_assert(NTI == 2, "transposed pair store expects the 32-token sub-tile of the 8-phase GEMM body");
      const int b = tok_batch(t0), key0 = tok_key(t0);
      const float rs0 = rsqrtf(rss[NTOK + t0 + lr] * (1.f / 256.f) + 1e-6f), rs1 = rsqrtf(rss[NTOK + t0 + 16 + lr] * (1.f / 256.f) + 1e-6f);
#pragma unroll
      for (int fi = 0; fi < 4; ++fi)
#pragma unroll
        for (int j = 0; j < 4; ++j) {
          const int dv = r - 128 + fi * 16 + 4 * lq + j;
          tstore2<true>(vt + ((size_t)(b * 8 + h) * 128 + dv) * KEYS + key0, lr, acc[fi][0][j] * rs0, acc[fi][1][j] * rs1);
        }
    }
  }
};

struct EpiRes {
  const float *sl, *sc; float *xl, *xc; const float* mod; bool dry;
  bf16_t* xg; const float* gn; const float* modn; float* rssn;
  template <int NTI> DI void operator()(int f0, int t0, f32x4 (&acc)[4][NTI]) const {
    if (dry) return;
    const int lane = otid() & 63, lr = lane & 15, lq = lane >> 4;
#pragma unroll
    for (int ti = 0; ti < NTI; ++ti) {
      const int tok = t0 + ti * 16 + lr;
      const size_t ro = tok < NLAT ? (size_t)tok * 1024 : (size_t)(tok - NLAT) * 1024;
      const float* xs = (tok < NLAT ? sl : sc) + ro;
      float* xr = (tok < NLAT ? xl : xc) + ro;
      const int mr = tok_modrow(tok);
      const float* g = mod + mr * 3072 + 2048;
      float ss = 0.f;
      PairW pw;
#pragma unroll
      for (int fi = 0; fi < 4; ++fi) {
        const int f = f0 + fi * 16 + 4 * lq;
        float4 xv = *(const float4*)(xs + f);
        float4 gv = *(const float4*)(g + f);
        f32x4 v = acc[fi][ti];
        xv.x += gv.x * v[0]; xv.y += gv.y * v[1]; xv.z += gv.z * v[2]; xv.w += gv.w * v[3];
        *(float4*)(xr + f) = xv;
        if (xg) {
          ss += xv.x * xv.x + xv.y * xv.y + xv.z * xv.z + xv.w * xv.w;
          const float4 gg = *(const float4*)(gn + f), sn = *(const float4*)(modn + mr * 3072 + 1024 + f);
          pw.put(fi, xg + (size_t)tok * 1024 + f0, lq, xv.x * gg.x * (1.f + sn.x), xv.y * gg.y * (1.f + sn.y), xv.z * gg.z * (1.f + sn.z), xv.w * gg.w * (1.f + sn.w));
        }
      }
      if (xg) {
        ss = half_sum(rowpair_sum(ss));
        if (lq == 0) atomicAdd(rssn + tok, ss);
      }
    }
  }
};
struct PreNorm {
  const float* rss; const float* sw; int nf;
  template <int NTI> DI void apply(int f0, int t0, f32x4 (&acc)[4][NTI]) const {
    const int lane = otid() & 63, lr = lane & 15, lq = lane >> 4;
#pragma unroll
    for (int ti = 0; ti < NTI; ++ti) {
      const int tok = t0 + ti * 16 + lr;
      const float rstd = rsqrtf(rss[tok] * (1.f / 1024.f) + 1e-6f);
      const float* sr = sw + (size_t)tok_modrow(tok) * nf + f0 + 4 * lq;
#pragma unroll
      for (int fi = 0; fi < 4; ++fi) {
        const float4 sv = *(const float4*)(sr + fi * 16);
        acc[fi][ti][0] = acc[fi][ti][0] * rstd + sv.x; acc[fi][ti][1] = acc[fi][ti][1] * rstd + sv.y;
        acc[fi][ti][2] = acc[fi][ti][2] * rstd + sv.z; acc[fi][ti][3] = acc[fi][ti][3] * rstd + sv.w;
      }
    }
  }
};

struct EpiHyIn {
  bf16_t* ut;
  PreNorm pn;
  template <int NTI> DI void operator()(int f0, int t0, f32x4 (&acc)[4][NTI]) const {
    pn.apply(f0, t0, acc);
    const int lane = otid() & 63, lr = lane & 15, lq = lane >> 4;
    const bool gate = f0 >= 3072;
    static_assert(NTI == 2, "transposed pair store expects the 32-token sub-tile of the 8-phase GEMM body");
#pragma unroll
    for (int fi = 0; fi < 4; ++fi)
#pragma unroll
      for (int j = 0; j < 4; ++j) {
        const int f = f0 + fi * 16 + 4 * lq + j;
        float v0 = acc[fi][0][j], v1 = acc[fi][1][j];
        if (gate) { v0 = siluf(v0); v1 = siluf(v1); }
        tstore2<false>(ut + (size_t)f * NTOK + t0, lr, v0, v1);
      }
  }
};

struct EpiSwaIn {
  bf16_t *qs, *ks, *vt, *sg; const float2* rope;
  PreNorm pn;
  template <int NTI> DI void operator()(int f0, int t0, f32x4 (&acc)[4][NTI]) const {
    pn.apply(f0, t0, acc);
    const int lane = otid() & 63, lr = lane & 15, lq = lane >> 4;
    const float sc = 0.125f * LOG2E;
#pragma unroll
    for (int ti = 0; ti < NTI; ++ti) {
      const int tok = t0 + ti * 16 + lr;
      const int pos = tok & 4095;
      if (f0 < 1280) {
        const bool isq = f0 < 1024;
        const float s = isq ? sc : 1.f;
        bf16_t* dst = isq ? qs + (size_t)tok * 1024 + f0 : ks + (size_t)tok * 256 + (f0 - 1024);
        PairW p1, p2;
#pragma unroll
        for (int fi = 0; fi < 2; ++fi) {
          float o1[4], o2[4];
          const f32x4 rc01 = *(const f32x4*)(rope + pos * 32 + fi * 16 + 4 * lq), rc23 = *(const f32x4*)(rope + pos * 32 + fi * 16 + 4 * lq + 2);
#pragma unroll
          for (int j = 0; j < 4; ++j) {
            float x1 = acc[fi][ti][j], x2 = acc[fi + 2][ti][j];
            const float2 cs = make_float2(j == 0 ? rc01.x : j == 1 ? rc01.z : j == 2 ? rc23.x : rc23.z, j == 0 ? rc01.y : j == 1 ? rc01.w : j == 2 ? rc23.y : rc23.w);
            if (tok < NLAT) { o1[j] = (x1 * cs.x - x2 * cs.y) * s; o2[j] = (x1 * cs.y + x2 * cs.x) * s; }
            else { o1[j] = x1 * s; o2[j] = x2 * s; }
          }
          p1.put(fi, dst, lq, o1[0], o1[1], o1[2], o1[3]);
          p2.put(fi, dst + 32, lq, o2[0], o2[1], o2[2], o2[3]);
        }
      } else if (f0 < 1536) {
        if (ti == 0) {
          static_assert(NTI == 2, "transposed pair store expects the 32-token sub-tile of the 8-phase GEMM body");
          const int g = (f0 - 1280) >> 6;
          const int b = tok_batch(t0), key0 = tok_key(t0);
#pragma unroll
          for (int fi = 0; fi < 4; ++fi)
#pragma unroll
            for (int j = 0; j < 4; ++j) {
              const int dv = fi * 16 + 4 * lq + j;
              tstore2<true>(vt + ((size_t)(b * 4 + g) * 64 + dv) * KEYS + key0, lr, acc[fi][0][j], acc[fi][1][j]);
            }
        }
      } else {
        PairW pw;
        bf16_t* row64 = sg + (size_t)tok * 1024 + (f0 - 1536);
#pragma unroll
        for (int fi = 0; fi < 4; ++fi) {
          f32x4 v = acc[fi][ti];
          pw.put(fi, row64, lq, siluf(v[0]), siluf(v[1]), siluf(v[2]), siluf(v[3]));
        }
      }
    }
  }
};

struct EpiCfIn {
  bf16_t *u3, *sg;
  PreNorm pn;
  template <int NTI> DI void operator()(int f0, int t0, f32x4 (&acc)[4][NTI]) const {
    pn.apply(f0, t0, acc);
    const int lane = otid() & 63, lr = lane & 15, lq = lane >> 4;
#pragma unroll
    for (int ti = 0; ti < NTI; ++ti) {
      const int tok = t0 + ti * 16 + lr;
      if (f0 < 2048) {
        const int c0 = (f0 >> 6) * 32;
        PairW pw;
#pragma unroll
        for (int fi = 0; fi < 2; ++fi) {
          f32x4 a = acc[fi][ti], b = acc[fi + 2][ti];
          pw.put(fi, u3 + (size_t)tok * 1024 + c0, lq, a[0] * sigmf(b[0]), a[1] * sigmf(b[1]), a[2] * sigmf(b[2]), a[3] * sigmf(b[3]));
        }
      } else {
        PairW pw;
        bf16_t* row64 = sg + (size_t)tok * 1024 + (f0 - 2048);
#pragma unroll
        for (int fi = 0; fi < 4; ++fi) {
          f32x4 v = acc[fi][ti];
          pw.put(fi, row64, lq, siluf(v[0]), siluf(v[1]), siluf(v[2]), siluf(v[3]));
        }
      }
    }
  }
};

template <int MODE>
DI void transpose_w(const float* __restrict__ src, int K, int N, bf16_t* __restrict__ dst, char* smem, const float* __restrict__ kscale = nullptr) {
  float* tile = (float*)smem;
  const int tid = otid();
  const int nkt = K / 64, nnt = N / 64;
  for (int t = blockIdx.x; t < nkt * nnt; t += gridDim.x) {
    const int k0 = (t % nkt) * 64, n0 = (t / nkt) * 64;
    __syncthreads();
#pragma unroll
    for (int i = 0; i < 8; ++i) {
      const int e = tid + NT * i, kk = e >> 6, nn = e & 63;
      tile[kk * 65 + nn] = src[(size_t)(k0 + kk) * N + n0 + nn] * (kscale ? kscale[k0 + kk] : 1.f);
    }
    __syncthreads();
    const int nn = tid >> 3, kc = tid & 7;
    int n = n0 + nn;
    if (MODE == 1) {
      if (n < 1024) n = (n >> 5) * 64 + (n & 31);
      else if (n < 2048) { const int c = n - 1024; n = (c >> 5) * 64 + 32 + (c & 31); }
    }
    uint4 v;
    v.x = pack2(tile[(kc * 8 + 0) * 65 + nn], tile[(kc * 8 + 1) * 65 + nn]);
    v.y = pack2(tile[(kc * 8 + 2) * 65 + nn], tile[(kc * 8 + 3) * 65 + nn]);
    v.z = pack2(tile[(kc * 8 + 4) * 65 + nn], tile[(kc * 8 + 5) * 65 + nn]);
    v.w = pack2(tile[(kc * 8 + 6) * 65 + nn], tile[(kc * 8 + 7) * 65 + nn]);
    *(uint4*)(dst + (size_t)n * K + k0 + kc * 8) = v;
  }
  __syncthreads();
}

DI void phase0(const P& p, char* smem) {
  const int tid = otid(), lane = tid & 63, wave = tid >> 6;
  unsigned char* ws = p.ws;
  transpose_w<0>(p.in[8], 1024, 1728, (bf16_t*)(ws + O_W_MLA_IN), smem);
  for (size_t i = (size_t)blockIdx.x * NT + tid; i < (size_t)64 * 1024 / 2; i += (size_t)gridDim.x * NT)
    ((unsigned*)(ws + O_W_MLA_IN + (size_t)1728 * 1024 * 2))[i] = 0u;
  transpose_w<0>(p.in[11], 384, 1536, (bf16_t*)(ws + O_W_UQ), smem, p.in[9]);
  transpose_w<0>(p.in[12], 256, 2048, (bf16_t*)(ws + O_W_UKV), smem, p.in[10]);
  for (int i = blockIdx.x * NT + tid; i < 5 * NTOK; i += gridDim.x * NT) ((float*)(ws + O_RSS))[i] = 0.f;
  transpose_w<0>(p.in[13], 1024, 1024, (bf16_t*)(ws + O_W_MLA_OUT), smem);
  transpose_w<0>(p.in[14], 1024, 4096, (bf16_t*)(ws + O_W_HY_IN), smem);
  transpose_w<0>(p.in[23], 1024, 1024, (bf16_t*)(ws + O_W_HY_OUT), smem);
  transpose_w<0>(p.in[24], 1024, 2560, (bf16_t*)(ws + O_W_SWA_IN), smem);
  transpose_w<0>(p.in[26], 1024, 1024, (bf16_t*)(ws + O_W_SWA_OUT), smem);
  transpose_w<1>(p.in[27], 1024, 3072, (bf16_t*)(ws + O_W_CF_IN), smem);
  transpose_w<0>(p.in[32], 1024, 1024, (bf16_t*)(ws + O_W_CF_OUT), smem);
  {
    float* sS = (float*)smem;
    float* red = sS + 5 * 1024;
    __syncthreads();
    for (int i = tid; i < 5 * 1024; i += NT) {
      const int r = i >> 10, k = i & 1023;
      const float v = r < 4 ? p.in[1][r * 1024 + k] : p.in[3][k];
      sS[i] = siluf(v);
    }
    __syncthreads();
    float* mod = (float*)(ws + O_MOD);
    for (int it = blockIdx.x; it < 4 * 48; it += gridDim.x) {
      const int layer = it / 48, col = (it % 48) * 64 + lane;
      const float* w = p.in[5] + ((size_t)layer * 1024 + wave * 128) * 3072 + col;
      float a0 = 0, a1 = 0, a2 = 0, a3 = 0, a4 = 0;
#pragma unroll 8
      for (int k = 0; k < 128; ++k) {
        const float wv = w[(size_t)k * 3072];
        const int kk = wave * 128 + k;
        a0 += sS[kk] * wv; a1 += sS[1024 + kk] * wv; a2 += sS[2048 + kk] * wv; a3 += sS[3072 + kk] * wv; a4 += sS[4096 + kk] * wv;
      }
      red[(wave * 5 + 0) * 64 + lane] = a0; red[(wave * 5 + 1) * 64 + lane] = a1; red[(wave * 5 + 2) * 64 + lane] = a2;
      red[(wave * 5 + 3) * 64 + lane] = a3; red[(wave * 5 + 4) * 64 + lane] = a4;
      __syncthreads();
      if (tid < 320) {
        const int r = tid >> 6, c = tid & 63;
        float s = 0;
#pragma unroll
        for (int w8 = 0; w8 < 8; ++w8) s += red[(w8 * 5 + r) * 64 + c];
        const int cc = (it % 48) * 64 + c;
        mod[(layer * 5 + r) * 3072 + cc] = s + p.in[6][layer * 3072 + cc];
      }
      __syncthreads();
    }
  }
  {
    float2* rope = (float2*)(ws + O_ROPE);
    for (int i = blockIdx.x * NT + tid; i < 4096 * 32; i += gridDim.x * NT) {
      const int pos = i >> 5, d = i & 31;
      const float inv = exp2f(-(float)(d & 15) * (13.287712379549449f / 16.f));
      const float ang = (float)(d < 16 ? (pos >> 6) : (pos & 63)) * inv;
      float s, c; sincosf(ang, &s, &c);
      rope[i] = make_float2(c, s);
    }
  }
  {
    float* swin = (float*)smem;
    float* swh = swin + 33 * 64;
    float* shall = swh + 2 * 64 * 64;
    float* sh = shall + wave * 64;
    const float* fb = p.in[19];
    const float* ff = p.in[20];
    __syncthreads();
    for (int i = tid; i < 33 * 64; i += NT) swin[i] = p.in[17][i];
    for (int i = tid; i < 2 * 64 * 64; i += NT) swh[i] = p.in[18][i];
    __syncthreads();
    const float f0 = ff[lane], f1 = ff[64 + lane], f2 = ff[128 + lane], b0 = fb[lane], b1 = fb[64 + lane], b2 = fb[128 + lane];
    for (int item = blockIdx.x * 8 + wave; item < SEQ + LCTX; item += gridDim.x * 8) {
      const bool isc = item >= SEQ;
      const int t = isc ? item - SEQ : item;
      const int Lf = isc ? LCTX : SEQ;
      const float tl = (float)t / (float)(Lf - 1);
      const float wpos = (6.283185307179586f / (float)Lf) * (float)t;
      float e = 0.f;
      if (lane == 0) e = tl;
      else if (lane < 33) {
        const int kb = (lane - 1) & 15;
        const float band = 1e-4f + (float)kb * ((15.f - 1e-4f) / 15.f);
        const float a = band * wpos;
        e = lane < 17 ? cosf(a) : -sinf(a);
      }
      sh[lane] = e;
      __builtin_amdgcn_wave_barrier();
      float acc = 0.f;
#pragma unroll 11
      for (int i = 0; i < 33; ++i) acc += sh[i] * swin[i * 64 + lane];
      float hv = sinf(f0 * (acc + b0));
      __builtin_amdgcn_wave_barrier();
      sh[lane] = hv;
      __builtin_amdgcn_wave_barrier();
      acc = 0.f;
#pragma unroll 16
      for (int i = 0; i < 64; ++i) acc += sh[i] * swh[i * 64 + lane];
      hv = sinf(f1 * (acc + b1));
      __builtin_amdgcn_wave_barrier();
      sh[lane] = hv;
      __builtin_amdgcn_wave_barrier();
      acc = 0.f;
#pragma unroll 16
      for (int i = 0; i < 64; ++i) acc += sh[i] * swh[4096 + i * 64 + lane];
      hv = sinf(f2 * (acc + b2));
      __builtin_amdgcn_wave_barrier();
      if (isc) ((float*)(ws + O_HDNC))[lane * LCTX + t] = hv;
      else { ((float*)(ws + O_HDN))[lane * SEQ + t] = hv; ((bf16_t*)(ws + O_HDNB))[t * 64 + lane] = f2bf(hv); }
    }
    __syncthreads();
  }
}

DI void phase_shiftw(const P& p, char* smem) {
  const int tid = otid(), lane = tid & 63, wave = tid >> 6;
  float* sS = (float*)smem;
  float* red = sS + 5 * 1024;
  const float* mod = (const float*)(p.ws + O_MOD);
  float* sw = (float*)(p.ws + O_SW);
  int cur = -1;
  for (int it = blockIdx.x; it < 64 + 40 + 48; it += gridDim.x) {
    const int L = it < 64 ? 1 : (it < 104 ? 2 : 3);
    const int chunk = it < 64 ? it : (it < 104 ? it - 64 : it - 104);
    const int N = L == 1 ? 4096 : (L == 2 ? 2560 : 3072);
    const float* W = L == 1 ? p.in[14] : (L == 2 ? p.in[24] : p.in[27]);
    float* out = sw + (L == 1 ? 0 : (L == 2 ? 5 * 4096 : 5 * (4096 + 2560)));
    __syncthreads();
    if (cur != L) {
      for (int i = tid; i < 5 * 1024; i += NT) sS[i] = mod[(L * 5 + (i >> 10)) * 3072 + (i & 1023)];
      cur = L;
    }
    __syncthreads();
    const int col = chunk * 64 + lane;
    const float* w = W + (size_t)(wave * 128) * N + col;
    float a0 = 0, a1 = 0, a2 = 0, a3 = 0, a4 = 0;
#pragma unroll 8
    for (int k = 0; k < 128; ++k) {
      const float wv = w[(size_t)k * N];
      const int kk = wave * 128 + k;
      a0 += sS[kk] * wv; a1 += sS[1024 + kk] * wv; a2 += sS[2048 + kk] * wv; a3 += sS[3072 + kk] * wv; a4 += sS[4096 + kk] * wv;
    }
    red[(wave * 5 + 0) * 64 + lane] = a0; red[(wave * 5 + 1) * 64 + lane] = a1; red[(wave * 5 + 2) * 64 + lane] = a2;
    red[(wave * 5 + 3) * 64 + lane] = a3; red[(wave * 5 + 4) * 64 + lane] = a4;
    __syncthreads();
    if (tid < 320) {
      const int r = tid >> 6, c = tid & 63;
      float sum = 0;
#pragma unroll
      for (int w8 = 0; w8 < 8; ++w8) sum += red[(w8 * 5 + r) * 64 + c];
      int n = chunk * 64 + c;
      if (L == 3) {
        if (n < 1024) n = (n >> 5) * 64 + (n & 31);
        else if (n < 2048) { const int cc = n - 1024; n = (cc >> 5) * 64 + 32 + (cc & 31); }
      }
      out[r * N + n] = sum;
    }
  }
  __syncthreads();
}

DI void phase_norm(const P& p, int layer, int ntok) {
  const int lane = otid() & 63, wave = otid() >> 6;
  const float* xc = layer == 0 ? p.in[2] : (const float*)(p.ws + O_XC);
  const float* xlat = layer == 0 ? p.in[0] : p.out;
  const float* mod = (const float*)(p.ws + O_MOD) + layer * 5 * 3072;
  const float* g = p.in[4] + layer * 1024;
  bf16_t* act = (bf16_t*)(p.ws + O_ACT);
  for (int row0 = (blockIdx.x * 8 + wave) * 4; row0 < ntok; row0 += gridDim.x * 32) {
    f32x4 v[4][4];
#pragma unroll
    for (int r = 0; r < 4; ++r) {
      const int row = row0 + r;
      const float* x = row < NLAT ? xlat + (size_t)row * 1024 : xc + (size_t)(row - NLAT) * 1024;
#pragma unroll
      for (int i = 0; i < 4; ++i) v[r][i] = ((const f32x4*)x)[lane + 64 * i];
    }
    const float* m = mod + tok_modrow(row0) * 3072;
#pragma unroll
    for (int r = 0; r < 4; ++r) {
      float ss = 0.f;
#pragma unroll
      for (int i = 0; i < 4; ++i) ss += v[r][i].x * v[r][i].x + v[r][i].y * v[r][i].y + v[r][i].z * v[r][i].z + v[r][i].w * v[r][i].w;
      ss = wave_sum(ss);
      const float rstd = rsqrtf(ss * (1.f / 1024.f) + 1e-6f);
#pragma unroll
      for (int i = 0; i < 4; ++i) {
        const int c = (lane + 64 * i) * 4;
        const f32x4 gv = *(const f32x4*)(g + c), sh = *(const f32x4*)(m + c), sc = *(const f32x4*)(m + 1024 + c);
        store4bf(act + (size_t)(row0 + r) * 1024 + c, v[r][i].x * rstd * gv.x * (1.f + sc.x) + sh.x, v[r][i].y * rstd * gv.y * (1.f + sc.y) + sh.y,
                 v[r][i].z * rstd * gv.z * (1.f + sc.z) + sh.z, v[r][i].w * rstd * gv.w * (1.f + sc.w) + sh.w);
      }
    }
  }
}

template <int PER>
DI void small_norm(bf16_t* buf, const float* g) {
  const int lane = otid() & 63, wave = otid() >> 6;
  for (int row = blockIdx.x * 8 + wave; row < NTOK; row += gridDim.x * 8) {
    bf16_t* r = buf + (size_t)row * (64 * PER);
    float v[PER]; float ss = 0.f;
#pragma unroll
    for (int i = 0; i < PER; ++i) { v[i] = bf2f(r[lane + 64 * i]); ss += v[i] * v[i]; }
    ss = wave_sum(ss);
    const float rstd = rsqrtf(ss / (float)(64 * PER) + 1e-6f);
#pragma unroll
    for (int i = 0; i < PER; ++i) r[lane + 64 * i] = f2bf(v[i] * rstd * g[lane + 64 * i]);
  }
}

DI void phase_final(const P& p) {
  const int lane = otid() & 63, wave = otid() >> 6;
  const float* g = p.in[7];
  for (int row = blockIdx.x * 8 + wave; row < NLAT; row += gridDim.x * 8) {
    float* x = p.out + (size_t)row * 1024;
    f32x4 v[4]; float ss = 0.f;
#pragma unroll
    for (int i = 0; i < 4; ++i) { v[i] = ((const f32x4*)x)[lane + 64 * i]; ss += v[i].x * v[i].x + v[i].y * v[i].y + v[i].z * v[i].z + v[i].w * v[i].w; }
    ss = wave_sum(ss);
    const float rstd = rsqrtf(ss * (1.f / 1024.f) + 1e-6f);
#pragma unroll
    for (int i = 0; i < 4; ++i) {
      const int c = (lane + 64 * i) * 4;
      const float4 gv = *(const float4*)(g + c);
      float4 o; o.x = v[i].x * rstd * gv.x; o.y = v[i].y * rstd * gv.y; o.z = v[i].z * rstd * gv.z; o.w = v[i].w * rstd * gv.w;
      ((float4*)x)[lane + 64 * i] = o;
    }
  }
}

struct AttnItem {
  const bf16_t* Kbase; int kld;
  const bf16_t* Vt;
  int b; int a0, n1, n2;
  const bf16_t* Q; int qld;
  int qtok0; int qpos0;
  float minit, linit;
  bf16_t* og; int ocol;
  bool dry;
};

template <int DQK, int DV, bool MASK>
DI void attn_item(const AttnItem& a, char* smem) {
  constexpr int NKS = DQK / 32, NDB = DV / 16;
  constexpr int KBYTES = 64 * DQK * 2, VBYTES = DV * 64 * 2, STG = KBYTES + VBYTES;
  constexpr int KCH = KBYTES / 8192, VCH = VBYTES / 8192;
  const int tid = otid(), lane = tid & 63, lr = lane & 15, lq = lane >> 4;
  bf16x8 qf[2][NKS];
#pragma unroll
  for (int nb = 0; nb < 2; ++nb)
#pragma unroll
    for (int ks = 0; ks < NKS; ++ks) qf[nb][ks] = *(const bf16x8*)(a.Q + (size_t)(nb * 16 + lr) * a.qld + ks * 32 + lq * 8);
  f32x4 o[NDB][2];
#pragma unroll
  for (int i = 0; i < NDB; ++i) { o[i][0] = (f32x4){0.f, 0.f, 0.f, 0.f}; o[i][1] = (f32x4){0.f, 0.f, 0.f, 0.f}; }
  float m[2] = {a.minit, a.minit};
  float l[2] = {lq == 0 ? a.linit : 0.f, lq == 0 ? a.linit : 0.f};
  int kR[KCH], kC[KCH], vOff[VCH];
#pragma unroll
  for (int c = 0; c < KCH; ++c) {
    const int bb = tid * 16 + c * 8192, st = bb >> 10, sb = bb & 1023, swz = sb ^ (((sb >> 9) & 1) << 5);
    kR[c] = (st / NKS) * 16 + (swz >> 6); kC[c] = (st % NKS) * 32 + ((swz & 63) >> 1);
  }
#pragma unroll
  for (int c = 0; c < VCH; ++c) {
    const int bb = tid * 16 + c * 8192, st = bb >> 10, sb = bb & 1023, swz = sb ^ (((sb >> 9) & 1) << 5);
    vOff[c] = ((st >> 1) * 16 + (swz >> 6)) * KEYS + (st & 1) * 32 + ((swz & 63) >> 1);
  }
  const int ntile = a.n1 + a.n2;
#define ATT_STAGE(buf, i)                                                                                     \
  {                                                                                                           \
    const int kt_ = (i) < a.n1 ? a.a0 + (i) : 64 + ((i) - a.n1);                                              \
    const int key0_ = kt_ * 64;                                                                               \
    const int tokb_ = key0_ < SEQ ? a.b * SEQ + key0_ : NLAT + a.b * LCTX + (key0_ - SEQ);                    \
    char* sb_ = smem + (buf) * STG + tid * 16;                                                                \
    _Pragma("unroll") for (int c = 0; c < KCH; ++c)                                                           \
      __builtin_amdgcn_global_load_lds((const unsigned*)(a.Kbase + (size_t)(tokb_ + kR[c]) * a.kld + kC[c]),  \
                                       (__attribute__((address_space(3))) unsigned*)(sb_ + c * 8192), 16, 0, 0); \
    _Pragma("unroll") for (int c = 0; c < VCH; ++c)                                                           \
      __builtin_amdgcn_global_load_lds((const unsigned*)(a.Vt + vOff[c] + key0_),                             \
                                       (__attribute__((address_space(3))) unsigned*)(sb_ + KBYTES + c * 8192), 16, 0, 0); \
  }
  const int ob = lr * 64 + lq * 16;
  const int lane_off = ob ^ (((ob >> 9) & 1) << 5);
  __syncthreads();
  ATT_STAGE(0, 0);
  for (int it = 0; it < ntile; ++it) {
    asm volatile("s_waitcnt vmcnt(0)" ::: "memory");
    __builtin_amdgcn_s_barrier();
    if (it + 1 < ntile) ATT_STAGE((it + 1) & 1, it + 1);
    const char* sK = smem + (it & 1) * STG + lane_off;
    const char* sV = sK + KBYTES;
    f32x4 s[4][2];
#pragma unroll
    for (int kb = 0; kb < 4; ++kb) { s[kb][0] = (f32x4){0.f, 0.f, 0.f, 0.f}; s[kb][1] = (f32x4){0.f, 0.f, 0.f, 0.f}; }
#pragma unroll
    for (int ks = 0; ks < NKS; ++ks)
#pragma unroll
      for (int kb = 0; kb < 4; ++kb) {
        const bf16x8 kf = *(const bf16x8*)(sK + (kb * NKS + ks) * 1024);
        s[kb][0] = mfma16(kf, qf[0][ks], s[kb][0]);
        s[kb][1] = mfma16(kf, qf[1][ks], s[kb][1]);
      }
    if (MASK) {
      const int kt = it < a.n1 ? a.a0 + it : 64;
      const int dq = kt - (a.qpos0 >> 6);
      if (kt < 64 && (dq <= -2 || dq >= 2)) {
#pragma unroll
        for (int nb = 0; nb < 2; ++nb) {
          const int qp = a.qpos0 + nb * 16 + lr;
#pragma unroll
          for (int kb = 0; kb < 4; ++kb)
#pragma unroll
            for (int j = 0; j < 4; ++j) {
              const int kp = kt * 64 + kb * 16 + 4 * lq + j;
              const int dlt = kp - qp;
              if (dlt > 128 || dlt < -128) s[kb][nb][j] = -INFINITY;
            }
        }
      }
    }
    bf16x8 pf[2][2];
#pragma unroll
    for (int nb = 0; nb < 2; ++nb) {
      float mx = -INFINITY;
#pragma unroll
      for (int kb = 0; kb < 4; ++kb)
#pragma unroll
        for (int j = 0; j < 4; ++j) mx = fmaxf(mx, s[kb][nb][j]);
      mx = half_max(rowpair_max(mx));
      const float mn = fmaxf(m[nb], mx);
      const float alpha = __builtin_amdgcn_exp2f(m[nb] - mn);
      m[nb] = mn;
      float rs = 0.f;
      float pv[4][4];
#pragma unroll
      for (int kb = 0; kb < 4; ++kb)
#pragma unroll
        for (int j = 0; j < 4; ++j) { pv[kb][j] = __builtin_amdgcn_exp2f(s[kb][nb][j] - mn); rs += pv[kb][j]; }
      l[nb] = l[nb] * alpha + rs;
#pragma unroll
      for (int st = 0; st < 2; ++st) {
        u32x4 u;
        u.x = pack2(pv[2 * st][0], pv[2 * st][1]); u.y = pack2(pv[2 * st][2], pv[2 * st][3]);
        u.z = pack2(pv[2 * st + 1][0], pv[2 * st + 1][1]); u.w = pack2(pv[2 * st + 1][2], pv[2 * st + 1][3]);
        pf[nb][st] = __builtin_bit_cast(bf16x8, u);
      }
      if (__builtin_amdgcn_ballot_w64(alpha != 1.f) != 0ull) {
#pragma unroll
        for (int db = 0; db < NDB; ++db) { o[db][nb][0] *= alpha; o[db][nb][1] *= alpha; o[db][nb][2] *= alpha; o[db][nb][3] *= alpha; }
      }
    }
#pragma unroll
    for (int st = 0; st < 2; ++st)
#pragma unroll
      for (int db = 0; db < NDB; ++db) {
        const bf16x8 vf = *(const bf16x8*)(sV + (db * 2 + st) * 1024);
        o[db][0] = mfma16(vf, pf[0][st], o[db][0]);
        o[db][1] = mfma16(vf, pf[1][st], o[db][1]);
      }
  }
#undef ATT_STAGE
  if (a.dry) return;
#pragma unroll
  for (int nb = 0; nb < 2; ++nb) {
    float lt = l[nb];
    lt = half_sum(rowpair_sum(lt));
    const float inv = 1.f / lt;
    const int tok = a.qtok0 + nb * 16 + lr;
    uint2 gg[NDB];
#pragma unroll
    for (int db = 0; db < NDB; ++db) gg[db] = *(const uint2*)(a.og + (size_t)tok * 1024 + a.ocol + db * 16 + 4 * lq);
    PairW pw;
#pragma unroll
    for (int db = 0; db < NDB; ++db) {
      const uint2 g = gg[db];
      const float g0 = __uint_as_float(g.x << 16), g1 = __uint_as_float(g.x & 0xffff0000u);
      const float g2 = __uint_as_float(g.y << 16), g3 = __uint_as_float(g.y & 0xffff0000u);
      pw.put(db & 1, a.og + (size_t)tok * 1024 + a.ocol + (db & ~1) * 16, lq, o[db][nb][0] * inv * g0, o[db][nb][1] * inv * g1, o[db][nb][2] * inv * g2, o[db][nb][3] * inv * g3);
    }
  }
}

DI void phase_mla_attn(const P& p, char* smem, bool dry) {
  const int wave = otid() >> 6;
  const bf16_t* q = (const bf16_t*)(p.ws + O_Q);
  const bf16_t* kp = (const bf16_t*)(p.ws + O_KP);
  const bf16_t* vt = (const bf16_t*)(p.ws + O_ACT);
  bf16_t* og = (bf16_t*)(p.ws + O_SG0);
  const int xcd = blockIdx.x & 7, lb = blockIdx.x >> 3, nlb = (gridDim.x - xcd + 7) >> 3;
  for (int li = lb; li < 68; li += nlb) {
    AttnItem a;
    int b, h, qtok;
    if (li < 64) { const int pair = (li >> 4) * 8 + xcd; b = pair >> 3; h = pair & 7; qtok = b * SEQ + (li & 15) * 256; a.a0 = 0; a.n1 = 64; }
    else { const int pair = (li - 64) * 8 + xcd; b = pair >> 3; h = pair & 7; qtok = NLAT + b * LCTX; a.a0 = 0; a.n1 = 0; }
    a.n2 = 4; a.b = b;
    a.Kbase = kp + h * 192; a.kld = 1536;
    a.Vt = vt + (size_t)(b * 8 + h) * 128 * KEYS;
    a.qtok0 = qtok + wave * 32; a.qpos0 = 0;
    a.Q = q + (size_t)a.qtok0 * 1536 + h * 192; a.qld = 1536;
    a.minit = -INFINITY; a.linit = 0.f;
    a.og = og; a.ocol = h * 128; a.dry = dry;
    attn_item<192, 128, false>(a, smem);
  }
}

DI void phase_swa_attn(const P& p, char* smem, bool dry) {
  const int wave = otid() >> 6;
  const bf16_t* qs = (const bf16_t*)(p.ws + O_QS);
  const bf16_t* ks = (const bf16_t*)(p.ws + O_KS);
  const bf16_t* vt = (const bf16_t*)(p.ws + O_VT2);
  bf16_t* og = (bf16_t*)(p.ws + O_SG2);
  const float* sink = p.in[25];
  for (int it = blockIdx.x; it < 1024; it += gridDim.x) {
    AttnItem a;
    int b, g, qtok, pos0;
    if (it < 1024) {
      b = it >> 8; g = (it >> 6) & 3; const int qb = it & 63;
      pos0 = qb * 64; qtok = b * SEQ + pos0;
      a.a0 = qb - 2 < 0 ? 0 : qb - 2; const int a1 = qb + 3 > 64 ? 64 : qb + 3; a.n1 = a1 - a.a0;
    } else {
      const int j = it - 1024; b = j >> 4; g = (j >> 2) & 3; pos0 = (j & 3) * 64; qtok = NLAT + b * LCTX + pos0;
      a.a0 = 0; a.n1 = 0;
    }
    const int head = g * 4 + (wave >> 1);
    a.n2 = 4; a.b = b;
    a.Kbase = ks + g * 64; a.kld = 256;
    a.Vt = vt + (size_t)(b * 4 + g) * 64 * KEYS;
    a.qtok0 = qtok + (wave & 1) * 32; a.qpos0 = pos0 + (wave & 1) * 32;
    a.Q = qs + (size_t)a.qtok0 * 1024 + head * 64; a.qld = 1024;
    a.minit = sink[head] * LOG2E; a.linit = 1.f;
    a.og = og; a.ocol = head * 64; a.dry = dry;
    attn_item<64, 64, true>(a, smem);
  }
}

typedef f32x2 c32;
DI c32 cmul(c32 a, c32 b) { return (c32){a.x * b.x - a.y * b.y, a.x * b.y + a.y * b.x}; }
DI c32 cmulc(c32 a, c32 b) { return (c32){a.x * b.x + a.y * b.y, a.y * b.x - a.x * b.y}; }
DI int phys(int i) { return i + (i >> 5); }
DI c32 w16(int k) {
  const float c1 = 0.9238795325112867f, s1 = 0.3826834323650898f, r = 0.7071067811865476f;
  switch (k & 7) {
    case 0: return (c32){1.f, 0.f};
    case 1: return (c32){c1, -s1};
    case 2: return (c32){r, -r};
    case 3: return (c32){s1, -c1};
    case 4: return (c32){0.f, -1.f};
    case 5: return (c32){-s1, -c1};
    case 6: return (c32){-r, -r};
    default: return (c32){-c1, -s1};
  }
}
DI c32 w16g(int m) {
  const c32 w = w16(m & 7);
  return (m & 8) ? (c32){-w.x, -w.y} : w;
}
template <bool ZHI>
DI void r4_fwd(c32& x0, c32& x1, c32& x2, c32& x3, c32 t1, c32 t2, c32 t3) {
  const c32 s02 = ZHI ? x0 : x0 + x2, s13 = ZHI ? x1 : x1 + x3, d02 = ZHI ? x0 : x0 - x2, d13 = ZHI ? x1 : x1 - x3;
  const c32 e = (c32){d13.y, -d13.x};
  x0 = s02 + s13; x1 = cmul(s02 - s13, t1); x2 = cmul(d02 + e, t2); x3 = cmul(d02 - e, t3);
}
template <bool LOONLY>
DI void r4_inv(c32& x0, c32& x1, c32& x2, c32& x3, c32 t1, c32 t2, c32 t3) {
  const c32 p1 = cmulc(x1, t1), p2 = cmulc(x2, t2), p3 = cmulc(x3, t3);
  const c32 a = x0 + p1, b = x0 - p1, c = p2 + p3, dd = p2 - p3;
  const c32 d = (c32){-dd.y, dd.x};
  x0 = a + c; x1 = b + d;
  if (!LOONLY) { x2 = a - c; x3 = b - d; }
}
template <bool ZHI>
DI void fft16_fwd2(c32 (&v0)[16], c32 (&v1)[16], c32 w1) {
  const c32 w2 = cmul(w1, w1), w3 = cmul(w1, w2), w4 = cmul(w2, w2), w8 = cmul(w4, w4), w48 = cmul(w4, w8);
#pragma unroll
  for (int k = 0; k < 4; ++k) {
    const c32 tB = k ? cmul(w2, w16g(2 * k)) : w2, tA = k ? cmul(w1, w16g(k)) : w1, tAB = k ? cmul(w3, w16g(3 * k)) : w3;
    r4_fwd<ZHI>(v0[k], v0[k + 4], v0[k + 8], v0[k + 12], tB, tA, tAB);
    r4_fwd<ZHI>(v1[k], v1[k + 4], v1[k + 8], v1[k + 12], tB, tA, tAB);
  }
#pragma unroll
  for (int q = 0; q < 16; q += 4) {
    r4_fwd<false>(v0[q], v0[q + 1], v0[q + 2], v0[q + 3], w8, w4, w48);
    r4_fwd<false>(v1[q], v1[q + 1], v1[q + 2], v1[q + 3], w8, w4, w48);
  }
}
template <bool LOONLY>
DI void fft16_inv2(c32 (&v0)[16], c32 (&v1)[16], c32 w1) {
  const c32 w2 = cmul(w1, w1), w3 = cmul(w1, w2), w4 = cmul(w2, w2), w8 = cmul(w4, w4), w48 = cmul(w4, w8);
#pragma unroll
  for (int q = 0; q < 16; q += 4) {
    r4_inv<false>(v0[q], v0[q + 1], v0[q + 2], v0[q + 3], w8, w4, w48);
    r4_inv<false>(v1[q], v1[q + 1], v1[q + 2], v1[q + 3], w8, w4, w48);
  }
#pragma unroll
  for (int k = 0; k < 4; ++k) {
    const c32 tB = k ? cmul(w2, w16g(2 * k)) : w2, tA = k ? cmul(w1, w16g(k)) : w1, tAB = k ? cmul(w3, w16g(3 * k)) : w3;
    r4_inv<LOONLY>(v0[k], v0[k + 4], v0[k + 8], v0[k + 12], tB, tA, tAB);
    r4_inv<LOONLY>(v1[k], v1[k + 4], v1[k + 8], v1[k + 12], tB, tA, tAB);
  }
}
template <int H, bool INV, bool PRUNE>
DI void fft_pass16(c32* X0, c32* X1) {
  constexpr int ST = H / 16;
  const int tid = otid();
  const int jb = tid & (ST - 1), base = (tid / ST) * H + jb;
  c32 v0[16], v1[16];
  constexpr int NLD = (PRUNE && !INV) ? 8 : 16, NSTR = (PRUNE && INV) ? 8 : 16;
#pragma unroll
  for (int k = 0; k < NLD; ++k) { v0[k] = X0[phys(base + k * ST)]; v1[k] = X1[phys(base + k * ST)]; }
#pragma unroll
  for (int k = NLD; k < 16; ++k) { v0[k] = (c32){0.f, 0.f}; v1[k] = (c32){0.f, 0.f}; }
  const float fr = (float)jb * (1.f / (float)H);
  const c32 w1 = (c32){__builtin_amdgcn_cosf(fr), -__builtin_amdgcn_sinf(fr)};
  if (INV) fft16_inv2<PRUNE>(v0, v1, w1); else fft16_fwd2<PRUNE>(v0, v1, w1);
#pragma unroll
  for (int k = 0; k < NSTR; ++k) { X0[phys(base + k * ST)] = v0[k]; X1[phys(base + k * ST)] = v1[k]; }
  __syncthreads();
}
DI void fft_pass2(c32* X0, c32* X1) {
  const int tid = otid();
#pragma unroll
  for (int i = 0; i < 8; ++i) {
    const int i0 = phys(2 * (tid + NT * i));
    const c32 a = X0[i0], b = X0[i0 + 1], c = X1[i0], d = X1[i0 + 1];
    X0[i0] = a + b; X0[i0 + 1] = a - b; X1[i0] = c + d; X1[i0 + 1] = c - d;
  }
  __syncthreads();
}
template <bool PRUNE>
DI void fft_fwd(c32* X0, c32* X1) { fft_pass16<8192, false, PRUNE>(X0, X1); fft_pass16<512, false, false>(X0, X1); fft_pass16<32, false, false>(X0, X1); fft_pass2(X0, X1); }
DI void fft_conv(c32* X0, c32* X1, const c32* __restrict__ Ks) {
  fft_pass16<8192, false, true>(X0, X1); fft_pass16<512, false, false>(X0, X1); fft_pass16<32, false, false>(X0, X1);
  {
    const int tid = otid();
#pragma unroll
    for (int i = 0; i < 8; ++i) {
      const int mm = tid + NT * i, i0 = phys(2 * mm);
      const f32x4 kk = *(const f32x4*)(Ks + 2 * mm);
      const c32 k0 = (c32){kk.x, kk.y}, k1 = (c32){kk.z, kk.w};
      const c32 a = X0[i0], b = X0[i0 + 1], c = X1[i0], d = X1[i0 + 1];
      const c32 pa = cmul(a + b, k0), pb = cmul(a - b, k1), pc = cmul(c + d, k0), pd = cmul(c - d, k1);
      X0[i0] = pa + pb; X0[i0 + 1] = pa - pb; X1[i0] = pc + pd; X1[i0 + 1] = pc - pd;
    }
    __syncthreads();
  }
  fft_pass16<32, true, false>(X0, X1); fft_pass16<512, true, false>(X0, X1); fft_pass16<8192, true, true>(X0, X1);
}
DI void spec_mul(c32* X0, c32* X1, const c32* __restrict__ Ks) {
  const int tid = otid();
#pragma unroll 8
  for (int i = 0; i < 16; ++i) {
    const c32 k = Ks[tid + NT * i];
    const int n = phys(tid + NT * i);
    X0[n] = cmul(X0[n], k); X1[n] = cmul(X1[n], k);
  }
  __syncthreads();
}
DI float sconv(const bf16_t* u, int t, int len, float w0, float w1, float w2, float cb) {
  float r = cb + w1 * bf2f(u[t]);
  if (t > 0) r += w0 * bf2f(u[t - 1]);
  if (t + 1 < len) r += w2 * bf2f(u[t + 1]);
  return r;
}

DI void sconv8(const bf16_t* u, int t0, int len, float w0, float w1, float w2, float cb, float (&out)[8]) {
  const u32x4 raw = *(const u32x4*)(u + t0);
  float x[10];
  x[0] = t0 > 0 ? bf2f(u[t0 - 1]) : 0.f;
  x[9] = t0 + 8 < len ? bf2f(u[t0 + 8]) : 0.f;
#pragma unroll
  for (int i = 0; i < 4; ++i) { x[1 + 2 * i] = __uint_as_float(raw[i] << 16); x[2 + 2 * i] = __uint_as_float(raw[i] & 0xffff0000u); }
#pragma unroll
  for (int i = 0; i < 8; ++i) out[i] = cb + w0 * x[i] + w1 * x[i + 1] + w2 * x[i + 2];
}

DI void phase_hyena(const P& p, char* smem, float* aux, bool dry) {
  const int tid = otid();
  c32* X0 = (c32*)smem; c32* X1 = (c32*)(smem + 67584);
  bf16_t* ut = (bf16_t*)(p.ws + O_UT);
  const float* hdn = (const float*)(p.ws + O_HDN);
  const float* hdnc = (const float*)(p.ws + O_HDNC);
  c32* Ksp = (c32*)(p.ws + O_FFT + (size_t)blockIdx.x * 131072);
  const float* cw = p.in[15];
  const float* cbv = p.in[16];
  const float* fwo = p.in[21];
  const float* hb = p.in[22];
  for (int c = blockIdx.x; c < 1024; c += gridDim.x) {
    __syncthreads();
    { const int ta = otid(); if (ta < 256) aux[ta] = fwo[(size_t)(ta >> 2) * 4096 + (ta & 3) * 1024 + c]; }
    __syncthreads();
    const float la0 = -15.350567286626973f, la1 = -3.0701134573253945f;
    const float delta = fabsf(la0 + (la1 - la0) * ((float)c / 1023.f));
    const float bias0 = hb[c], bias1 = hb[1024 + c];
    float w0[3], w1[3], w2[3], cb[3];
#pragma unroll
    for (int r = 0; r < 3; ++r) { const int f = r * 1024 + c; w0[r] = cw[f]; w1[r] = cw[3072 + f]; w2[r] = cw[6144 + f]; cb[r] = cbv[f]; }
    const int t0 = tid * 8;
    {
      const int lane = tid & 63, wv = tid >> 6, lr = lane & 15, lq = lane >> 4;
      const bf16_t* hdnb = (const bf16_t*)(p.ws + O_HDNB);
      bf16x8 bfr[2];
#pragma unroll
      for (int ks = 0; ks < 2; ++ks) {
        u32x4 u;
#pragma unroll
        for (int e = 0; e < 4; ++e) {
          const int j0 = ks * 32 + lq * 8 + 2 * e;
          const float wa = lr < 4 ? aux[j0 * 4 + lr] : 0.f, wb = lr < 4 ? aux[(j0 + 1) * 4 + lr] : 0.f;
          u[e] = pack2(wa, wb);
        }
        bfr[ks] = __builtin_bit_cast(bf16x8, u);
      }
      const int o = (lr >> 1) & 1, dir = lr & 1;
      c32* Xo = o ? X1 : X0;
#pragma unroll 1
      for (int mb0 = 0; mb0 < 32; mb0 += 8) {
        bf16x8 a0[8], a1[8];
#pragma unroll
        for (int i = 0; i < 8; ++i) {
          const bf16_t* src = hdnb + (size_t)((wv * 32 + mb0 + i) * 16 + lr) * 64 + lq * 8;
          a0[i] = *(const bf16x8*)src; a1[i] = *(const bf16x8*)(src + 32);
        }
#pragma unroll
        for (int i = 0; i < 8; ++i) {
          f32x4 cc = (f32x4){0.f, 0.f, 0.f, 0.f};
          cc = mfma16(a0[i], bfr[0], cc);
          cc = mfma16(a1[i], bfr[1], cc);
#pragma unroll
          for (int j = 0; j < 4; ++j) {
            const int t = (wv * 32 + mb0 + i) * 16 + 4 * lq + j;
            const float val = cc[j] * __expf(-((float)t / 4095.f) * delta);
            const float partner = __shfl_xor(val, 1, 64);
            if (lr < 4) {
              if (t == 0) { if (dir == 0) Xo[0] = (c32){val + partner, 0.f}; else Xo[phys(4096)] = (c32){0.f, 0.f}; }
              else Xo[phys(dir ? 8192 - t : t)] = (c32){val, 0.f};
            }
          }
        }
      }
      __syncthreads();
      fft_fwd<false>(X0, X1);
#pragma unroll 4
      for (int i = 0; i < 16; ++i) { Ksp[tid + NT * i] = X0[phys(tid + NT * i)]; Ksp[8192 + tid + NT * i] = X1[phys(tid + NT * i)]; }
      __syncthreads();
    }
    const bf16_t* uv = ut + (size_t)c * NTOK;
    const bf16_t* ug0 = ut + (size_t)(1024 + c) * NTOK;
    const bf16_t* ug1 = ut + (size_t)(2048 + c) * NTOK;
    bf16_t* usg = ut + (size_t)(3072 + c) * NTOK;
    {
      float z[4][8], g[4][8];
#pragma unroll
      for (int bb = 0; bb < 4; ++bb) sconv8(uv + bb * SEQ, t0, SEQ, w0[0], w1[0], w2[0], cb[0], z[bb]);
#pragma unroll
      for (int i = 0; i < 8; ++i) {
        X0[phys(t0 + i)] = (c32){z[0][i], z[1][i]};
        X1[phys(t0 + i)] = (c32){z[2][i], z[3][i]};
      }
      __syncthreads();
      fft_conv(X0, X1, Ksp);
      const int t0b = otid() * 8;
#pragma unroll
      for (int bb = 0; bb < 4; ++bb) sconv8(ug0 + bb * SEQ, t0b, SEQ, w0[1], w1[1], w2[1], cb[1], g[bb]);
#pragma unroll
      for (int i = 0; i < 8; ++i) {
        const c32 y0 = X0[phys(t0b + i)], y1 = X1[phys(t0b + i)];
        z[0][i] = g[0][i] * (y0.x * (1.f / 8192.f) + z[0][i] * bias0);
        z[1][i] = g[1][i] * (y0.y * (1.f / 8192.f) + z[1][i] * bias0);
        z[2][i] = g[2][i] * (y1.x * (1.f / 8192.f) + z[2][i] * bias0);
        z[3][i] = g[3][i] * (y1.y * (1.f / 8192.f) + z[3][i] * bias0);
      }
      __syncthreads();
#pragma unroll
      for (int i = 0; i < 8; ++i) {
        X0[phys(t0b + i)] = (c32){z[0][i], z[1][i]};
        X1[phys(t0b + i)] = (c32){z[2][i], z[3][i]};
      }
      __syncthreads();
      fft_conv(X0, X1, Ksp + 8192);
      const int t0c = otid() * 8;
#pragma unroll
      for (int bb = 0; bb < 4; ++bb) sconv8(ug1 + bb * SEQ, t0c, SEQ, w0[2], w1[2], w2[2], cb[2], g[bb]);
#pragma unroll
      for (int bb = 0; bb < 4; ++bb) {
        const u32x4 sgv = *(const u32x4*)(usg + bb * SEQ + t0c);
        float oo[8];
#pragma unroll
        for (int i = 0; i < 8; ++i) {
          const c32 y = (bb < 2) ? X0[phys(t0c + i)] : X1[phys(t0c + i)];
          const float yy = (bb & 1) ? y.y : y.x;
          const float zz = g[bb][i] * (yy * (1.f / 8192.f) + z[bb][i] * bias1);
          const unsigned ra = sgv[i >> 1];
          const float fa = (i & 1) ? __uint_as_float(ra & 0xffff0000u) : __uint_as_float(ra << 16);
          oo[i] = zz * fa;
        }
        u32x4 wv;
        wv.x = pack2(oo[0], oo[1]); wv.y = pack2(oo[2], oo[3]); wv.z = pack2(oo[4], oo[5]); wv.w = pack2(oo[6], oo[7]);
        if (!dry) *(u32x4*)(usg + bb * SEQ + t0c) = wv;
      }
      __syncthreads();
    }
  }
  for (int cb0 = blockIdx.x; cb0 < 1024; cb0 += 4 * gridDim.x) {
    float* aux4 = (float*)smem;
    float* klag = aux4 + 1024;
    f32x4* su = (f32x4*)(klag + 4096);
    f32x4* sz4 = su + 1024;
    f32x4* part = sz4 + 1024;
    int cch[4];
#pragma unroll
    for (int ch = 0; ch < 4; ++ch) { const int cc = cb0 + ch * gridDim.x; cch[ch] = cc < 1024 ? cc : cb0; }
    __syncthreads();
    {
      const int ta = otid();
      if (ta < 256) {
#pragma unroll
        for (int ch = 0; ch < 4; ++ch) aux4[ch * 256 + ta] = fwo[(size_t)(ta >> 2) * 4096 + (ta & 3) * 1024 + cch[ch]];
      }
    }
    __syncthreads();
    {
      const int tf = otid();
      const int t = tf & 255, o = tf >> 8;
      float a0[4] = {0.f, 0.f, 0.f, 0.f}, a1[4] = {0.f, 0.f, 0.f, 0.f};
#pragma unroll 16
      for (int j = 0; j < 64; ++j) {
        const float hv = hdnc[j * LCTX + t];
#pragma unroll
        for (int ch = 0; ch < 4; ++ch) { a0[ch] += hv * aux4[ch * 256 + j * 4 + 2 * o]; a1[ch] += hv * aux4[ch * 256 + j * 4 + 2 * o + 1]; }
      }
#pragma unroll
      for (int ch = 0; ch < 4; ++ch) {
        const float la0 = -15.350567286626973f, la1 = -3.0701134573253945f;
        const float delta = fabsf(la0 + (la1 - la0) * ((float)cch[ch] / 1023.f));
        const float dec = __expf(-((float)t / 255.f) * delta);
        float* kl = klag + ch * 1024 + o * 512;
        if (t == 0) kl[255] = (a0[ch] + a1[ch]) * dec;
        else { kl[255 + t] = a0[ch] * dec; kl[255 - t] = a1[ch] * dec; }
      }
    }
    const int tc = otid();
    const int t = tc & 255, half = tc >> 8;
    float vreg[4][2], g0r[4][2], g1r[4][2], z1[4][2];
#pragma unroll
    for (int ch = 0; ch < 4; ++ch) {
      const int c = cch[ch];
      const bf16_t* uv = ut + (size_t)c * NTOK;
      const bf16_t* ug0 = ut + (size_t)(1024 + c) * NTOK;
      const bf16_t* ug1 = ut + (size_t)(2048 + c) * NTOK;
#pragma unroll
      for (int i = 0; i < 2; ++i) {
        const int base = NLAT + (2 * half + i) * LCTX;
        vreg[ch][i] = sconv(uv + base, t, LCTX, cw[c], cw[3072 + c], cw[6144 + c], cbv[c]);
        g0r[ch][i] = sconv(ug0 + base, t, LCTX, cw[1024 + c], cw[3072 + 1024 + c], cw[6144 + 1024 + c], cbv[1024 + c]);
        g1r[ch][i] = sconv(ug1 + base, t, LCTX, cw[2048 + c], cw[3072 + 2048 + c], cw[6144 + 2048 + c], cbv[2048 + c]);
        ((float*)(su + ch * 256))[t * 4 + 2 * half + i] = vreg[ch][i];
      }
    }
    __syncthreads();
#pragma unroll
    for (int o = 0; o < 2; ++o) {
#pragma unroll
      for (int ch = 0; ch < 4; ++ch) {
        const f32x4* src = (o == 0 ? su : sz4) + ch * 256;
        const float* kl = klag + ch * 1024 + o * 512 + t + 255 - half * 128;
        f32x4 acc = (f32x4){0.f, 0.f, 0.f, 0.f};
#pragma unroll 8
        for (int s2 = 0; s2 < 128; ++s2) acc += kl[-s2] * src[half * 128 + s2];
        part[ch * 512 + half * 256 + t] = acc;
      }
      __syncthreads();
#pragma unroll
      for (int ch = 0; ch < 4; ++ch) {
        const int c = cch[ch];
        const f32x4 p0 = part[ch * 512 + t], p1 = part[ch * 512 + 256 + t];
        const float bias0 = hb[c], bias1 = hb[1024 + c];
        bf16_t* usg = ut + (size_t)(3072 + c) * NTOK;
#pragma unroll
        for (int i = 0; i < 2; ++i) {
          const int bsel = 2 * half + i;
          const float y = (bsel == 0 ? p0.x + p1.x : bsel == 1 ? p0.y + p1.y : bsel == 2 ? p0.z + p1.z : p0.w + p1.w);
          if (o == 0) {
            z1[ch][i] = g0r[ch][i] * (y + vreg[ch][i] * bias0);
            ((float*)(sz4 + ch * 256))[t * 4 + bsel] = z1[ch][i];
          } else {
            const float z2 = g1r[ch][i] * (y + z1[ch][i] * bias1);
            const int tok = NLAT + bsel * LCTX + t;
            if (!dry && (ch == 0 || cb0 + ch * (int)gridDim.x < 1024)) usg[tok] = f2bf(z2 * bf2f(usg[tok]));
          }
        }
      }
      __syncthreads();
    }
  }
}

DI void phase_hy_transpose(const P& p, char* smem) {
  const int tid = otid();
  const bf16_t* z = (const bf16_t*)(p.ws + O_UT) + (size_t)3072 * NTOK;
  bf16_t* og = (bf16_t*)(p.ws + O_ACT);
  bf16_t* tile = (bf16_t*)smem;
  for (int t = blockIdx.x; t < 272 * 16; t += gridDim.x) {
    const int tk0 = (t >> 4) * 64, c0 = (t & 15) * 64;
    __syncthreads();
    { const int ch = tid >> 3, kc = tid & 7;
      *(u32x4*)(tile + ch * 72 + kc * 8) = *(const u32x4*)(z + (size_t)(c0 + ch) * NTOK + tk0 + kc * 8); }
    __syncthreads();
    { const int tk = tid >> 3, cc = tid & 7;
      u32x4 v;
      v.x = (unsigned)tile[(cc * 8 + 0) * 72 + tk] | ((unsigned)tile[(cc * 8 + 1) * 72 + tk] << 16);
      v.y = (unsigned)tile[(cc * 8 + 2) * 72 + tk] | ((unsigned)tile[(cc * 8 + 3) * 72 + tk] << 16);
      v.z = (unsigned)tile[(cc * 8 + 4) * 72 + tk] | ((unsigned)tile[(cc * 8 + 5) * 72 + tk] << 16);
      v.w = (unsigned)tile[(cc * 8 + 6) * 72 + tk] | ((unsigned)tile[(cc * 8 + 7) * 72 + tk] << 16);
      *(u32x4*)(og + (size_t)(tk0 + tk) * 1024 + c0 + cc * 8) = v; }
  }
}

DI void phase_cfconv(const P& p, char* smem) {
  const int tid = otid(), lane = tid & 63, wave = tid >> 6;
  const bf16_t* u3 = (const bf16_t*)(p.ws + O_U3);
  const bf16_t* sg = (const bf16_t*)(p.ws + O_SG3);
  bf16_t* og = (bf16_t*)(p.ws + O_ACT);
  float* red = (float*)smem;
  float* red2 = red + 256;
  const int c0 = tid * 2;
  float w[31][2];
#pragma unroll
  for (int k = 0; k < 31; ++k) { const float2 t = *(const float2*)(p.in[28] + k * 1024 + c0); w[k][0] = t.x; w[k][1] = t.y; }
  const float2 bb = *(const float2*)(p.in[29] + c0), lg = *(const float2*)(p.in[30] + c0), lb = *(const float2*)(p.in[31] + c0);
  for (int tile = blockIdx.x; tile < 1024; tile += gridDim.x) {
    const int tok0 = tile * 16, b = tok0 >> 12, pos0 = tok0 & 4095;
    float acc[16][2];
#pragma unroll
    for (int o = 0; o < 16; ++o) { acc[o][0] = bb.x; acc[o][1] = bb.y; }
#pragma unroll
    for (int r = 0; r < 46; ++r) {
      const int pos = pos0 - 15 + r;
      const int pc = pos < 0 ? 0 : (pos > 4095 ? 4095 : pos);
      unsigned raw = *(const unsigned*)(u3 + (size_t)(b * SEQ + pc) * 1024 + c0);
      if (pos != pc) raw = 0u;
      const float x0 = __uint_as_float(raw << 16), x1 = __uint_as_float(raw & 0xffff0000u);
#pragma unroll
      for (int o = 0; o < 16; ++o) {
        const int j = r - o;
        if (j >= 0 && j <= 30) { acc[o][0] += w[j][0] * x0; acc[o][1] += w[j][1] * x1; }
      }
    }
    __syncthreads();
#pragma unroll
    for (int o = 0; o < 16; ++o) {
      float s1 = acc[o][0] + acc[o][1];
      float s2 = acc[o][0] * acc[o][0] + acc[o][1] * acc[o][1];
      s1 = wave_sum(s1); s2 = wave_sum(s2);
      if (lane == 0) { red[wave * 32 + o] = s1; red[wave * 32 + 16 + o] = s2; }
    }
    __syncthreads();
    if (tid < 32) {
      float s = 0.f;
#pragma unroll
      for (int w8 = 0; w8 < 8; ++w8) s += red[w8 * 32 + tid];
      red2[tid] = s;
    }
    __syncthreads();
#pragma unroll
    for (int o = 0; o < 16; ++o) {
      const float mean = red2[o] * (1.f / 1024.f);
      const float var = red2[16 + o] * (1.f / 1024.f) - mean * mean;
      const float rstd = rsqrtf(fmaxf(var, 0.f) + 1e-6f);
      const int tok = tok0 + o;
      const unsigned graw = *(const unsigned*)(sg + (size_t)tok * 1024 + c0);
      const float y0 = siluf((acc[o][0] - mean) * rstd * lg.x + lb.x) * __uint_as_float(graw << 16);
      const float y1 = siluf((acc[o][1] - mean) * rstd * lg.y + lb.y) * __uint_as_float(graw & 0xffff0000u);
      *(unsigned*)(og + (size_t)tok * 1024 + c0) = pack2(y0, y1);
    }
  }
}


#define XB_TMO      128
#define XB_XCNT(j)  (256  + 64 * (j))
#define XB_XSUB(j)  (1280 + 64 * (j))
#define XB_XGEN(j)  (2304 + 64 * (j))
#define XB_TOP      3328
#define XB_TOPGEN   3392
#define XCD_BAR_WORDS 3456
#define XB_SPIN_CAP (1u << 22)
#define LAS __attribute__((address_space(3)))
DI unsigned xb_ld(unsigned* p) { return __hip_atomic_load(p, __ATOMIC_RELAXED, __HIP_MEMORY_SCOPE_AGENT); }
DI unsigned xb_add(unsigned* p, unsigned v) { return __hip_atomic_fetch_add(p, v, __ATOMIC_RELAXED, __HIP_MEMORY_SCOPE_AGENT); }
DI unsigned xb_xcc_id() { return (unsigned)__builtin_amdgcn_s_getreg((3 << 11) | 20) & 0xFu; }
#define XB_SPIN(cond, bar) do { unsigned _sp = 0; while (cond) { __builtin_amdgcn_s_sleep(1); \
    if ((++_sp & 255u) == 0u) { if (xb_ld(&(bar)[XB_TMO])) break; if (_sp > XB_SPIN_CAP) { atomicAdd(&(bar)[XB_TMO], 1u); break; } } } } while (0)
struct XcdBarrier { unsigned* bar; unsigned x; volatile LAS unsigned* st; };
DI XcdBarrier xcd_barrier_post(unsigned* bar, volatile LAS unsigned* st) {
  XcdBarrier b; b.bar = bar; b.x = xb_xcc_id(); b.st = st;
  if (threadIdx.x == 0) (void)xb_add(&bar[XB_XCNT(b.x)], 1u);
  return b;
}
DI void xcd_barrier_complete(unsigned* bar, unsigned x, unsigned& nloc, unsigned& nx) {
  const unsigned G = gridDim.x * gridDim.y * gridDim.z;
  unsigned sum, cnt, mine, sp = 0u;
  for (;;) {
    sum = 0u; cnt = 0u; mine = 0u;
#pragma unroll
    for (unsigned j = 0; j < 16; ++j) { const unsigned c = xb_ld(&bar[XB_XCNT(j)]); sum += c; cnt += (c > 0u) ? 1u : 0u; mine = (j == x) ? c : mine; }
    if (sum == G) break;
    __builtin_amdgcn_s_sleep(1);
    if ((++sp & 255u) == 0u) { if (xb_ld(&bar[XB_TMO])) break; if (sp > XB_SPIN_CAP) { atomicAdd(&bar[XB_TMO], 1u); break; } }
  }
  nloc = mine > 0u ? mine : 1u; nx = cnt > 0u ? cnt : 1u;
}
__device__ __attribute__((noinline)) void xcd_barrier(unsigned* bbar, unsigned bx, volatile LAS unsigned* bst, bool leader) {
  XcdBarrier b; b.bar = bbar; b.x = bx; b.st = bst;
  asm volatile("s_waitcnt vmcnt(0)" ::: "memory");
  __syncthreads();
  if (leader) {
    unsigned* bar = b.bar;
    __builtin_amdgcn_s_waitcnt(0);
    unsigned nloc = b.st[0], nx = b.st[1];
    if (nloc == 0u) { xcd_barrier_complete(bar, b.x, nloc, nx); b.st[0] = nloc; b.st[1] = nx; }
    const unsigned old = xb_add(&bar[XB_XSUB(b.x)], 1u);
    const unsigned gen = old / nloc;
    if (old + 1u == (gen + 1u) * nloc) {
      __builtin_amdgcn_fence(__ATOMIC_RELEASE, "agent");
      asm volatile("s_waitcnt vmcnt(0)" ::: "memory");
      const unsigned og = xb_add(&bar[XB_TOP], 1u);
      const unsigned tg = og / nx;
      if (og + 1u == (tg + 1u) * nx) xb_add(&bar[XB_TOPGEN], 1u);
      else XB_SPIN(xb_ld(&bar[XB_TOPGEN]) == tg, bar);
      __builtin_amdgcn_fence(__ATOMIC_ACQUIRE, "agent");
      xb_add(&bar[XB_XGEN(b.x)], 1u);
      asm volatile("s_waitcnt vmcnt(0)" ::: "memory");
    } else {
      XB_SPIN(xb_ld(&bar[XB_XGEN(b.x)]) == gen, bar);
      __builtin_amdgcn_fence(__ATOMIC_ACQUIRE, "agent");
      asm volatile("s_waitcnt vmcnt(0)" ::: "memory");
    }
  }
  __syncthreads();
}

__global__ void __launch_bounds__(NT) mega(P p) {
  cg::grid_group grid = cg::this_grid();
  extern __shared__ __attribute__((aligned(16))) char smem[];
  __shared__ float aux[256];
  __shared__ uint4 xb_words;
  if (threadIdx.x == 0) xb_words = make_uint4(0u, 0u, 0u, 0u);
  __syncthreads();
  const XcdBarrier xb = xcd_barrier_post((unsigned*)(p.ws + O_BAR), (volatile LAS unsigned*)&xb_words);
  if (p.reps[7] == 0x7fffffff) grid.sync();

#define REP(g) for (int rep_ = 0; rep_ < p.reps[g]; ++rep_)
  REP(0) { phase0(p, smem); xcd_barrier(xb.bar, xb.x, xb.st, otid() == 0); }
  REP(1) { phase_norm(p, 0, NTOK); phase_shiftw(p, smem); xcd_barrier(xb.bar, xb.x, xb.st, otid() == 0); }
  REP(2) {
    unsigned char* ws = opq(p.ws); const bf16_t* act = (const bf16_t*)(ws + O_ACT); const float2* rope = (const float2*)(ws + O_ROPE); (void)act; (void)rope;
    EpiMlaIn e{(bf16_t*)(ws + O_CQ), (bf16_t*)(ws + O_CKV), (bf16_t*)(ws + O_KP), (bf16_t*)(ws + O_SG0), rope, (float*)(ws + O_RSS)};
    gemm_phase256((const bf16_t*)(ws + O_W_MLA_IN), act, 1024, 1792, NTOK, smem, e, rep_ + 1 < p.reps[2]);
    xcd_barrier(xb.bar, xb.x, xb.st, otid() == 0);
  }
  REP(2) {
    unsigned char* ws = opq(p.ws); const bf16_t* act = (const bf16_t*)(ws + O_ACT); const float2* rope = (const float2*)(ws + O_ROPE); (void)act; (void)rope;
    EpiUq e1{(bf16_t*)(ws + O_Q), rope, (const float*)(ws + O_RSS)};
    EpiUkv e2{(bf16_t*)(ws + O_KP), (bf16_t*)(ws + O_ACT), (const float*)(ws + O_RSS)};
    TileWalk tw(14, 68);
    int ft, tt;
    while (tw.next(ft, tt)) {
      if (ft < 6) gemm_tile8p((const bf16_t*)(ws + O_W_UQ), (const bf16_t*)(ws + O_CQ), 384, ft * 256, tt * 256, smem, e1, rep_ + 1 < p.reps[2]);
      else gemm_tile8p((const bf16_t*)(ws + O_W_UKV), (const bf16_t*)(ws + O_CKV), 256, (ft - 6) * 256, tt * 256, smem, e2, rep_ + 1 < p.reps[2]);
    }
    xcd_barrier(xb.bar, xb.x, xb.st, otid() == 0);
  }
  REP(4) { phase_mla_attn(p, smem, rep_ + 1 < p.reps[4]); xcd_barrier(xb.bar, xb.x, xb.st, otid() == 0); }
  REP(3) {
    unsigned char* ws = opq(p.ws); const bf16_t* act = (const bf16_t*)(ws + O_ACT); float* xc = (float*)(ws + O_XC); float* mod = (float*)(ws + O_MOD); (void)act;
    EpiRes e{p.in[0], p.in[2], p.out, xc, mod + 0 * 5 * 3072, rep_ + 1 < p.reps[3], (bf16_t*)(ws + O_ACT), p.in[4] + 1 * 1024, mod + 1 * 5 * 3072, (float*)(ws + O_RSSL) + 0 * NTOK};
    gemm_phase256((const bf16_t*)(ws + O_W_MLA_OUT), (const bf16_t*)(ws + O_SG0), 1024, 1024, NTOK, smem, e);
    xcd_barrier(xb.bar, xb.x, xb.st, otid() == 0);
  }
  REP(2) {
    unsigned char* ws = opq(p.ws); const bf16_t* act = (const bf16_t*)(ws + O_ACT); const float2* rope = (const float2*)(ws + O_ROPE); (void)act; (void)rope;
    EpiHyIn e{(bf16_t*)(ws + O_UT), PreNorm{(const float*)(ws + O_RSSL) + 0 * NTOK, (const float*)(ws + O_SW), 4096}};
    gemm_phase256((const bf16_t*)(ws + O_W_HY_IN), act, 1024, 4096, NTOK, smem, e, rep_ + 1 < p.reps[2]);
    xcd_barrier(xb.bar, xb.x, xb.st, otid() == 0);
  }
  REP(5) { phase_hyena(p, smem, aux, rep_ + 1 < p.reps[5]); xcd_barrier(xb.bar, xb.x, xb.st, otid() == 0); }
  phase_hy_transpose(p, smem);
  xcd_barrier(xb.bar, xb.x, xb.st, otid() == 0);
  REP(3) {
    unsigned char* ws = opq(p.ws); const bf16_t* act = (const bf16_t*)(ws + O_ACT); float* xc = (float*)(ws + O_XC); float* mod = (float*)(ws + O_MOD); (void)act;
    EpiRes e{p.out, xc, p.out, xc, mod + 1 * 5 * 3072, rep_ + 1 < p.reps[3], (bf16_t*)(ws + O_XG2), p.in[4] + 2 * 1024, mod + 2 * 5 * 3072, (float*)(ws + O_RSSL) + 1 * NTOK};
    gemm_phase256((const bf16_t*)(ws + O_W_HY_OUT), act, 1024, 1024, NTOK, smem, e);
    xcd_barrier(xb.bar, xb.x, xb.st, otid() == 0);
  }
  REP(2) {
    unsigned char* ws = opq(p.ws); const bf16_t* act = (const bf16_t*)(ws + O_ACT); const float2* rope = (const float2*)(ws + O_ROPE); (void)act; (void)rope;
    EpiSwaIn e{(bf16_t*)(ws + O_QS), (bf16_t*)(ws + O_KS), (bf16_t*)(ws + O_VT2), (bf16_t*)(ws + O_SG2), rope, PreNorm{(const float*)(ws + O_RSSL) + 1 * NTOK, (const float*)(ws + O_SW) + 5 * 4096, 2560}};
    gemm_phase256((const bf16_t*)(ws + O_W_SWA_IN), (const bf16_t*)(ws + O_XG2), 1024, 2560, NTOK, smem, e, rep_ + 1 < p.reps[2]);
    xcd_barrier(xb.bar, xb.x, xb.st, otid() == 0);
  }
  REP(6) { phase_swa_attn(p, smem, rep_ + 1 < p.reps[6]); xcd_barrier(xb.bar, xb.x, xb.st, otid() == 0); }
  REP(3) {
    unsigned char* ws = opq(p.ws); const bf16_t* act = (const bf16_t*)(ws + O_ACT); float* xc = (float*)(ws + O_XC); float* mod = (float*)(ws + O_MOD); (void)act;
    EpiRes e{p.out, xc, p.out, xc, mod + 2 * 5 * 3072, rep_ + 1 < p.reps[3], (bf16_t*)(ws + O_ACT), p.in[4] + 3 * 1024, mod + 3 * 5 * 3072, (float*)(ws + O_RSSL) + 2 * NTOK};
    gemm_phase256((const bf16_t*)(ws + O_W_SWA_OUT), (const bf16_t*)(ws + O_SG2), 1024, 1024, NLAT, smem, e);
    xcd_barrier(xb.bar, xb.x, xb.st, otid() == 0);
  }
  REP(2) {
    unsigned char* ws = opq(p.ws); const bf16_t* act = (const bf16_t*)(ws + O_ACT); const float2* rope = (const float2*)(ws + O_ROPE); (void)act; (void)rope;
    EpiCfIn e{(bf16_t*)(ws + O_U3), (bf16_t*)(ws + O_SG3), PreNorm{(const float*)(ws + O_RSSL) + 2 * NTOK, (const float*)(ws + O_SW) + 5 * (4096 + 2560), 3072}};
    gemm_phase256((const bf16_t*)(ws + O_W_CF_IN), act, 1024, 3072, NLAT, smem, e, rep_ + 1 < p.reps[2]);
    xcd_barrier(xb.bar, xb.x, xb.st, otid() == 0);
  }
  REP(7) { phase_cfconv(p, smem); xcd_barrier(xb.bar, xb.x, xb.st, otid() == 0); }
  REP(3) {
    unsigned char* ws = opq(p.ws); const bf16_t* act = (const bf16_t*)(ws + O_ACT); float* xc = (float*)(ws + O_XC); float* mod = (float*)(ws + O_MOD); (void)act;
    EpiRes e{p.out, xc, p.out, xc, mod + 3 * 5 * 3072, rep_ + 1 < p.reps[3], nullptr, nullptr, nullptr, nullptr};
    gemm_phase256((const bf16_t*)(ws + O_W_CF_OUT), act, 1024, 1024, NLAT, smem, e);
    xcd_barrier(xb.bar, xb.x, xb.st, otid() == 0);
  }
  phase_final(p);
}

extern "C" void kernel_launch(void* const* d_in, const int* in_sizes, int n_in, void* d_out, int out_size, void* d_ws, size_t ws_size,
                              hipStream_t stream) {
  static int grid = 0;
  if (grid == 0) {
    if (n_in != 33 || ws_size < WS_NEED) {
      fprintf(stderr, "kernel_launch: need 33 inputs and >= %zu bytes of workspace; got n_in %d, ws %zu\n", (size_t)WS_NEED, n_in, ws_size);
      grid = -1;
      return;
    }
    int dev = 0, cus = 0, per_cu = 0;
    hipGetDevice(&dev);
    hipDeviceGetAttribute(&cus, hipDeviceAttributeMultiprocessorCount, dev);
    if (hipFuncSetAttribute((const void*)mega, hipFuncAttributeMaxDynamicSharedMemorySize, DYN_LDS) != hipSuccess) { fprintf(stderr, "hipFuncSetAttribute failed\n"); grid = -1; return; }
    hipOccupancyMaxActiveBlocksPerMultiprocessor(&per_cu, mega, NT, DYN_LDS);
    int g = cus * per_cu;
    if (g > 256) g = 256;
    if (g < 1) g = 256;
    grid = g;
  }
  if (grid < 0) return;
  P p{};
  for (int i = 0; i < 33; ++i) p.in[i] = (const float*)d_in[i];
  p.out = (float*)d_out;
  p.ws = (unsigned char*)d_ws;
  { const int r[8] = {PROBE_REPS}; for (int i = 0; i < 8; ++i) p.reps[i] = r[i]; }
  if (hipMemsetAsync((char*)d_ws + O_BAR, 0, XCD_BAR_BYTES, stream) != hipSuccess) { fprintf(stderr, "memset of barrier words failed\n"); return; }
  void* args[] = {&p};
  hipError_t e = hipLaunchCooperativeKernel((void*)mega, dim3(grid), dim3(NT), args, DYN_LDS, stream);
  if (e != hipSuccess) fprintf(stderr, "cooperative launch failed: %s (grid %d)\n", hipGetErrorString(e), grid);
}
```
